# Optimizing an MI355X kernel written in HIP

```python
import math
import jax
import jax.numpy as jnp
from jax import lax
import numpy as np

D_MODEL = 1024
BATCH = 8
SEQ = 2048
DEPTH = 2
DEC_BATCH = 32
DEC_SEQ = 16
PAST_LEN = 4096

CHUNK = 64
N_HEADS = 8
N_KV_HEADS = 2
HEAD_DIM = 64
GQA_GROUP = N_HEADS // N_KV_HEADS
ROT_DIM = HEAD_DIM // 4
ROPE_THETA = 500000.0
WINDOW = 128
WIN_CHUNKS = WINDOW // CHUNK
SSM_HEADS = 16
SSM_HEAD_DIM = 64
SSM_INNER = SSM_HEADS * SSM_HEAD_DIM
SSM_GROUPS = 2
SSM_STATE = 128
SSM_CHUNK = 64
CONV_WIDTH = 4
CONV_DIM = SSM_INNER + 2 * SSM_GROUPS * SSM_STATE
GM_WIDTH = 512
GM_GROUPS = 4
GM_GROUP_DIM = GM_WIDTH // GM_GROUPS
GM_CHUNK = 128
D_FF = 4 * D_MODEL
N_BRANCH = 3
Q_W = N_HEADS * HEAD_DIM
KV_W = N_KV_HEADS * HEAD_DIM
N_IN = Q_W + 2 * KV_W + SSM_INNER + CONV_DIM + SSM_HEADS + 2 * GM_WIDTH + N_BRANCH * D_MODEL
EPS = 1e-6

kernel_name = 'hybrid_streaming_encoder_step'


def rms_norm(x, g):
    xf = x.astype(jnp.float32)
    y = xf * lax.rsqrt(jnp.mean(xf * xf, axis=-1, keepdims=True) + EPS)
    return (y * g.astype(jnp.float32)).astype(x.dtype)


def layer_norm(x, g, b):
    xf = x.astype(jnp.float32)
    xc = xf - jnp.mean(xf, axis=-1, keepdims=True)
    y = xc * lax.rsqrt(jnp.mean(xc * xc, axis=-1, keepdims=True) + EPS)
    return (y * g.astype(jnp.float32) + b.astype(jnp.float32)).astype(x.dtype)


def partial_rope(x, pos):
    half = ROT_DIM // 2
    inv_freq = ROPE_THETA ** (-jnp.arange(half, dtype=jnp.float32) * (2.0 / ROT_DIM))
    ang = pos.astype(jnp.float32)[:, None] * inv_freq[None, :]
    cos = jnp.cos(ang)[None, :, None, :]
    sin = jnp.sin(ang)[None, :, None, :]
    xf = x.astype(jnp.float32)
    x1 = xf[..., :half]
    x2 = xf[..., half:ROT_DIM]
    out = jnp.concatenate([x1 * cos - x2 * sin, x2 * cos + x1 * sin, xf[..., ROT_DIM:]], axis=-1)
    return out.astype(x.dtype)


def split_projection(proj):
    sizes = (Q_W, KV_W, KV_W, SSM_INNER, CONV_DIM, SSM_HEADS, GM_WIDTH, GM_WIDTH, N_BRANCH * D_MODEL)
    idx = [int(i) for i in np.cumsum(np.array(sizes))[:-1]]
    return jnp.split(proj, idx, axis=-1)


def sink_attend(q, k, v, valid, sinks):
    s = jnp.einsum('bcqkgd,bcnkd->bckgqn', q.astype(jnp.float32), k.astype(jnp.float32)) * (HEAD_DIM ** -0.5)
    s = jnp.where(valid[:, None, None, None, :], s, -jnp.inf)
    sink = sinks.astype(jnp.float32).reshape(N_KV_HEADS, GQA_GROUP)[:, :, None]
    m = jnp.maximum(jnp.max(s, axis=-1), sink)
    p = jnp.exp(s - m[..., None])
    denom = jnp.sum(p, axis=-1) + jnp.exp(sink - m)
    o = jnp.einsum('bckgqn,bcnkd->bcqkgd', p, v.astype(jnp.float32))
    o = o / jnp.moveaxis(denom, -1, 2)[..., None]
    return o.astype(q.dtype)


def attn_prompt(q, k, v, sinks):
    bsz, s = q.shape[0], q.shape[1]
    nc = s // CHUNK
    qb = q.reshape(bsz, nc, CHUNK, N_KV_HEADS, GQA_GROUP, HEAD_DIM)

    def band(t):
        tp = jnp.pad(t, ((0, 0), (WINDOW, 0), (0, 0), (0, 0)))
        tp = tp.reshape(bsz, nc + WIN_CHUNKS, CHUNK, N_KV_HEADS, HEAD_DIM)
        return jnp.concatenate([tp[:, j:j + nc] for j in range(WIN_CHUNKS + 1)], axis=2)

    kb = band(k)
    vb = band(v)
    slot_chunk = jnp.repeat(jnp.arange(WIN_CHUNKS + 1), CHUNK)
    valid = (jnp.arange(nc)[:, None] + slot_chunk[None, :] - WIN_CHUNKS) >= 0
    return sink_attend(qb, kb, vb, valid, sinks).reshape(bsz, s, Q_W)


def attn_sample(q, k, v, cache_k, cache_v, sinks):
    bsz, s = q.shape[0], q.shape[1]
    qb = q.reshape(bsz, 1, s, N_KV_HEADS, GQA_GROUP, HEAD_DIM)
    kb = jnp.concatenate([cache_k.astype(k.dtype), k], axis=1)[:, None]
    vb = jnp.concatenate([cache_v.astype(v.dtype), v], axis=1)[:, None]
    valid = jnp.ones((1, kb.shape[2]), dtype=bool)
    return sink_attend(qb, kb, vb, valid, sinks).reshape(bsz, s, Q_W)


def causal_conv(xbc, conv_state, w, b):
    s = xbc.shape[1]
    xp = jnp.concatenate([conv_state.astype(xbc.dtype), xbc], axis=1)
    out = b
    for i in range(CONV_WIDTH):
        out = out + xp[:, i:i + s] * w[i]
    return jax.nn.silu(out), xp[:, xp.shape[1] - (CONV_WIDTH - 1):]


def ssd_scan(x, dt, a, bm, cm, h0):
    bsz, s = x.shape[0], x.shape[1]
    l = min(SSM_CHUNK, s)
    nc = s // l
    hg = SSM_HEADS // SSM_GROUPS
    xdt = (x * dt[..., None]).reshape(bsz, nc, l, SSM_GROUPS, hg, SSM_HEAD_DIM)
    cum = jnp.cumsum((dt * a).reshape(bsz, nc, l, SSM_GROUPS, hg), axis=2)
    bc = bm.reshape(bsz, nc, l, SSM_GROUPS, SSM_STATE)
    cc = cm.reshape(bsz, nc, l, SSM_GROUPS, SSM_STATE)
    causal = jnp.tril(jnp.ones((l, l), dtype=bool))[:, :, None, None]
    diff = cum[:, :, :, None] - cum[:, :, None, :]
    decay = jnp.exp(jnp.where(causal, diff, -jnp.inf))
    cb = jnp.einsum('bctgn,bcsgn->bctsg', cc, bc)
    y_intra = jnp.einsum('bctsg,bctsgk,bcsgkp->bctgkp', cb, decay, xdt)
    decay_end = jnp.exp(cum[:, :, -1:] - cum)
    chunk_state = jnp.einsum('bcsgn,bcsgk,bcsgkp->bcgkpn', bc, decay_end, xdt)
    chunk_decay = jnp.exp(cum[:, :, -1])

    def step(h, inp):
        dec, st = inp
        return dec[..., None, None] * h + st, h

    h_last, h_in = lax.scan(step, h0.reshape(bsz, SSM_GROUPS, hg, SSM_HEAD_DIM, SSM_STATE),
                            (jnp.moveaxis(chunk_decay, 1, 0), jnp.moveaxis(chunk_state, 1, 0)))
    h_in = jnp.moveaxis(h_in, 0, 1)
    y_inter = jnp.einsum('bctgn,bcgkpn->bctgkp', cc, h_in) * jnp.exp(cum)[..., None]
    y = (y_intra + y_inter).reshape(bsz, s, SSM_HEADS, SSM_HEAD_DIM)
    return y, h_last.reshape(bsz, SSM_HEADS, SSM_HEAD_DIM, SSM_STATE)


def mamba_branch(xbc, z, dt_raw, conv_state, ssm_state, p):
    xbc_act, new_conv = causal_conv(xbc, conv_state, p['conv_w'], p['conv_b'])
    bsz, s = xbc.shape[0], xbc.shape[1]
    xs, bm, cm = jnp.split(xbc_act.astype(jnp.float32), [SSM_INNER, SSM_INNER + SSM_GROUPS * SSM_STATE], axis=-1)
    xs = xs.reshape(bsz, s, SSM_HEADS, SSM_HEAD_DIM)
    dt = jax.nn.softplus(dt_raw.astype(jnp.float32) + p['dt_bias'].astype(jnp.float32))
    a = -jnp.exp(p['a_log'].astype(jnp.float32))
    y, h_last = ssd_scan(xs, dt, a,
                         bm.reshape(bsz, s, SSM_GROUPS, SSM_STATE),
                         cm.reshape(bsz, s, SSM_GROUPS, SSM_STATE),
                         ssm_state.astype(jnp.float32))
    y = y + p['d_skip'].astype(jnp.float32)[:, None] * xs
    y = rms_norm(y.reshape(bsz, s, SSM_INNER) * jax.nn.silu(z.astype(jnp.float32)), p['ssm_norm_w'])
    return y.astype(z.dtype), new_conv, h_last.astype(ssm_state.dtype)


def gmlp_branch(u, v, p):
    bsz, s = u.shape[0], u.shape[1]
    l = min(GM_CHUNK, s)
    nc = s // l
    u = jax.nn.gelu(u)
    v = layer_norm(jax.nn.gelu(v), p['gm_ln_g'], p['gm_ln_b'])
    vg = v.reshape(bsz, nc, l, GM_GROUPS, GM_GROUP_DIM)
    w = jnp.where(jnp.tril(jnp.ones((l, l), dtype=bool)), p['gm_w_s'][:, :l, :l], 0)
    mixed = jnp.einsum('gts,bcsgd->bctgd', w, vg) + jnp.transpose(p['gm_b_s'][:, :l])[:, :, None]
    return u * mixed.reshape(bsz, s, GM_WIDTH).astype(u.dtype), v


def trunk_layer(x, c, pos, conv_state, ssm_state, kv_cache, p):
    bsz, s = x.shape[0], x.shape[1]
    mod = (jax.nn.silu(c) @ p['w_ada'] + p['b_ada']).reshape(bsz, 6, D_MODEL)
    shift1, scale1, gate1, shift2, scale2, gate2 = [mod[:, i][:, None, :] for i in range(6)]
    h = rms_norm(x, p['g_mix']) * (1 + scale1) + shift1
    q, k, v, z, xbc, dt_raw, gu, gv, gates = split_projection(h @ p['w_in'])
    q = partial_rope(q.reshape(bsz, s, N_HEADS, HEAD_DIM), pos)
    k = partial_rope(k.reshape(bsz, s, N_KV_HEADS, HEAD_DIM), pos)
    v = v.reshape(bsz, s, N_KV_HEADS, HEAD_DIM)
    if kv_cache is None:
        attn = attn_prompt(q, k, v, p['sinks'])
        keep_k, keep_v = k[:, s - WINDOW:], v[:, s - WINDOW:]
    else:
        attn = attn_sample(q, k, v, kv_cache[0], kv_cache[1], p['sinks'])
        keep_k, keep_v = k, v
    ssm_out, new_conv, h_last = mamba_branch(xbc, z, dt_raw, conv_state, ssm_state, p)
    gm_out, gm_v = gmlp_branch(gu, gv, p)
    g = jax.nn.sigmoid(gates.astype(jnp.float32)).astype(x.dtype).reshape(bsz, s, N_BRANCH, D_MODEL)
    merged = (g[:, :, 0] * (attn @ p['w_attn_o'])
              + g[:, :, 1] * (ssm_out @ p['w_ssm_o'])
              + g[:, :, 2] * (gm_out @ p['w_gm_o']))
    x = x + gate1 * (merged @ p['w_out'])
    h2 = rms_norm(x, p['g_ff']) * (1 + scale2) + shift2
    x = x + gate2 * (jnp.square(jax.nn.relu(h2 @ p['w_ff1'])) @ p['w_ff2'])
    return x, keep_k, keep_v, new_conv, h_last, gm_v


def setup_inputs(seed: int = 0) -> dict:
    key = jax.random.key(seed)
    keys = jax.random.split(key, 40)
    counter = [0]

    def nxt():
        k = keys[counter[0]]
        counter[0] += 1
        return k

    def nrm(shape, scale):
        return jax.random.normal(nxt(), shape, jnp.float32) * scale

    attn_rows = min(WINDOW, PAST_LEN)
    x_prompt = nrm((BATCH, SEQ, D_MODEL), 1.0)
    x_sample = nrm((DEC_BATCH, DEC_SEQ, D_MODEL), 1.0)
    c_prompt = nrm((BATCH, D_MODEL), 1.0)
    c_sample = nrm((DEC_BATCH, D_MODEL), 1.0)
    cache_attn_k = nrm((DEPTH, DEC_BATCH, attn_rows, N_KV_HEADS, HEAD_DIM), 1.0)
    cache_attn_v = nrm((DEPTH, DEC_BATCH, attn_rows, N_KV_HEADS, HEAD_DIM), 1.0)
    state_ssm = nrm((DEPTH, DEC_BATCH, SSM_HEADS, SSM_HEAD_DIM, SSM_STATE), 0.1)
    state_conv = nrm((DEPTH, DEC_BATCH, CONV_WIDTH - 1, CONV_DIM), 1.0)
    dt0 = jnp.exp(jax.random.uniform(nxt(), (DEPTH, SSM_HEADS), jnp.float32, math.log(1e-3), math.log(1e-1)))
    a0 = jax.random.uniform(nxt(), (DEPTH, SSM_HEADS), jnp.float32, 1.0, 16.0)
    return {
        'x_prompt': x_prompt,
        'x_sample': x_sample,
        'c_prompt': c_prompt,
        'c_sample': c_sample,
        'cache_attn_k': cache_attn_k,
        'cache_attn_v': cache_attn_v,
        'state_ssm': state_ssm,
        'state_conv': state_conv,
        'w_ada': nrm((DEPTH, D_MODEL, 6 * D_MODEL), 0.5 * D_MODEL ** -0.5),
        'b_ada': nrm((DEPTH, 6 * D_MODEL), 0.01),
        'g_mix': 1.0 + nrm((DEPTH, D_MODEL), 0.05),
        'w_in': nrm((DEPTH, D_MODEL, N_IN), D_MODEL ** -0.5),
        'sinks': nrm((DEPTH, N_HEADS), 0.5),
        'conv_w': nrm((DEPTH, CONV_WIDTH, CONV_DIM), CONV_WIDTH ** -0.5),
        'conv_b': nrm((DEPTH, CONV_DIM), 0.01),
        'dt_bias': dt0 + jnp.log(-jnp.expm1(-dt0)),
        'a_log': jnp.log(a0),
        'd_skip': 1.0 + nrm((DEPTH, SSM_HEADS), 0.1),
        'ssm_norm_w': 1.0 + nrm((DEPTH, SSM_INNER), 0.05),
        'gm_ln_g': 1.0 + nrm((DEPTH, GM_WIDTH), 0.05),
        'gm_ln_b': nrm((DEPTH, GM_WIDTH), 0.01),
        'gm_w_s': nrm((DEPTH, GM_GROUPS, GM_CHUNK, GM_CHUNK), GM_CHUNK ** -0.5),
        'gm_b_s': 1.0 + nrm((DEPTH, GM_GROUPS, GM_CHUNK), 0.1),
        'w_attn_o': nrm((DEPTH, Q_W, D_MODEL), Q_W ** -0.5),
        'w_ssm_o': nrm((DEPTH, SSM_INNER, D_MODEL), SSM_INNER ** -0.5),
        'w_gm_o': nrm((DEPTH, GM_WIDTH, D_MODEL), GM_WIDTH ** -0.5),
        'w_out': nrm((DEPTH, D_MODEL, D_MODEL), D_MODEL ** -0.5),
        'g_ff': 1.0 + nrm((DEPTH, D_MODEL), 0.05),
        'w_ff1': nrm((DEPTH, D_MODEL, D_FF), D_MODEL ** -0.5),
        'w_ff2': nrm((DEPTH, D_FF, D_MODEL), D_FF ** -0.5),
        'g_final': 1.0 + nrm((D_MODEL,), 0.05),
    }


def reference(x_prompt, x_sample, c_prompt, c_sample, cache_attn_k, cache_attn_v, state_ssm, state_conv,
              w_ada, b_ada, g_mix, w_in, sinks, conv_w, conv_b, dt_bias, a_log, d_skip, ssm_norm_w,
              gm_ln_g, gm_ln_b, gm_w_s, gm_b_s, w_attn_o, w_ssm_o, w_gm_o, w_out, g_ff, w_ff1, w_ff2,
              g_final):
    bp, sp = x_prompt.shape[0], x_prompt.shape[1]
    pos_p = jnp.arange(sp)
    pos_s = PAST_LEN + jnp.arange(x_sample.shape[1])
    xp = x_prompt
    xs = x_sample
    kp_l, vp_l, sp_l, cp_l = [], [], [], []
    ks_l, vs_l, ss_l, cs_l, gs_l = [], [], [], [], []
    for l in range(DEPTH):
        p = {
            'w_ada': w_ada[l], 'b_ada': b_ada[l], 'g_mix': g_mix[l], 'w_in': w_in[l], 'sinks': sinks[l],
            'conv_w': conv_w[l], 'conv_b': conv_b[l], 'dt_bias': dt_bias[l], 'a_log': a_log[l],
            'd_skip': d_skip[l], 'ssm_norm_w': ssm_norm_w[l], 'gm_ln_g': gm_ln_g[l], 'gm_ln_b': gm_ln_b[l],
            'gm_w_s': gm_w_s[l], 'gm_b_s': gm_b_s[l], 'w_attn_o': w_attn_o[l], 'w_ssm_o': w_ssm_o[l],
            'w_gm_o': w_gm_o[l], 'w_out': w_out[l], 'g_ff': g_ff[l], 'w_ff1': w_ff1[l], 'w_ff2': w_ff2[l],
        }
        zero_conv = jnp.zeros((bp, CONV_WIDTH - 1, CONV_DIM), x_prompt.dtype)
        zero_ssm = jnp.zeros((bp, SSM_HEADS, SSM_HEAD_DIM, SSM_STATE), jnp.float32)
        xp, kp, vp, convp, ssmp, _ = trunk_layer(xp, c_prompt, pos_p, zero_conv, zero_ssm, None, p)
        xs, ksn, vsn, convs, ssms, gvs = trunk_layer(xs, c_sample, pos_s, state_conv[l], state_ssm[l],
                                                     (cache_attn_k[l], cache_attn_v[l]), p)
        kp_l.append(kp)
        vp_l.append(vp)
        sp_l.append(ssmp)
        cp_l.append(convp)
        ks_l.append(ksn)
        vs_l.append(vsn)
        ss_l.append(ssms)
        cs_l.append(convs)
        gs_l.append(gvs)
    y_prompt = rms_norm(xp, g_final)
    y_sample = rms_norm(xs, g_final)
    return (y_prompt, y_sample,
            jnp.stack(kp_l), jnp.stack(vp_l), jnp.stack(sp_l), jnp.stack(cp_l),
            jnp.stack(ks_l), jnp.stack(vs_l), jnp.stack(ss_l), jnp.stack(cs_l), jnp.stack(gs_l))
```

```cpp
#include <hip/hip_runtime.h>
#include <hip/hip_cooperative_groups.h>
#include <cstdio>
namespace cg = cooperative_groups;

#define LAS __attribute__((address_space(3)))
typedef unsigned short bf16_t;
typedef short bf16x8 __attribute__((ext_vector_type(8)));
typedef float f32x4 __attribute__((ext_vector_type(4)));
typedef float f32x2 __attribute__((ext_vector_type(2)));
typedef unsigned u32x2 __attribute__((ext_vector_type(2)));
typedef unsigned u32x4 __attribute__((ext_vector_type(4)));

constexpr int DM = 1024, TP = 16384, TS = 512, T = TP + TS;
constexpr int NINP = 7680;
constexpr float EPSF = 1e-6f;

constexpr size_t O_Y = 0;
constexpr size_t O_KP = (size_t)T * DM;
constexpr size_t O_VP = O_KP + 2 * 8 * 128 * 128;
constexpr size_t O_SP = O_VP + 2 * 8 * 128 * 128;
constexpr size_t O_CP = O_SP + (size_t)2 * 8 * 16 * 64 * 128;
constexpr size_t O_KS = O_CP + 2 * 8 * 3 * 1536;
constexpr size_t O_VS = O_KS + 2 * 32 * 16 * 128;
constexpr size_t O_SS = O_VS + 2 * 32 * 16 * 128;
constexpr size_t O_CS = O_SS + (size_t)2 * 32 * 16 * 64 * 128;
constexpr size_t O_GS = O_CS + 2 * 32 * 3 * 1536;

constexpr size_t WT_IN = 0;
constexpr size_t WT_AO = WT_IN + (size_t)NINP * 1024;
constexpr size_t WT_SO = WT_AO + 1024 * 512;
constexpr size_t WT_GO = WT_SO + 1024 * 1024;
constexpr size_t WT_OUT = WT_GO + 1024 * 512;
constexpr size_t WT_F1 = WT_OUT + 1024 * 1024;
constexpr size_t WT_F2 = WT_F1 + (size_t)4096 * 1024;
constexpr size_t WT_END = WT_F2 + (size_t)1024 * 4096;

constexpr size_t al256(size_t x) { return (x + 255) & ~(size_t)255; }
constexpr size_t W_WT = 0;
constexpr size_t W_MOD = al256(W_WT + WT_END * 2);
constexpr size_t W_ROPE = al256(W_MOD + (size_t)2 * 40 * 6144 * 4);
constexpr size_t W_ROWSS = al256(W_ROPE + (size_t)2064 * 8 * 8);
constexpr size_t W_CNT = al256(W_ROWSS + (size_t)T * 4);
constexpr size_t W_DT = al256(W_CNT + 256);
constexpr size_t W_H = al256(W_DT + (size_t)T * 16 * 4);
constexpr size_t W_Q = al256(W_H + (size_t)T * 1024 * 2);
constexpr size_t W_K = W_Q + (size_t)T * 512 * 2;
constexpr size_t W_V = W_K + (size_t)T * 128 * 2;
constexpr size_t W_Z = W_V + (size_t)T * 128 * 2;
constexpr size_t W_XBC = W_Z + (size_t)T * 1024 * 2;
constexpr size_t W_GU = W_XBC + (size_t)T * 1536 * 2;
constexpr size_t W_GV = W_GU + (size_t)T * 512 * 2;
constexpr size_t W_PAEND = W_GV + (size_t)T * 512 * 2;
constexpr size_t W_FH = W_Q;
constexpr size_t W_G8 = al256(W_PAEND);
constexpr size_t W_END = W_G8 + (size_t)T * 3072;
static_assert((size_t)T * 4096 * 2 <= W_PAEND - W_Q, "FH alias");

constexpr int LDS_BYTES = 131072 + 256;

struct Params {
    const float *x_prompt, *x_sample, *c_prompt, *c_sample, *cache_k, *cache_v, *state_ssm, *state_conv;
    const float *w_ada, *b_ada, *g_mix, *w_in, *sinks, *conv_w, *conv_b, *dt_bias, *a_log, *d_skip, *ssm_norm_w;
    const float *gm_ln_g, *gm_ln_b, *gm_w_s, *gm_b_s, *w_attn_o, *w_ssm_o, *w_gm_o, *w_out, *g_ff, *w_ff1, *w_ff2, *g_final;
    float* out;
    unsigned char* ws;
};

typedef const Params __attribute__((address_space(4)))* KP;
__device__ __forceinline__ KP kparams() { KP q = (KP)__builtin_amdgcn_kernarg_segment_ptr(); asm volatile("" : "+s"(q)); return q; }

__device__ __forceinline__ int tid_() { int t = threadIdx.x; asm volatile("" : "+v"(t)); return t; }
__device__ __forceinline__ unsigned pk2(float lo, float hi) { unsigned r; asm("v_cvt_pk_bf16_f32 %0, %1, %2" : "=v"(r) : "v"(lo), "v"(hi)); return r; }
__device__ __forceinline__ bf16_t f2bf(float f) { return (bf16_t)(pk2(f, 0.f) & 0xffffu); }
__device__ __forceinline__ float bf2f(bf16_t b) { return __uint_as_float(((unsigned)b) << 16); }
__device__ __forceinline__ float bflo(unsigned u) { return __uint_as_float(u << 16); }
__device__ __forceinline__ float bfhi(unsigned u) { return __uint_as_float(u & 0xffff0000u); }
__device__ __forceinline__ float sigm(float x) { return 1.f / (1.f + __expf(-x)); }
__device__ __forceinline__ float siluf_(float x) { return x * sigm(x); }
__device__ __forceinline__ float geluf_(float x) { return x * sigm(1.5957691216057308f * (x + 0.044715f * x * x * x)); }
__device__ __forceinline__ float wave_sum(float v) {
#pragma unroll
    for (int o = 1; o < 64; o <<= 1) v += __shfl_xor(v, o);
    return v;
}
__device__ __forceinline__ f32x4 mfma16(bf16x8 a, bf16x8 b, f32x4 c) { return __builtin_amdgcn_mfma_f32_16x16x32_bf16(a, b, c, 0, 0, 0); }
__device__ __forceinline__ int mod_row(int row) { return row < TP ? (row >> 11) : 8 + ((row - TP) >> 4); }

namespace pg8 {
constexpr int BM = 256, BK = 64, HALF = 128, HTB = HALF * BK * 2, STAGE_BYTES = 8 * HTB, NXCD = 8, WGM = 8;
__device__ __forceinline__ int lds_byte(int r, int c) { const int st = (r >> 4) * 2 + (c >> 5), rr = r & 15, cc = c & 31, ob = rr * 64 + cc * 2; return st * 1024 + (ob ^ (((ob >> 9) & 1) << 5)); }
__device__ __forceinline__ void stage_rc(int b, int& R, int& C) { const int st = b / 1024, sb = b % 1024, swz = sb ^ (((sb >> 9) & 1) << 5); R = (st >> 1) * 16 + swz / 64; C = (st & 1) * 32 + (swz % 64) / 2; }
struct Unit { int pm, pn; };
struct Gemm { const bf16_t* A; const bf16_t* Bt; int M, N, K; };
struct StaticOrder {
    int nM, nN, nwg, G, c;
    __device__ void init(int M, int N, int G_, int c_) { nM = M / BM; nN = N / BM; nwg = nM * nN; G = G_; c = c_; }
    __device__ bool next(int i, Unit& u) const {
        const long L = (long)i * G + c; if (L >= nwg) return false;
        int wgid = (int)L; { const int q = nwg / NXCD, r = nwg % NXCD, xcd = wgid % NXCD, off = wgid / NXCD; wgid = (xcd < r ? xcd * (q + 1) : r * (q + 1) + (xcd - r) * q) + off; }
        const int nig = WGM * nN, gid = wgid / nig, fm = gid * WGM, gsz = (nM - fm) < WGM ? (nM - fm) : WGM;
        u.pm = fm + ((wgid % nig) % gsz); u.pn = (wgid % nig) / gsz; return true;
    }
};
template <class Epi>
__device__ __forceinline__ void gemm_phase(LAS unsigned char* lds, const Gemm g, const StaticOrder& S, const Epi& E) {
    const int tid = tid_(), wid = __builtin_amdgcn_readfirstlane(tid >> 6), lane = tid & 63, wr = wid >> 2, wc = wid & 3, fr = lane & 15, fq = lane >> 4;
    const int K = g.K, nt = K / BK;
    unsigned voffA[2], voffB[2];
#pragma unroll
    for (int i = 0; i < 2; ++i) { int R, C; stage_rc(tid * 16 + i * 8192, R, C); voffA[i] = (unsigned)(R * K + C) * 2u; voffB[i] = voffA[i]; }
    const size_t kstep = (size_t)(BK * 2);
    const size_t hstep = (size_t)HALF * K * 2;
    const size_t tstep = 2 * hstep;
    const unsigned ldsw = (unsigned)wid * 1024u;
    const int aoff = lds_byte(wr * 64 + fr, fq * 8), boff = lds_byte(wc * 32 + fr, fq * 8);
#define PG8_SA(b, h) (((b) * 2 + (h)) * HTB)
#define PG8_SB(b, h) ((4 + (b) * 2 + (h)) * HTB)
#define PG8_STAGE(bufoff, gbase, voff) do { _Pragma("unroll") for (int _i = 0; _i < 2; ++_i) \
        __builtin_amdgcn_global_load_lds((const unsigned*)((const char*)(gbase) + (voff)[_i]), (LAS unsigned*)(lds + (bufoff) + ldsw + _i * 8192), 16, 0, 0); } while (0)
#define PG8_LDA(dst, b, h) do { _Pragma("unroll") for (int m = 0; m < 4; ++m) _Pragma("unroll") for (int k = 0; k < 2; ++k) dst[m][k] = *(const LAS bf16x8*)(lds + PG8_SA(b, h) + aoff + m * 2048 + k * 1024); } while (0)
#define PG8_LDB(dst, b, h) do { _Pragma("unroll") for (int n = 0; n < 2; ++n) _Pragma("unroll") for (int k = 0; k < 2; ++k) dst[n][k] = *(const LAS bf16x8*)(lds + PG8_SB(b, h) + boff + n * 2048 + k * 1024); } while (0)
#define PG8_MMA(ai, bj, At, Bt) do { __builtin_amdgcn_s_setprio(1); _Pragma("unroll") for (int m = 0; m < 4; ++m) _Pragma("unroll") for (int n = 0; n < 2; ++n) _Pragma("unroll") for (int k = 0; k < 2; ++k) \
        acc[ai][bj][m][n] = __builtin_amdgcn_mfma_f32_16x16x32_bf16(Bt[n][k], At[m][k], acc[ai][bj][m][n], 0, 0, 0); __builtin_amdgcn_s_setprio(0); } while (0)
#define PG8_WAIT_V(n) asm volatile("s_waitcnt vmcnt(" #n ")" ::: "memory")
#define PG8_WAIT_L(n) asm volatile("s_waitcnt lgkmcnt(" #n ")" ::: "memory")
#define PG8_BAR __builtin_amdgcn_s_barrier()
#define PG8_SCHED __builtin_amdgcn_sched_barrier(0)
    Unit cur, nxt; int ui = 0;
    if (!S.next(0, cur)) return;
    f32x4 acc[2][2][4][2];
#pragma unroll
    for (int a = 0; a < 2; ++a)
#pragma unroll
        for (int b = 0; b < 2; ++b)
#pragma unroll
            for (int m = 0; m < 4; ++m)
#pragma unroll
                for (int n = 0; n < 2; ++n) acc[a][b][m][n] = (f32x4){0.f, 0.f, 0.f, 0.f};
    bf16x8 At[4][2], B0[2][2], B1[2][2];
    const char* cA = (const char*)g.A + (size_t)cur.pm * tstep; const char* cB = (const char*)g.Bt + (size_t)cur.pn * tstep;
    PG8_STAGE(PG8_SB(0, 0), cB, voffB); PG8_STAGE(PG8_SA(0, 0), cA, voffA); PG8_STAGE(PG8_SB(0, 1), cB + hstep, voffB); PG8_STAGE(PG8_SA(0, 1), cA + hstep, voffA);
    if (wr == 1) PG8_BAR;
    PG8_WAIT_V(4); PG8_BAR;
    PG8_STAGE(PG8_SB(1, 0), cB + kstep, voffB); PG8_STAGE(PG8_SA(1, 0), cA + kstep, voffA); PG8_STAGE(PG8_SB(1, 1), cB + hstep + kstep, voffB);
    PG8_WAIT_V(6); PG8_BAR;
    for (;;) {
        const bool has_next = S.next(ui + 1, nxt);
        const char* nA = has_next ? (const char*)g.A + (size_t)nxt.pm * tstep : cA; const char* nB = has_next ? (const char*)g.Bt + (size_t)nxt.pn * tstep : cB;
        for (int t = 0; t < nt; t += 2) {
            const bool last = (t == nt - 2);
            const char* a1 = cA + (size_t)(t + 1) * kstep;
            const char* a2 = last ? nA : cA + (size_t)(t + 2) * kstep; const char* b2 = last ? nB : cB + (size_t)(t + 2) * kstep;
            const char* a3 = a2 + kstep; const char* b3 = b2 + kstep;
            PG8_LDB(B0, 0, 0); PG8_SCHED; PG8_LDA(At, 0, 0); PG8_STAGE(PG8_SA(1, 1), a1 + hstep, voffA);
            PG8_WAIT_L(8); PG8_BAR; PG8_WAIT_L(0); PG8_MMA(0, 0, At, B0); PG8_BAR; PG8_SCHED;
            PG8_LDB(B1, 0, 1); PG8_STAGE(PG8_SB(0, 0), b2, voffB);
            PG8_BAR; PG8_WAIT_L(0); PG8_MMA(0, 1, At, B1); PG8_BAR;
            PG8_LDA(At, 0, 1); PG8_STAGE(PG8_SA(0, 0), a2, voffA);
            PG8_BAR; PG8_WAIT_L(0); PG8_MMA(1, 0, At, B0); PG8_BAR; PG8_SCHED;
            PG8_STAGE(PG8_SB(0, 1), b2 + hstep, voffB);
            PG8_WAIT_V(6); PG8_BAR; PG8_MMA(1, 1, At, B1); PG8_BAR;
            PG8_LDB(B0, 1, 0); PG8_SCHED; PG8_LDA(At, 1, 0); PG8_STAGE(PG8_SA(0, 1), a2 + hstep, voffA);
            PG8_WAIT_L(8); PG8_BAR; PG8_WAIT_L(0); PG8_MMA(0, 0, At, B0); PG8_BAR; PG8_SCHED;
            PG8_LDB(B1, 1, 1); PG8_STAGE(PG8_SB(1, 0), b3, voffB);
            PG8_BAR; PG8_WAIT_L(0); PG8_MMA(0, 1, At, B1); PG8_BAR;
            PG8_LDA(At, 1, 1); PG8_STAGE(PG8_SA(1, 0), a3, voffA);
            PG8_BAR; PG8_WAIT_L(0); PG8_MMA(1, 0, At, B0); PG8_BAR; PG8_SCHED;
            PG8_STAGE(PG8_SB(1, 1), b3 + hstep, voffB);
            PG8_WAIT_V(6); PG8_BAR; PG8_MMA(1, 1, At, B1); PG8_BAR;
        }
        E(acc, cur, wr, wc, fr, fq);
        if (!has_next) break;
#pragma unroll
        for (int a = 0; a < 2; ++a)
#pragma unroll
            for (int b = 0; b < 2; ++b)
#pragma unroll
                for (int m = 0; m < 4; ++m)
#pragma unroll
                    for (int n = 0; n < 2; ++n) acc[a][b][m][n] = (f32x4){0.f, 0.f, 0.f, 0.f};
        cur = nxt; cA = nA; cB = nB; ++ui;
    }
    PG8_WAIT_V(0);
    if (wr == 0) PG8_BAR;
    PG8_BAR;
#undef PG8_SA
#undef PG8_SB
#undef PG8_STAGE
#undef PG8_LDA
#undef PG8_LDB
#undef PG8_MMA
#undef PG8_WAIT_V
#undef PG8_WAIT_L
#undef PG8_BAR
#undef PG8_SCHED
}
}

template <class F> struct EpiRC {
    F f;
    __device__ __forceinline__ void operator()(const f32x4 (&acc)[2][2][4][2], const pg8::Unit& u, int wr, int wc, int fr, int fq) const {
        const int row0 = u.pm * 256 + wr * 64 + fr, col0 = u.pn * 256 + wc * 32 + 4 * fq;
#pragma unroll
        for (int ai = 0; ai < 2; ++ai)
#pragma unroll
            for (int m = 0; m < 4; ++m)
#pragma unroll
                for (int bj = 0; bj < 2; ++bj)
#pragma unroll
                    for (int n = 0; n < 2; ++n) f(row0 + ai * 128 + m * 16, col0 + bj * 128 + n * 16, acc[ai][bj][m][n]);
    }
};

template <class F>
__device__ __forceinline__ void skinny_gemm(unsigned char* shm, const bf16_t* A, const bf16_t* Bt, int N, int K, const F& f) {
    const int tid = tid_(), w = tid >> 6, lane = tid & 63, fr = lane & 15, fq = lane >> 4;
    f32x4* red = (f32x4*)shm;
    const int nun = 16 * (N / 64), kw = K / 8;
    for (int u = blockIdx.x; u < nun; u += gridDim.x) {
        const int m0 = (u & 15) * 32, n0 = (u >> 4) * 64;
        f32x4 acc[2][4];
#pragma unroll
        for (int i = 0; i < 2; ++i)
#pragma unroll
            for (int j = 0; j < 4; ++j) acc[i][j] = (f32x4){0.f, 0.f, 0.f, 0.f};
        const bf16_t* ap = A + (size_t)(m0 + fr) * K + w * kw + fq * 8;
        const bf16_t* bp = Bt + (size_t)(n0 + fr) * K + w * kw + fq * 8;
#pragma unroll 2
        for (int k = 0; k < kw; k += 32) {
            bf16x8 a[2], b[4];
#pragma unroll
            for (int i = 0; i < 2; ++i) a[i] = *(const bf16x8*)(ap + (size_t)i * 16 * K + k);
#pragma unroll
            for (int j = 0; j < 4; ++j) b[j] = *(const bf16x8*)(bp + (size_t)j * 16 * K + k);
#pragma unroll
            for (int i = 0; i < 2; ++i)
#pragma unroll
                for (int j = 0; j < 4; ++j) acc[i][j] = mfma16(b[j], a[i], acc[i][j]);
        }
        __syncthreads();
#pragma unroll
        for (int i = 0; i < 2; ++i)
#pragma unroll
            for (int j = 0; j < 4; ++j) red[(w * 8 + i * 4 + j) * 64 + lane] = acc[i][j];
        __syncthreads();
        f32x4 s = red[w * 64 + lane];
#pragma unroll
        for (int q = 1; q < 8; ++q) s += red[(q * 8 + w) * 64 + lane];
        f(TP + m0 + (w >> 2) * 16 + fr, n0 + (w & 3) * 16 + fq * 4, s);
    }
    __syncthreads();
}

struct EpiIn {
    int l; KP pp;
    __device__ __forceinline__ void operator()(const f32x4 (&acc)[2][2][4][2], const pg8::Unit& u, int wr, int wc, int fr, int fq) const {
        const KP p = pp;
        unsigned char* ws = p->ws;
        const int pn = u.pn;
        const int row0 = u.pm * 256 + wr * 64 + fr;
        const int ct0 = wc * 32 + 4 * fq;
        if (pn < 3) {
            bf16_t* Qb = (bf16_t*)(ws + W_Q); bf16_t* Kb = (bf16_t*)(ws + W_K); bf16_t* Vb = (bf16_t*)(ws + W_V);
            const f32x2* rope = (const f32x2*)(ws + W_ROPE);
#pragma unroll
            for (int ai = 0; ai < 2; ++ai)
#pragma unroll
                for (int m = 0; m < 4; ++m) {
                    const int row = row0 + ai * 128 + m * 16;
                    const bool samp = row >= TP;
                    const int b = samp ? (row - TP) >> 4 : row >> 11, t = samp ? (row - TP) & 15 : row & 2047;
                    const int pi = samp ? 2048 + t : t;
#pragma unroll
                    for (int bj = 0; bj < 2; ++bj)
#pragma unroll
                        for (int n = 0; n < 2; ++n) {
                            f32x4 v = acc[ai][bj][m][n];
                            const int ct = bj * 128 + ct0 + n * 16;
                            const bool isv = (pn == 2) && (bj == 1);
                            if (!isv && n == 0 && (wc & 1) == 0) {
                                f32x4 o;
                                o[0] = __shfl_xor(v[0], 32); o[1] = __shfl_xor(v[1], 32); o[2] = __shfl_xor(v[2], 32); o[3] = __shfl_xor(v[3], 32);
                                const f32x4* cs = (const f32x4*)(rope + pi * 8 + 4 * (fq & 1));
                                const f32x4 c01 = cs[0], c23 = cs[1];
                                const float sgn = (fq < 2) ? -1.f : 1.f;
                                v[0] = v[0] * c01[0] + sgn * o[0] * c01[1];
                                v[1] = v[1] * c01[2] + sgn * o[1] * c01[3];
                                v[2] = v[2] * c23[0] + sgn * o[2] * c23[1];
                                v[3] = v[3] * c23[2] + sgn * o[3] * c23[3];
                            }
                            u32x2 pk; pk.x = pk2(v[0], v[1]); pk.y = pk2(v[2], v[3]);
                            if (pn < 2) { *(u32x2*)(Qb + (size_t)row * 512 + pn * 256 + ct) = pk; }
                            else {
                                const int c = ct & 127;
                                bf16_t* dst = isv ? Vb : Kb;
                                *(u32x2*)(dst + (size_t)row * 128 + c) = pk;
                                if (samp) {
                                    float* o = p->out + (isv ? O_VS : O_KS) + ((size_t)(l * 32 + b) * 16 + t) * 128 + c;
                                    *(f32x4*)o = v;
                                } else if (t >= 1920) {
                                    float* o = p->out + (isv ? O_VP : O_KP) + ((size_t)(l * 8 + b) * 128 + (t - 1920)) * 128 + c;
                                    *(f32x4*)o = v;
                                }
                            }
                        }
                }
        } else if (pn < 7) {
            bf16_t* Zb = (bf16_t*)(ws + W_Z);
#pragma unroll
            for (int ai = 0; ai < 2; ++ai)
#pragma unroll
                for (int m = 0; m < 4; ++m) {
                    const int row = row0 + ai * 128 + m * 16;
#pragma unroll
                    for (int bj = 0; bj < 2; ++bj)
#pragma unroll
                        for (int n = 0; n < 2; ++n) {
                            const f32x4 v = acc[ai][bj][m][n];
                            u32x2 pk; pk.x = pk2(v[0], v[1]); pk.y = pk2(v[2], v[3]);
                            *(u32x2*)(Zb + (size_t)row * 1024 + (pn - 3) * 256 + bj * 128 + ct0 + n * 16) = pk;
                        }
                }
        } else if (pn < 13) {
            bf16_t* Xb = (bf16_t*)(ws + W_XBC);
#pragma unroll
            for (int ai = 0; ai < 2; ++ai)
#pragma unroll
                for (int m = 0; m < 4; ++m) {
                    const int row = row0 + ai * 128 + m * 16;
                    const bool samp = row >= TP;
                    const int b = samp ? (row - TP) >> 4 : row >> 11, t = samp ? (row - TP) & 15 : row & 2047;
#pragma unroll
                    for (int bj = 0; bj < 2; ++bj)
#pragma unroll
                        for (int n = 0; n < 2; ++n) {
                            const f32x4 v = acc[ai][bj][m][n];
                            const int cc = (pn - 7) * 256 + bj * 128 + ct0 + n * 16;
                            u32x2 pk; pk.x = pk2(v[0], v[1]); pk.y = pk2(v[2], v[3]);
                            *(u32x2*)(Xb + (size_t)row * 1536 + cc) = pk;
                            if (samp) { if (t >= 13) *(f32x4*)(p->out + O_CS + ((size_t)(l * 32 + b) * 3 + (t - 13)) * 1536 + cc) = v; }
                            else if (t >= 2045) *(f32x4*)(p->out + O_CP + ((size_t)(l * 8 + b) * 3 + (t - 2045)) * 1536 + cc) = v;
                        }
                }
        } else if (pn < 17) {
            bf16_t* dst = (bf16_t*)(ws + (pn < 15 ? W_GU : W_GV));
            const int cb = ((pn - 13) & 1) * 256;
#pragma unroll
            for (int ai = 0; ai < 2; ++ai)
#pragma unroll
                for (int m = 0; m < 4; ++m) {
                    const int row = row0 + ai * 128 + m * 16;
#pragma unroll
                    for (int bj = 0; bj < 2; ++bj)
#pragma unroll
                        for (int n = 0; n < 2; ++n) {
                            const f32x4 v = acc[ai][bj][m][n];
                            u32x2 pk; pk.x = pk2(geluf_(v[0]), geluf_(v[1])); pk.y = pk2(geluf_(v[2]), geluf_(v[3]));
                            *(u32x2*)(dst + (size_t)row * 512 + cb + bj * 128 + ct0 + n * 16) = pk;
                        }
                }
        } else if (pn < 29) {
            unsigned char* G8 = ws + W_G8;
#pragma unroll
            for (int ai = 0; ai < 2; ++ai)
#pragma unroll
                for (int m = 0; m < 4; ++m) {
                    const int row = row0 + ai * 128 + m * 16;
#pragma unroll
                    for (int bj = 0; bj < 2; ++bj)
#pragma unroll
                        for (int n = 0; n < 2; ++n) {
                            const f32x4 v = acc[ai][bj][m][n];
                            const unsigned q0 = (unsigned)(sigm(v[0]) * 255.f + 0.5f), q1 = (unsigned)(sigm(v[1]) * 255.f + 0.5f);
                            const unsigned q2 = (unsigned)(sigm(v[2]) * 255.f + 0.5f), q3 = (unsigned)(sigm(v[3]) * 255.f + 0.5f);
                            *(unsigned*)(G8 + (size_t)row * 3072 + (pn - 17) * 256 + bj * 128 + ct0 + n * 16) = q0 | (q1 << 8) | (q2 << 16) | (q3 << 24);
                        }
                }
        } else {
            if (wc == 0) {
                float* DT = (float*)(ws + W_DT);
                const f32x4 bias = *(const f32x4*)(p->dt_bias + l * 16 + 4 * fq);
#pragma unroll
                for (int ai = 0; ai < 2; ++ai)
#pragma unroll
                    for (int m = 0; m < 4; ++m) {
                        const int row = row0 + ai * 128 + m * 16;
                        f32x4 v = acc[ai][0][m][0] + bias;
#pragma unroll
                        for (int e = 0; e < 4; ++e) { const float x = v[e]; v[e] = fmaxf(x, 0.f) + log1pf(__expf(-fabsf(x))); }
                        *(f32x4*)(DT + (size_t)row * 16 + 4 * fq) = v;
                    }
            }
        }
    }
};

struct FMerge {
    int b; const unsigned char* G8; const float* rowss; bf16_t* MG;
    __device__ __forceinline__ void operator()(int row, int col, f32x4 v) const {
        const unsigned g = *(const unsigned*)(G8 + (size_t)row * 3072 + b * 1024 + col);
        float sc = 1.f / 255.f;
        if (b == 1) sc *= rsqrtf(rowss[row] * (1.f / 1024.f) + EPSF);
        f32x4 r;
        r[0] = (float)(g & 255u) * sc * v[0]; r[1] = (float)((g >> 8) & 255u) * sc * v[1];
        r[2] = (float)((g >> 16) & 255u) * sc * v[2]; r[3] = (float)(g >> 24) * sc * v[3];
        u32x2* dst = (u32x2*)(MG + (size_t)row * 1024 + col);
        if (b > 0) { const u32x2 o = *dst; r[0] += bflo(o.x); r[1] += bfhi(o.x); r[2] += bflo(o.y); r[3] += bfhi(o.y); }
        u32x2 pk; pk.x = pk2(r[0], r[1]); pk.y = pk2(r[2], r[3]);
        *dst = pk;
    }
};
struct FResid {
    const float* srcP; const float* srcS; float* X; const float* modg;
    __device__ __forceinline__ void operator()(int row, int col, f32x4 v) const {
        const float* s = row < TP ? srcP + (size_t)row * 1024 + col : srcS + (size_t)(row - TP) * 1024 + col;
        const f32x4 x = *(const f32x4*)s;
        const f32x4 g = *(const f32x4*)(modg + (size_t)mod_row(row) * 6144 + col);
        *(f32x4*)(X + (size_t)row * 1024 + col) = x + g * v;
    }
};
struct FRelu2 {
    bf16_t* FH;
    __device__ __forceinline__ void operator()(int row, int col, f32x4 v) const {
        f32x4 r; r[0] = fmaxf(v[0], 0.f); r[1] = fmaxf(v[1], 0.f); r[2] = fmaxf(v[2], 0.f); r[3] = fmaxf(v[3], 0.f);
        u32x2 pk; pk.x = pk2(r[0] * r[0], r[1] * r[1]); pk.y = pk2(r[2] * r[2], r[3] * r[3]);
        *(u32x2*)(FH + (size_t)row * 4096 + col) = pk;
    }
};

__device__ __forceinline__ void phase_mod(KP p, float* lds) {
    float* sc = lds;
    float* red = lds + 20480;
    float* MOD = (float*)(p->ws + W_MOD);
    const int tid = tid_();
    for (int u = blockIdx.x; u < 384; u += gridDim.x) {
        const int rh = u & 1, cgp = (u >> 1) % 96, l = u / 192;
        __syncthreads();
        for (int idx = tid; idx < 20480; idx += 512) {
            const int r = idx >> 10, k = idx & 1023, gr = rh * 20 + r;
            const float c = gr < 8 ? p->c_prompt[gr * 1024 + k] : p->c_sample[(gr - 8) * 1024 + k];
            sc[k * 20 + r] = siluf_(c);
        }
        __syncthreads();
        const int cn = tid & 63, ks = tid >> 6, n = cgp * 64 + cn;
        float acc[20];
#pragma unroll
        for (int r = 0; r < 20; ++r) acc[r] = 0.f;
        const float* w = p->w_ada + (size_t)l * 1024 * 6144 + n;
#pragma unroll 4
        for (int k = ks * 128; k < ks * 128 + 128; ++k) {
            const float wv = w[(size_t)k * 6144];
            const f32x4* s4 = (const f32x4*)(sc + k * 20);
#pragma unroll
            for (int q = 0; q < 5; ++q) { const f32x4 s = s4[q]; acc[4 * q] += s[0] * wv; acc[4 * q + 1] += s[1] * wv; acc[4 * q + 2] += s[2] * wv; acc[4 * q + 3] += s[3] * wv; }
        }
#pragma unroll
        for (int r = 0; r < 20; ++r) red[(ks * 20 + r) * 64 + cn] = acc[r];
        __syncthreads();
        for (int idx = tid; idx < 1280; idx += 512) {
            const int r = idx >> 6, c2 = idx & 63, n2 = cgp * 64 + c2;
            float s = 0.f;
#pragma unroll
            for (int k8 = 0; k8 < 8; ++k8) s += red[(k8 * 20 + r) * 64 + c2];
            MOD[((size_t)l * 40 + rh * 20 + r) * 6144 + n2] = s + p->b_ada[l * 6144 + n2];
        }
    }
    __syncthreads();
}

__device__ __forceinline__ void convert_weights(KP p, int l, float* tile) {
    bf16_t* WT = (bf16_t*)(p->ws + W_WT);
    const int tid = tid_();
    for (int it = blockIdx.x; it < 4736; it += gridDim.x) {
        const float* src; bf16_t* dst; int K, Ns, nT, mode = 0; int r = it;
        if (r < 1920) { src = p->w_in + (size_t)l * 1024 * 7440; K = 1024; Ns = 7440; nT = 120; dst = WT + WT_IN; mode = 1; }
        else if ((r -= 1920) < 128) { src = p->w_attn_o + (size_t)l * 512 * 1024; K = 512; Ns = 1024; nT = 16; dst = WT + WT_AO; }
        else if ((r -= 128) < 256) { src = p->w_ssm_o + (size_t)l * 1024 * 1024; K = 1024; Ns = 1024; nT = 16; dst = WT + WT_SO; mode = 2; }
        else if ((r -= 256) < 128) { src = p->w_gm_o + (size_t)l * 512 * 1024; K = 512; Ns = 1024; nT = 16; dst = WT + WT_GO; }
        else if ((r -= 128) < 256) { src = p->w_out + (size_t)l * 1024 * 1024; K = 1024; Ns = 1024; nT = 16; dst = WT + WT_OUT; }
        else if ((r -= 256) < 1024) { src = p->w_ff1 + (size_t)l * 1024 * 4096; K = 1024; Ns = 4096; nT = 64; dst = WT + WT_F1; }
        else { r -= 1024; src = p->w_ff2 + (size_t)l * 4096 * 1024; K = 4096; Ns = 1024; nT = 16; dst = WT + WT_F2; }
        const int nt = r % nT, kt = r / nT, n0 = nt * 64, k0 = kt * 64;
        __syncthreads();
        {
            const int nn = tid & 63, ns = n0 + nn; int sc_ = ns; bool zero = false;
            if (mode == 1) { if (ns < 3328) sc_ = ns; else if (ns < 7424) sc_ = ns + 16; else if (ns < 7440) sc_ = ns - 7424 + 3328; else { zero = true; sc_ = 0; } }
#pragma unroll
            for (int i = 0; i < 8; ++i) {
                const int kk = (tid >> 6) + 8 * i;
                float v = zero ? 0.f : src[(size_t)(k0 + kk) * Ns + sc_];
                if (mode == 2) v *= p->ssm_norm_w[l * 1024 + k0 + kk];
                tile[kk * 65 + nn] = v;
            }
        }
        __syncthreads();
        {
            const int nr = tid >> 3, kc = (tid & 7) * 8;
            u32x4 o;
            o.x = pk2(tile[(kc + 0) * 65 + nr], tile[(kc + 1) * 65 + nr]);
            o.y = pk2(tile[(kc + 2) * 65 + nr], tile[(kc + 3) * 65 + nr]);
            o.z = pk2(tile[(kc + 4) * 65 + nr], tile[(kc + 5) * 65 + nr]);
            o.w = pk2(tile[(kc + 6) * 65 + nr], tile[(kc + 7) * 65 + nr]);
            *(u32x4*)(dst + (size_t)(n0 + nr) * K + k0 + kc) = o;
        }
    }
    __syncthreads();
}

__device__ __forceinline__ void phase_norm(KP p, int l, const float* srcP, const float* srcS, const float* gvec, int shift_idx) {
    const int tid = tid_(), lane = tid & 63, gw = blockIdx.x * 8 + (tid >> 6), ngw = gridDim.x * 8;
    const float* MOD = (const float*)(p->ws + W_MOD);
    bf16_t* H = (bf16_t*)(p->ws + W_H);
    for (int row = gw; row < T; row += ngw) {
        const float* xr = row < TP ? srcP + (size_t)row * 1024 : srcS + (size_t)(row - TP) * 1024;
        const float* md = MOD + ((size_t)l * 40 + mod_row(row)) * 6144 + shift_idx * 1024;
        f32x4 v[4]; float ss = 0.f;
#pragma unroll
        for (int j = 0; j < 4; ++j) { v[j] = ((const f32x4*)xr)[lane + 64 * j]; ss += v[j][0] * v[j][0] + v[j][1] * v[j][1] + v[j][2] * v[j][2] + v[j][3] * v[j][3]; }
        ss = wave_sum(ss);
        const float rstd = rsqrtf(ss * (1.f / 1024.f) + EPSF);
#pragma unroll
        for (int j = 0; j < 4; ++j) {
            const int c4 = lane + 64 * j;
            const f32x4 g = ((const f32x4*)gvec)[c4], sh = ((const f32x4*)md)[c4], sc = ((const f32x4*)(md + 1024))[c4];
            f32x4 h;
#pragma unroll
            for (int e = 0; e < 4; ++e) h[e] = (v[j][e] * rstd * g[e]) * (1.f + sc[e]) + sh[e];
            u32x2 pk; pk.x = pk2(h[0], h[1]); pk.y = pk2(h[2], h[3]);
            *(u32x2*)(H + (size_t)row * 1024 + c4 * 4) = pk;
        }
    }
}

template <int NMT>
__device__ __forceinline__ void attn_compute(const bf16_t* Ks, const bf16_t* VT, bf16_t* qo, int kt0, int kt1, int nkeys, float sink, int lane) {
    const int fr = lane & 15, fq = lane >> 4;
    bf16x8 qf[NMT][2];
#pragma unroll
    for (int mt = 0; mt < NMT; ++mt)
#pragma unroll
        for (int ks = 0; ks < 2; ++ks) qf[mt][ks] = *(const bf16x8*)(qo + (size_t)(mt * 16 + fr) * 512 + ks * 32 + fq * 8);
    f32x4 s[12][NMT];
#pragma unroll
    for (int kt = 0; kt < 12; ++kt) {
#pragma unroll
        for (int mt = 0; mt < NMT; ++mt) s[kt][mt] = (f32x4){0.f, 0.f, 0.f, 0.f};
        if (kt >= kt0 && kt < kt1) {
#pragma unroll
            for (int ks = 0; ks < 2; ++ks) {
                const bf16x8 kf = *(const bf16x8*)(Ks + (kt * 16 + fr) * 72 + ks * 32 + fq * 8);
#pragma unroll
                for (int mt = 0; mt < NMT; ++mt) s[kt][mt] = mfma16(kf, qf[mt][ks], s[kt][mt]);
            }
        }
    }
    float inv[NMT];
#pragma unroll
    for (int mt = 0; mt < NMT; ++mt) {
        float mx = -INFINITY;
#pragma unroll
        for (int kt = 0; kt < 12; ++kt)
            if (kt >= kt0 && kt < kt1) {
#pragma unroll
                for (int j = 0; j < 4; ++j) { const int key = kt * 16 + fq * 4 + j; const float v = key < nkeys ? s[kt][mt][j] * 0.125f : -INFINITY; s[kt][mt][j] = v; mx = fmaxf(mx, v); }
            }
        mx = fmaxf(mx, __shfl_xor(mx, 16)); mx = fmaxf(mx, __shfl_xor(mx, 32)); mx = fmaxf(mx, sink);
        float sum = 0.f;
#pragma unroll
        for (int kt = 0; kt < 12; ++kt)
            if (kt >= kt0 && kt < kt1) {
#pragma unroll
                for (int j = 0; j < 4; ++j) { const float e = __expf(s[kt][mt][j] - mx); s[kt][mt][j] = e; sum += e; }
            }
        sum += __shfl_xor(sum, 16); sum += __shfl_xor(sum, 32);
        inv[mt] = 1.f / (sum + __expf(sink - mx));
    }
    f32x4 o[4][NMT];
#pragma unroll
    for (int dt = 0; dt < 4; ++dt)
#pragma unroll
        for (int mt = 0; mt < NMT; ++mt) o[dt][mt] = (f32x4){0.f, 0.f, 0.f, 0.f};
#pragma unroll
    for (int kb = 0; kb < 6; ++kb) {
        if (2 * kb >= kt0 && 2 * kb < kt1) {
            bf16x8 pf[NMT];
#pragma unroll
            for (int mt = 0; mt < NMT; ++mt) {
                const f32x4 a = s[2 * kb][mt], b = s[2 * kb + 1][mt];
                u32x4 t; t.x = pk2(a[0], a[1]); t.y = pk2(a[2], a[3]); t.z = pk2(b[0], b[1]); t.w = pk2(b[2], b[3]);
                pf[mt] = __builtin_bit_cast(bf16x8, t);
            }
#pragma unroll
            for (int dt = 0; dt < 4; ++dt) {
                const u32x2 lo = *(const u32x2*)(VT + (dt * 16 + fr) * 200 + kb * 32 + fq * 4);
                const u32x2 hi = *(const u32x2*)(VT + (dt * 16 + fr) * 200 + kb * 32 + 16 + fq * 4);
                u32x4 t; t.x = lo.x; t.y = lo.y; t.z = hi.x; t.w = hi.y;
                const bf16x8 vf = __builtin_bit_cast(bf16x8, t);
#pragma unroll
                for (int mt = 0; mt < NMT; ++mt) o[dt][mt] = mfma16(vf, pf[mt], o[dt][mt]);
            }
        }
    }
#pragma unroll
    for (int mt = 0; mt < NMT; ++mt)
#pragma unroll
        for (int dt = 0; dt < 4; ++dt) {
            const f32x4 v = o[dt][mt] * inv[mt];
            u32x2 pk; pk.x = pk2(v[0], v[1]); pk.y = pk2(v[2], v[3]);
            *(u32x2*)(qo + (size_t)(mt * 16 + fr) * 512 + dt * 16 + fq * 4) = pk;
        }
}

__device__ __forceinline__ void scatter_vt(bf16_t* VT, int ch, int kk, u32x4 vv) {
    bf16_t* d = VT + (ch * 8) * 200 + kk;
    d[0 * 200] = (bf16_t)(vv.x & 0xffffu); d[1 * 200] = (bf16_t)(vv.x >> 16);
    d[2 * 200] = (bf16_t)(vv.y & 0xffffu); d[3 * 200] = (bf16_t)(vv.y >> 16);
    d[4 * 200] = (bf16_t)(vv.z & 0xffffu); d[5 * 200] = (bf16_t)(vv.z >> 16);
    d[6 * 200] = (bf16_t)(vv.w & 0xffffu); d[7 * 200] = (bf16_t)(vv.w >> 16);
}

__device__ __forceinline__ void attn_prompt_item(KP p, int l, int it, unsigned char* shm) {
    const int tid = tid_(), w = tid >> 6, lane = tid & 63;
    const int b = it >> 6, c = (it >> 1) & 31, kvh = it & 1;
    bf16_t* Ks = (bf16_t*)shm; bf16_t* VT = Ks + 192 * 72;
    bf16_t* Qb = (bf16_t*)(p->ws + W_Q); const bf16_t* Kb = (const bf16_t*)(p->ws + W_K); const bf16_t* Vb = (const bf16_t*)(p->ws + W_V);
    const int kt0 = c >= 2 ? 0 : (2 - c) * 4;
    __syncthreads();
    for (int idx = tid; idx < 1536; idx += 512) {
        const int kk = idx >> 3, ch = idx & 7;
        if (kk >= kt0 * 16) {
            const size_t row = (size_t)b * 2048 + (c - 2) * 64 + kk;
            const u32x4 kv = *(const u32x4*)(Kb + row * 128 + kvh * 64 + ch * 8);
            const u32x4 vv = *(const u32x4*)(Vb + row * 128 + kvh * 64 + ch * 8);
            *(u32x4*)(Ks + kk * 72 + ch * 8) = kv;
            scatter_vt(VT, ch, kk, vv);
        }
    }
    __syncthreads();
    const int g = w >> 1, q0 = (w & 1) * 32, hq = kvh * 4 + g;
    attn_compute<2>(Ks, VT, Qb + ((size_t)b * 2048 + c * 64 + q0) * 512 + hq * 64, kt0, 12, 192, p->sinks[l * 8 + hq], lane);
}

__device__ __forceinline__ void attn_sample_item(KP p, int l, int it, unsigned char* shm) {
    const int tid = tid_(), w = tid >> 6, lane = tid & 63;
    const int sb = it >> 1, kvh = it & 1;
    bf16_t* Ks = (bf16_t*)shm; bf16_t* VT = Ks + 192 * 72;
    bf16_t* Qb = (bf16_t*)(p->ws + W_Q); const bf16_t* Kb = (const bf16_t*)(p->ws + W_K); const bf16_t* Vb = (const bf16_t*)(p->ws + W_V);
    __syncthreads();
    for (int idx = tid; idx < 160 * 8; idx += 512) {
        const int kk = idx >> 3, ch = idx & 7;
        u32x4 kv, vv;
        if (kk < 128) {
            const size_t o = ((((size_t)l * 32 + sb) * 128 + kk) * 2 + kvh) * 64 + ch * 8;
            const f32x4 k0 = *(const f32x4*)(p->cache_k + o), k1 = *(const f32x4*)(p->cache_k + o + 4);
            const f32x4 v0 = *(const f32x4*)(p->cache_v + o), v1 = *(const f32x4*)(p->cache_v + o + 4);
            kv.x = pk2(k0[0], k0[1]); kv.y = pk2(k0[2], k0[3]); kv.z = pk2(k1[0], k1[1]); kv.w = pk2(k1[2], k1[3]);
            vv.x = pk2(v0[0], v0[1]); vv.y = pk2(v0[2], v0[3]); vv.z = pk2(v1[0], v1[1]); vv.w = pk2(v1[2], v1[3]);
        } else if (kk < 144) {
            const size_t row = (size_t)TP + sb * 16 + (kk - 128);
            kv = *(const u32x4*)(Kb + row * 128 + kvh * 64 + ch * 8);
            vv = *(const u32x4*)(Vb + row * 128 + kvh * 64 + ch * 8);
        } else { kv = (u32x4){0u, 0u, 0u, 0u}; vv = kv; }
        *(u32x4*)(Ks + kk * 72 + ch * 8) = kv;
        scatter_vt(VT, ch, kk, vv);
    }
    __syncthreads();
    if (w < 4) {
        const int hq = kvh * 4 + w;
        attn_compute<1>(Ks, VT, Qb + ((size_t)TP + sb * 16) * 512 + hq * 64, 0, 10, 144, p->sinks[l * 8 + hq], lane);
    }
}

__device__ __forceinline__ void gmlp_item(KP p, int l, bool samp, int bi, int cidx, int g, unsigned char* shm) {
    const int tid = tid_(), w = tid >> 6, lane = tid & 63, fr = lane & 15, fq = lane >> 4;
    bf16_t* Wm = (bf16_t*)shm; bf16_t* VT = Wm + 128 * 136;
    const int L = samp ? 16 : 128;
    const int row0 = samp ? TP + bi * 16 : bi * 2048 + cidx * 128;
    bf16_t* GUb = (bf16_t*)(p->ws + W_GU); const bf16_t* GVb = (const bf16_t*)(p->ws + W_GV);
    __syncthreads();
    if (samp) {
        { const int idx = tid * 8, d = idx >> 5, s = idx & 31; *(u32x4*)(VT + d * 136 + s) = (u32x4){0u, 0u, 0u, 0u}; }
        if (tid < 128) {
            const int t = tid >> 3, s4 = (tid & 7) * 4;
            f32x4 wv = (f32x4){0.f, 0.f, 0.f, 0.f};
            if (s4 < 16) wv = *(const f32x4*)(p->gm_w_s + ((size_t)(l * 4 + g) * 128 + t) * 128 + s4);
#pragma unroll
            for (int e = 0; e < 4; ++e) if (s4 + e > t) wv[e] = 0.f;
            u32x2 pk; pk.x = pk2(wv[0], wv[1]); pk.y = pk2(wv[2], wv[3]);
            *(u32x2*)(Wm + t * 136 + s4) = pk;
        }
        __syncthreads();
    } else {
        for (int idx = tid; idx < 128 * 32; idx += 512) {
            const int t = idx >> 5, s4 = (idx & 31) * 4;
            f32x4 wv = *(const f32x4*)(p->gm_w_s + ((size_t)(l * 4 + g) * 128 + t) * 128 + s4);
#pragma unroll
            for (int e = 0; e < 4; ++e) if (s4 + e > t) wv[e] = 0.f;
            u32x2 pk; pk.x = pk2(wv[0], wv[1]); pk.y = pk2(wv[2], wv[3]);
            *(u32x2*)(Wm + t * 136 + s4) = pk;
        }
    }
    if (w * 16 < L) {
        for (int r = 0; r < 16; ++r) {
            const int row = row0 + w * 16 + r;
            const u32x4 raw = *(const u32x4*)(GVb + (size_t)row * 512 + lane * 8);
            float v[8];
            v[0] = bflo(raw.x); v[1] = bfhi(raw.x); v[2] = bflo(raw.y); v[3] = bfhi(raw.y); v[4] = bflo(raw.z); v[5] = bfhi(raw.z); v[6] = bflo(raw.w); v[7] = bfhi(raw.w);
            float s = 0.f;
#pragma unroll
            for (int e = 0; e < 8; ++e) s += v[e];
            const float mean = wave_sum(s) * (1.f / 512.f);
            float s2 = 0.f;
#pragma unroll
            for (int e = 0; e < 8; ++e) { v[e] -= mean; s2 += v[e] * v[e]; }
            const float rstd = rsqrtf(wave_sum(s2) * (1.f / 512.f) + EPSF);
            if (fq == g) {
#pragma unroll
                for (int e = 0; e < 8; ++e) {
                    const int d = fr * 8 + e, col = g * 128 + d;
                    const float vn = v[e] * rstd * p->gm_ln_g[l * 512 + col] + p->gm_ln_b[l * 512 + col];
                    VT[d * 136 + w * 16 + r] = f2bf(vn);
                    if (samp) p->out[O_GS + ((size_t)(l * 32 + bi) * 16 + r) * 512 + col] = vn;
                }
            }
        }
    }
    __syncthreads();
    if (w * 16 < L) {
        f32x4 acc[8];
#pragma unroll
        for (int dt = 0; dt < 8; ++dt) acc[dt] = (f32x4){0.f, 0.f, 0.f, 0.f};
        const int nks = samp ? 1 : ((w * 16 + 15) >> 5) + 1;
#pragma unroll
        for (int ks = 0; ks < 4; ++ks) {
            if (ks < nks) {
                const bf16x8 wf = *(const bf16x8*)(Wm + (w * 16 + fr) * 136 + ks * 32 + fq * 8);
#pragma unroll
                for (int dt = 0; dt < 8; ++dt) {
                    const bf16x8 vf = *(const bf16x8*)(VT + (dt * 16 + fr) * 136 + ks * 32 + fq * 8);
                    acc[dt] = mfma16(wf, vf, acc[dt]);
                }
            }
        }
#pragma unroll
        for (int j = 0; j < 4; ++j) {
            const int t = w * 16 + fq * 4 + j;
            const float bias = p->gm_b_s[(l * 4 + g) * 128 + t];
#pragma unroll
            for (int dt = 0; dt < 8; ++dt) {
                const size_t idx = (size_t)(row0 + t) * 512 + g * 128 + dt * 16 + fr;
                const float u = bf2f(GUb[idx]);
                GUb[idx] = f2bf(u * (acc[dt][j] + bias));
            }
        }
    }
}

__device__ __forceinline__ void ssd_item(KP p, int l, bool samp, int bi, int h, unsigned char* shm) {
    const int tid = tid_(), w = tid >> 6, lane = tid & 63, fr = lane & 15, fq = lane >> 4;
    bf16_t* xT = (bf16_t*)shm;
    bf16_t* xwT = xT + 64 * 72;
    bf16_t* Bs = xwT + 64 * 72;
    bf16_t* BT = Bs + 64 * 136;
    bf16_t* Cs = BT + 128 * 72;
    bf16_t* Ms = Cs + 64 * 136;
    bf16_t* hb = Ms + 64 * 72;
    float* cumv = (float*)(hb + 64 * 136);
    float* dtv = cumv + 64;
    const int gr = h >> 3, nch = samp ? 1 : 32, Lv = samp ? 16 : 64;
    const int rowbase = samp ? TP + bi * 16 : bi * 2048;
    const float a_h = -__expf(p->a_log[l * 16 + h]), Dh = p->d_skip[l * 16 + h];
    const float* DT = (const float*)(p->ws + W_DT);
    const bf16_t* Xb = (const bf16_t*)(p->ws + W_XBC);
    bf16_t* Zb = (bf16_t*)(p->ws + W_Z);
    float* ROWSS = (float*)(p->ws + W_ROWSS);
    const int pts = w >> 1, nt0 = (w & 1) * 4;
    f32x4 hacc[4];
    float* stout = samp ? p->out + O_SS + (((size_t)l * 32 + bi) * 16 + h) * 8192 : p->out + O_SP + (((size_t)l * 8 + bi) * 16 + h) * 8192;
    __syncthreads();
#pragma unroll
    for (int i = 0; i < 4; ++i) {
#pragma unroll
        for (int j = 0; j < 4; ++j) {
            const int pr = pts * 16 + fq * 4 + j, n = (nt0 + i) * 16 + fr;
            float v = 0.f;
            if (samp) v = p->state_ssm[((((size_t)l * 32 + bi) * 16 + h) * 64 + pr) * 128 + n];
            hacc[i][j] = v;
            hb[pr * 136 + n] = f2bf(v);
        }
    }
    const bool cact = tid < 480;
    const int cp = tid % 160, seg = tid / 160;
    int ccol;
    if (cp < 32) ccol = h * 64 + cp * 2; else if (cp < 96) ccol = 1024 + gr * 128 + (cp - 32) * 2; else ccol = 1280 + gr * 128 + (cp - 96) * 2;
    float cw[4][2], cbias[2];
#pragma unroll
    for (int i = 0; i < 4; ++i) { cw[i][0] = p->conv_w[(l * 4 + i) * 1536 + ccol]; cw[i][1] = p->conv_w[(l * 4 + i) * 1536 + ccol + 1]; }
    cbias[0] = p->conv_b[l * 1536 + ccol]; cbias[1] = p->conv_b[l * 1536 + ccol + 1];

    for (int ch = 0; ch < nch; ++ch) {
        const int t0 = rowbase + ch * 64;
        __syncthreads();
        if (w == 0) {
            const float d = lane < Lv ? DT[(size_t)(t0 + lane) * 16 + h] : 0.f;
            float c = d * a_h;
#pragma unroll
            for (int o = 1; o < 64; o <<= 1) { const float y = __shfl_up(c, o); if (lane >= o) c += y; }
            cumv[lane] = c; dtv[lane] = d;
        }
        f32x2 raw[25];
        if (cact) {
#pragma unroll
            for (int i = 0; i < 25; ++i) {
                const int rr = seg * 22 - 3 + i;
                f32x2 v = (f32x2){0.f, 0.f};
                if (rr < 64) {
                    if (rr < 0) {
                        if (samp) { const float* sp = p->state_conv + (((size_t)l * 32 + bi) * 3 + (3 + rr)) * 1536 + ccol; v[0] = sp[0]; v[1] = sp[1]; }
                        else if (ch > 0) { const unsigned u = *(const unsigned*)(Xb + (size_t)(t0 + rr) * 1536 + ccol); v[0] = bflo(u); v[1] = bfhi(u); }
                    } else if (rr < Lv) { const unsigned u = *(const unsigned*)(Xb + (size_t)(t0 + rr) * 1536 + ccol); v[0] = bflo(u); v[1] = bfhi(u); }
                }
                raw[i] = v;
            }
        }
        __syncthreads();
        if (cact) {
            const float cum63 = cumv[63];
#pragma unroll
            for (int i = 0; i < 22; ++i) {
                const int tt = seg * 22 + i;
                if (tt < 64) {
                    float o0 = cbias[0] + cw[0][0] * raw[i][0] + cw[1][0] * raw[i + 1][0] + cw[2][0] * raw[i + 2][0] + cw[3][0] * raw[i + 3][0];
                    float o1 = cbias[1] + cw[0][1] * raw[i][1] + cw[1][1] * raw[i + 1][1] + cw[2][1] * raw[i + 2][1] + cw[3][1] * raw[i + 3][1];
                    o0 = siluf_(o0); o1 = siluf_(o1);
                    if (tt >= Lv) { o0 = 0.f; o1 = 0.f; }
                    if (cp < 32) {
                        const float sc = dtv[tt] * __expf(cum63 - cumv[tt]);
                        const int pc = cp * 2;
                        xT[pc * 72 + tt] = f2bf(o0); xT[(pc + 1) * 72 + tt] = f2bf(o1);
                        xwT[pc * 72 + tt] = f2bf(o0 * sc); xwT[(pc + 1) * 72 + tt] = f2bf(o1 * sc);
                    } else if (cp < 96) {
                        const int n = (cp - 32) * 2;
                        *(unsigned*)(Bs + tt * 136 + n) = pk2(o0, o1);
                        BT[n * 72 + tt] = f2bf(o0); BT[(n + 1) * 72 + tt] = f2bf(o1);
                    } else {
                        const int n = (cp - 96) * 2;
                        *(unsigned*)(Cs + tt * 136 + n) = pk2(o0, o1);
                    }
                }
            }
        }
        __syncthreads();
        const int ttile = w >> 1, half = w & 1;
        f32x4 cb[2], yacc[2];
#pragma unroll
        for (int i = 0; i < 2; ++i) { cb[i] = (f32x4){0.f, 0.f, 0.f, 0.f}; yacc[i] = (f32x4){0.f, 0.f, 0.f, 0.f}; }
#pragma unroll
        for (int ks = 0; ks < 4; ++ks) {
            const bf16x8 cf = *(const bf16x8*)(Cs + (ttile * 16 + fr) * 136 + ks * 32 + fq * 8);
#pragma unroll
            for (int i = 0; i < 2; ++i) {
                const bf16x8 bfr = *(const bf16x8*)(Bs + ((half * 2 + i) * 16 + fr) * 136 + ks * 32 + fq * 8);
                cb[i] = mfma16(cf, bfr, cb[i]);
                const bf16x8 hf = *(const bf16x8*)(hb + ((half * 2 + i) * 16 + fr) * 136 + ks * 32 + fq * 8);
                yacc[i] = mfma16(cf, hf, yacc[i]);
            }
        }
#pragma unroll
        for (int j = 0; j < 4; ++j) {
            const int t = ttile * 16 + fq * 4 + j;
            const float ct = cumv[t];
            const float et = __expf(ct);
#pragma unroll
            for (int i = 0; i < 2; ++i) {
                const int s = (half * 2 + i) * 16 + fr;
                const float mv = (s <= t) ? cb[i][j] * __expf(ct - cumv[s]) * dtv[s] : 0.f;
                Ms[t * 72 + s] = f2bf(mv);
                yacc[i][j] *= et;
            }
        }
        __syncthreads();
#pragma unroll
        for (int ks = 0; ks < 2; ++ks) {
            const bf16x8 mf = *(const bf16x8*)(Ms + (ttile * 16 + fr) * 72 + ks * 32 + fq * 8);
#pragma unroll
            for (int i = 0; i < 2; ++i) {
                const bf16x8 xf = *(const bf16x8*)(xT + ((half * 2 + i) * 16 + fr) * 72 + ks * 32 + fq * 8);
                yacc[i] = mfma16(mf, xf, yacc[i]);
            }
        }
        {
            float ssq[4] = {0.f, 0.f, 0.f, 0.f};
#pragma unroll
            for (int j = 0; j < 4; ++j) {
                const int t = ttile * 16 + fq * 4 + j;
                if (t < Lv) {
#pragma unroll
                    for (int i = 0; i < 2; ++i) {
                        const int pc = (half * 2 + i) * 16 + fr;
                        const float xv = bf2f(xT[pc * 72 + t]);
                        const float y = yacc[i][j] + Dh * xv;
                        const size_t zi = (size_t)(t0 + t) * 1024 + h * 64 + pc;
                        const float z = bf2f(Zb[zi]);
                        const float uu = y * siluf_(z);
                        Zb[zi] = f2bf(uu);
                        ssq[j] += uu * uu;
                    }
                }
            }
#pragma unroll
            for (int j = 0; j < 4; ++j) {
                float s = ssq[j];
                s += __shfl_xor(s, 1); s += __shfl_xor(s, 2); s += __shfl_xor(s, 4); s += __shfl_xor(s, 8);
                const int t = ttile * 16 + fq * 4 + j;
                if (fr == 0 && t < Lv) atomicAdd(ROWSS + t0 + t, s);
            }
        }
        const float dec = __expf(cumv[63]);
#pragma unroll
        for (int i = 0; i < 4; ++i) hacc[i] *= dec;
#pragma unroll
        for (int ks = 0; ks < 2; ++ks) {
            const bf16x8 xf = *(const bf16x8*)(xwT + (pts * 16 + fr) * 72 + ks * 32 + fq * 8);
#pragma unroll
            for (int i = 0; i < 4; ++i) {
                const bf16x8 bfr = *(const bf16x8*)(BT + ((nt0 + i) * 16 + fr) * 72 + ks * 32 + fq * 8);
                hacc[i] = mfma16(xf, bfr, hacc[i]);
            }
        }
#pragma unroll
        for (int i = 0; i < 4; ++i)
#pragma unroll
            for (int j = 0; j < 4; ++j) hb[(pts * 16 + fq * 4 + j) * 136 + (nt0 + i) * 16 + fr] = f2bf(hacc[i][j]);
    }
#pragma unroll
    for (int i = 0; i < 4; ++i)
#pragma unroll
        for (int j = 0; j < 4; ++j) stout[(pts * 16 + fq * 4 + j) * 128 + (nt0 + i) * 16 + fr] = hacc[i][j];
}

constexpr int N_OTHER = 512 + 512 + 512 + 64 + 128;
__device__ __forceinline__ void phase_mixers(int l, unsigned char* shm) {
    int* s_item = (int*)(shm + 131072);
    for (int it = blockIdx.x; it < 128; it += gridDim.x) ssd_item(kparams(), l, false, it >> 4, it & 15, shm);
    for (;;) {
        __syncthreads();
        if (threadIdx.x == 0) *s_item = (int)atomicAdd((unsigned*)(kparams()->ws + W_CNT) + l, 1u);
        __syncthreads();
        int j = *s_item;
        const KP p = kparams();
        if (j >= N_OTHER) break;
        if (j < 512) { attn_prompt_item(p, l, j, shm); continue; } j -= 512;
        if (j < 512) { gmlp_item(p, l, false, j >> 6, (j >> 2) & 15, j & 3, shm); continue; } j -= 512;
        if (j < 512) { ssd_item(p, l, true, j >> 4, j & 15, shm); continue; } j -= 512;
        if (j < 64) { attn_sample_item(p, l, j, shm); continue; } j -= 64;
        gmlp_item(p, l, true, j >> 2, 0, j & 3, shm);
    }
}

__global__ void __launch_bounds__(512, 2) fwd_kernel(Params p_unused) {
    extern __shared__ __attribute__((aligned(16))) unsigned char shm[];
    cg::grid_group grid = cg::this_grid();
    LAS unsigned char* lds = (LAS unsigned char*)shm;
    const int tid = tid_();

    phase_mod(kparams(), (float*)shm);
    {
        const KP p = kparams();
        unsigned char* ws = p->ws;
        f32x2* rope = (f32x2*)(ws + W_ROPE);
        for (int idx = blockIdx.x * 512 + tid; idx < 2064 * 8; idx += gridDim.x * 512) {
            const int pi = idx >> 3, j = idx & 7;
            const float pos = (float)(pi < 2048 ? pi : 4096 + (pi - 2048));
            const float invf = exp2f(-(float)j * 0.125f * 18.931568569324174f);
            const float ang = pos * invf;
            const double a = (double)ang;
            const double kk = rint(a * 0.15915494309189535);
            const float r = (float)(a - kk * 6.283185307179586);
            rope[idx] = (f32x2){__cosf(r), __sinf(r)};
        }
        float* ROWSS = (float*)(ws + W_ROWSS);
        for (int idx = blockIdx.x * 512 + tid; idx < T; idx += gridDim.x * 512) ROWSS[idx] = 0.f;
        if (blockIdx.x == 0 && tid < 64) ((unsigned*)(ws + W_CNT))[tid] = 0u;
    }
    convert_weights(kparams(), 0, (float*)shm);
    grid.sync();

#pragma unroll 1
    for (int l = 0; l < 2; ++l) {
        {
            const KP p = kparams();
            float* X = p->out + O_Y;
            phase_norm(p, l, l == 0 ? p->x_prompt : X, l == 0 ? p->x_sample : X + (size_t)TP * 1024, p->g_mix + l * 1024, 0);
        }
        if (l == 1) {
            convert_weights(kparams(), 1, (float*)shm);
            float* ROWSS = (float*)(kparams()->ws + W_ROWSS);
            for (int idx = blockIdx.x * 512 + tid; idx < T; idx += gridDim.x * 512) ROWSS[idx] = 0.f;
        }
        grid.sync();
        {
            const KP p = kparams();
            const bf16_t* H = (const bf16_t*)(p->ws + W_H); const bf16_t* WT = (const bf16_t*)(p->ws + W_WT);
            pg8::StaticOrder S; S.init(T, NINP, (int)gridDim.x, (int)blockIdx.x);
            EpiIn E; E.l = l; E.pp = p;
            pg8::gemm_phase(lds, pg8::Gemm{H, WT + WT_IN, T, NINP, 1024}, S, E);
        }
        grid.sync();
        phase_mixers(l, shm);
        grid.sync();
#pragma unroll 1
        for (int b = 0; b < 3; ++b) {
            const KP p = kparams();
            unsigned char* ws = p->ws;
            const bf16_t* WT = (const bf16_t*)(ws + W_WT);
            const bf16_t* A = (const bf16_t*)(ws + (b == 0 ? W_Q : (b == 1 ? W_Z : W_GU)));
            const bf16_t* Bt = WT + (b == 0 ? WT_AO : (b == 1 ? WT_SO : WT_GO));
            const int K = b == 1 ? 1024 : 512;
            EpiRC<FMerge> E; E.f.b = b; E.f.G8 = ws + W_G8; E.f.rowss = (const float*)(ws + W_ROWSS); E.f.MG = (bf16_t*)(ws + W_H);
            pg8::StaticOrder S; S.init(TP, 1024, (int)gridDim.x, (int)blockIdx.x);
            pg8::gemm_phase(lds, pg8::Gemm{A, Bt, TP, 1024, K}, S, E);
            skinny_gemm(shm, A + (size_t)TP * K, Bt, 1024, K, E.f);
        }
        grid.sync();
#pragma unroll 1
        for (int s2 = 0; s2 < 2; ++s2) {
            {
                const KP p = kparams();
                unsigned char* ws = p->ws;
                float* X = p->out + O_Y;
                const bf16_t* WT = (const bf16_t*)(ws + W_WT);
                const bf16_t* A = (const bf16_t*)(ws + (s2 == 0 ? W_H : W_FH));
                const bf16_t* Bt = WT + (s2 == 0 ? WT_OUT : WT_F2);
                const int K = s2 == 0 ? 1024 : 4096;
                const bool first = (l == 0 && s2 == 0);
                EpiRC<FResid> E; E.f.srcP = first ? p->x_prompt : X; E.f.srcS = first ? p->x_sample : X + (size_t)TP * 1024; E.f.X = X;
                E.f.modg = (const float*)(ws + W_MOD) + (size_t)l * 40 * 6144 + (s2 == 0 ? 2 : 5) * 1024;
                pg8::StaticOrder S; S.init(TP, 1024, (int)gridDim.x, (int)blockIdx.x);
                pg8::gemm_phase(lds, pg8::Gemm{A, Bt, TP, 1024, K}, S, E);
                skinny_gemm(shm, A + (size_t)TP * K, Bt, 1024, K, E.f);
            }
            grid.sync();
            if (s2 == 0) {
                {
                    const KP p = kparams();
                    float* X = p->out + O_Y;
                    phase_norm(p, l, X, X + (size_t)TP * 1024, p->g_ff + l * 1024, 3);
                }
                grid.sync();
                {
                    const KP p = kparams();
                    unsigned char* ws = p->ws;
                    const bf16_t* H = (const bf16_t*)(ws + W_H); const bf16_t* WT = (const bf16_t*)(ws + W_WT);
                    EpiRC<FRelu2> E; E.f.FH = (bf16_t*)(ws + W_FH);
                    pg8::StaticOrder S; S.init(TP, 4096, (int)gridDim.x, (int)blockIdx.x);
                    pg8::gemm_phase(lds, pg8::Gemm{H, WT + WT_F1, TP, 4096, 1024}, S, E);
                    skinny_gemm(shm, H + (size_t)TP * 1024, WT + WT_F1, 4096, 1024, E.f);
                }
                grid.sync();
            }
        }
    }
    {
        const KP p = kparams();
        float* X = p->out + O_Y;
        const float* gf = p->g_final;
        const int lane = tid & 63, gw = blockIdx.x * 8 + (tid >> 6), ngw = gridDim.x * 8;
        for (int row = gw; row < T; row += ngw) {
            f32x4* xr = (f32x4*)(X + (size_t)row * 1024);
            f32x4 v[4]; float ss = 0.f;
#pragma unroll
            for (int j = 0; j < 4; ++j) { v[j] = xr[lane + 64 * j]; ss += v[j][0] * v[j][0] + v[j][1] * v[j][1] + v[j][2] * v[j][2] + v[j][3] * v[j][3]; }
            ss = wave_sum(ss);
            const float rstd = rsqrtf(ss * (1.f / 1024.f) + EPSF);
#pragma unroll
            for (int j = 0; j < 4; ++j) { const f32x4 g = ((const f32x4*)gf)[lane + 64 * j]; xr[lane + 64 * j] = v[j] * rstd * g; }
        }
    }
}

extern "C" void kernel_launch(void* const* d_in, const int* in_sizes, int n_in, void* d_out, int out_size, void* d_ws, size_t ws_size, hipStream_t stream) {
    static int grid_blocks = 0;
    if (!grid_blocks) {
        int dev = 0, cus = 0, per_cu = 0;
        hipGetDevice(&dev);
        hipDeviceGetAttribute(&cus, hipDeviceAttributeMultiprocessorCount, dev);
        hipFuncSetAttribute((const void*)fwd_kernel, hipFuncAttributeMaxDynamicSharedMemorySize, LDS_BYTES);
        hipOccupancyMaxActiveBlocksPerMultiprocessor(&per_cu, (const void*)fwd_kernel, 512, LDS_BYTES);
        if (per_cu < 1) per_cu = 1;
        grid_blocks = cus * per_cu;
        if (ws_size < W_END) fprintf(stderr, "kernel_launch: workspace too small: need %zu, got %zu\n", (size_t)W_END, ws_size);
    }
    Params p{};
    const float** fp = (const float**)&p;
    for (int i = 0; i < 31; ++i) fp[i] = (const float*)d_in[i];
    p.out = (float*)d_out; p.ws = (unsigned char*)d_ws;
    void* args[] = {&p};
    hipError_t e = hipLaunchCooperativeKernel((const void*)fwd_kernel, dim3(grid_blocks), dim3(512), args, LDS_BYTES, stream);
    if (e != hipSuccess) fprintf(stderr, "cooperative launch failed: %s (grid %d)\n", hipGetErrorString(e), grid_blocks);
}
```

```cpp
#include <hip/hip_runtime.h>
#include <hip/hip_cooperative_groups.h>
#include <cstdio>
namespace cg = cooperative_groups;

#define LAS __attribute__((address_space(3)))
typedef unsigned short bf16_t;
typedef short bf16x8 __attribute__((ext_vector_type(8)));
typedef float f32x4 __attribute__((ext_vector_type(4)));
typedef float f32x2 __attribute__((ext_vector_type(2)));
typedef unsigned u32x2 __attribute__((ext_vector_type(2)));
typedef unsigned u32x4 __attribute__((ext_vector_type(4)));

constexpr int DM = 1024, TP = 16384, TS = 512, T = TP + TS;
constexpr int NINP = 7680;
constexpr float EPSF = 1e-6f;

constexpr size_t O_Y = 0;
constexpr size_t O_KP = (size_t)T * DM;
constexpr size_t O_VP = O_KP + 2 * 8 * 128 * 128;
constexpr size_t O_SP = O_VP + 2 * 8 * 128 * 128;
constexpr size_t O_CP = O_SP + (size_t)2 * 8 * 16 * 64 * 128;
constexpr size_t O_KS = O_CP + 2 * 8 * 3 * 1536;
constexpr size_t O_VS = O_KS + 2 * 32 * 16 * 128;
constexpr size_t O_SS = O_VS + 2 * 32 * 16 * 128;
constexpr size_t O_CS = O_SS + (size_t)2 * 32 * 16 * 64 * 128;
constexpr size_t O_GS = O_CS + 2 * 32 * 3 * 1536;

constexpr size_t WT_IN = 0;
constexpr size_t WT_AO = WT_IN + (size_t)NINP * 1024;
constexpr size_t WT_SO = WT_AO + 1024 * 512;
constexpr size_t WT_GO = WT_SO + 1024 * 1024;
constexpr size_t WT_OUT = WT_GO + 1024 * 512;
constexpr size_t WT_F1 = WT_OUT + 1024 * 1024;
constexpr size_t WT_F2 = WT_F1 + (size_t)4096 * 1024;
constexpr size_t WT_END = WT_F2 + (size_t)1024 * 4096;

constexpr size_t al256(size_t x) { return (x + 255) & ~(size_t)255; }
constexpr size_t W_WT = 0;
constexpr size_t W_MOD = al256(W_WT + WT_END * 2);
constexpr size_t W_ROPE = al256(W_MOD + (size_t)2 * 40 * 6144 * 4);
constexpr size_t W_ROWSS = al256(W_ROPE + (size_t)2064 * 8 * 8);
constexpr size_t W_CNT = al256(W_ROWSS + (size_t)T * 4);
constexpr size_t W_BAR = al256(W_CNT + 256);
constexpr size_t W_DT = al256(W_BAR + 3456 * 4);
constexpr size_t W_H = al256(W_DT + (size_t)T * 16 * 4);
constexpr size_t W_Q = al256(W_H + (size_t)T * 1024 * 2);
constexpr size_t W_K = W_Q + (size_t)T * 512 * 2;
constexpr size_t W_V = W_K + (size_t)T * 128 * 2;
constexpr size_t W_Z = W_V + (size_t)T * 128 * 2;
constexpr size_t W_XBC = W_Z + (size_t)T * 1024 * 2;
constexpr size_t W_GU = W_XBC + (size_t)T * 1536 * 2;
constexpr size_t W_GV = W_GU + (size_t)T * 512 * 2;
constexpr size_t W_PAEND = W_GV + (size_t)T * 512 * 2;
constexpr size_t W_FH = W_Q;
constexpr size_t W_G8 = al256(W_PAEND);
constexpr size_t W_BCN = al256(W_G8 + (size_t)T * 3072);
constexpr size_t W_BT = al256(W_BCN + (size_t)T * 512 * 2);
constexpr size_t W_END = W_BT + ((size_t)256 * 256 * 64 + (size_t)32 * 256 * 16) * 2;
static_assert((size_t)T * 4096 * 2 <= W_PAEND - W_Q, "FH alias");

constexpr int LDS_BYTES = 131072 + 256;
#ifndef PROBE_MASK
#define PROBE_MASK 0
#endif
#if PROBE_MASK
#define PH_BEGIN(id) const unsigned long long _t_##id = wall_clock64()
#define PH_END(id) do { if ((PROBE_MASK >> (id)) & 1) probe_acc += wall_clock64() - _t_##id; } while (0)
#else
#define PH_BEGIN(id) do {} while (0)
#define PH_END(id) do {} while (0)
#endif

struct Params {
    const float *x_prompt, *x_sample, *c_prompt, *c_sample, *cache_k, *cache_v, *state_ssm, *state_conv;
    const float *w_ada, *b_ada, *g_mix, *w_in, *sinks, *conv_w, *conv_b, *dt_bias, *a_log, *d_skip, *ssm_norm_w;
    const float *gm_ln_g, *gm_ln_b, *gm_w_s, *gm_b_s, *w_attn_o, *w_ssm_o, *w_gm_o, *w_out, *g_ff, *w_ff1, *w_ff2, *g_final;
    float* out;
    unsigned char* ws;
};

typedef const Params __attribute__((address_space(4)))* KP;
__device__ __forceinline__ KP kparams() { KP q = (KP)__builtin_amdgcn_kernarg_segment_ptr(); asm volatile("" : "+s"(q)); return q; }

__device__ __forceinline__ int tid_() { int t = threadIdx.x; asm volatile("" : "+v"(t)); return t; }
__device__ __forceinline__ unsigned pk2(float lo, float hi) { unsigned r; asm("v_cvt_pk_bf16_f32 %0, %1, %2" : "=v"(r) : "v"(lo), "v"(hi)); return r; }
__device__ __forceinline__ bf16_t f2bf(float f) { return (bf16_t)(pk2(f, 0.f) & 0xffffu); }
__device__ __forceinline__ float bf2f(bf16_t b) { return __uint_as_float(((unsigned)b) << 16); }
__device__ __forceinline__ float bflo(unsigned u) { return __uint_as_float(u << 16); }
__device__ __forceinline__ float bfhi(unsigned u) { return __uint_as_float(u & 0xffff0000u); }
__device__ __forceinline__ float sigm(float x) { return __builtin_amdgcn_rcpf(1.f + __expf(-x)); }
__device__ __forceinline__ float siluf_(float x) { return x * sigm(x); }
__device__ __forceinline__ float geluf_(float x) { return x * sigm(1.5957691216057308f * (x + 0.044715f * x * x * x)); }
__device__ __forceinline__ float wave_sum(float v) {
#pragma unroll
    for (int o = 1; o < 64; o <<= 1) v += __shfl_xor(v, o);
    return v;
}
__device__ __forceinline__ u32x4 zero4() { unsigned z; asm volatile("v_mov_b32 %0, 0" : "=v"(z)); return (u32x4){z, z, z, z}; }
template <int CTRL, int RM = 0xf, int BK = 0xf>
__device__ __forceinline__ float dpp_add(float v) { return v + __int_as_float(__builtin_amdgcn_update_dpp(0, __float_as_int(v), CTRL, RM, BK, false)); }
__device__ __forceinline__ float row16_sum(float v) { v = dpp_add<0xB1>(v); v = dpp_add<0x4E>(v); v = dpp_add<0x141>(v); return dpp_add<0x140>(v); }
__device__ __forceinline__ float wave_scan(float c) { c = dpp_add<0x111>(c); c = dpp_add<0x112>(c); c = dpp_add<0x114>(c); c = dpp_add<0x118>(c); c = dpp_add<0x142, 0xa>(c); return dpp_add<0x143, 0xc>(c); }
__device__ __forceinline__ f32x4 mfma16(bf16x8 a, bf16x8 b, f32x4 c) { return __builtin_amdgcn_mfma_f32_16x16x32_bf16(a, b, c, 0, 0, 0); }
__device__ __forceinline__ int mod_row(int row) { return row < TP ? (row >> 11) : 8 + ((row - TP) >> 4); }

namespace pg8 {
constexpr int BM = 256, BK = 64, HALF = 128, HTB = HALF * BK * 2, STAGE_BYTES = 8 * HTB, NXCD = 8, WGM = 8;
__device__ __forceinline__ int lds_byte(int r, int c) { const int st = (r >> 4) * 2 + (c >> 5), rr = r & 15, cc = c & 31, ob = rr * 64 + cc * 2; return st * 1024 + (ob ^ (((ob >> 9) & 1) << 5)); }
__device__ __forceinline__ void stage_rc(int b, int& R, int& C) { const int st = b / 1024, sb = b % 1024, swz = sb ^ (((sb >> 9) & 1) << 5); R = (st >> 1) * 16 + swz / 64; C = (st & 1) * 32 + (swz % 64) / 2; }
struct Unit { int pm, pn; };
struct Gemm { const bf16_t* A; const bf16_t* Bt; int M, N, K; };
struct StaticOrder {
    int nM, nN, nwg, G, c;
    __device__ void init(int M, int N, int G_, int c_) { nM = M / BM; nN = N / BM; nwg = nM * nN; G = G_; c = c_; }
    __device__ bool next(int i, Unit& u) const {
        const long L = (long)i * G + c; if (L >= nwg) return false;
        int wgid = (int)L; { const int q = nwg / NXCD, r = nwg % NXCD, xcd = wgid % NXCD, off = wgid / NXCD; wgid = (xcd < r ? xcd * (q + 1) : r * (q + 1) + (xcd - r) * q) + off; }
        const int nig = WGM * nN, gid = wgid / nig, fm = gid * WGM, gsz = (nM - fm) < WGM ? (nM - fm) : WGM;
        u.pm = fm + ((wgid % nig) % gsz); u.pn = (wgid % nig) / gsz; return true;
    }
};
template <class Epi>
__device__ __forceinline__ void gemm_phase(LAS unsigned char* lds, const Gemm g, const StaticOrder& S, const Epi& E) {
    const int tid = tid_(), wid = __builtin_amdgcn_readfirstlane(tid >> 6), lane = tid & 63, wr = wid >> 2, wc = wid & 3, fr = lane & 15, fq = lane >> 4;
    const int K = g.K, nt = K / BK;
    unsigned voffA[2], voffB[2];
#pragma unroll
    for (int i = 0; i < 2; ++i) { int R, C; stage_rc(tid * 16 + i * 8192, R, C); voffA[i] = (unsigned)(R * K + C) * 2u; voffB[i] = voffA[i]; }
    const size_t kstep = (size_t)(BK * 2);
    const size_t hstep = (size_t)HALF * K * 2;
    const size_t tstep = 2 * hstep;
    const unsigned ldsw = (unsigned)wid * 1024u;
    const int aoff = lds_byte(wr * 64 + fr, fq * 8), boff = lds_byte(wc * 32 + fr, fq * 8);
#define PG8_SA(b, h) (((b) * 2 + (h)) * HTB)
#define PG8_SB(b, h) ((4 + (b) * 2 + (h)) * HTB)
#define PG8_STAGE(bufoff, gbase, voff) do { _Pragma("unroll") for (int _i = 0; _i < 2; ++_i) \
        __builtin_amdgcn_global_load_lds((const unsigned*)((const char*)(gbase) + (voff)[_i]), (LAS unsigned*)(lds + (bufoff) + ldsw + _i * 8192), 16, 0, 0); } while (0)
#define PG8_LDA(dst, b, h) do { _Pragma("unroll") for (int m = 0; m < 4; ++m) _Pragma("unroll") for (int k = 0; k < 2; ++k) dst[m][k] = *(const LAS bf16x8*)(lds + PG8_SA(b, h) + aoff + m * 2048 + k * 1024); } while (0)
#define PG8_LDB(dst, b, h) do { _Pragma("unroll") for (int n = 0; n < 2; ++n) _Pragma("unroll") for (int k = 0; k < 2; ++k) dst[n][k] = *(const LAS bf16x8*)(lds + PG8_SB(b, h) + boff + n * 2048 + k * 1024); } while (0)
#define PG8_MMA(ai, bj, At, Bt) do { __builtin_amdgcn_s_setprio(1); _Pragma("unroll") for (int m = 0; m < 4; ++m) _Pragma("unroll") for (int n = 0; n < 2; ++n) _Pragma("unroll") for (int k = 0; k < 2; ++k) \
        acc[ai][bj][m][n] = __builtin_amdgcn_mfma_f32_16x16x32_bf16(Bt[n][k], At[m][k], acc[ai][bj][m][n], 0, 0, 0); __builtin_amdgcn_s_setprio(0); } while (0)
#define PG8_WAIT_V(n) asm volatile("s_waitcnt vmcnt(" #n ")" ::: "memory")
#define PG8_WAIT_L(n) asm volatile("s_waitcnt lgkmcnt(" #n ")" ::: "memory")
#define PG8_BAR __builtin_amdgcn_s_barrier()
#define PG8_SCHED __builtin_amdgcn_sched_barrier(0)
    Unit cur, nxt; int ui = 0;
    if (!S.next(0, cur)) return;
    f32x4 acc[2][2][4][2];
#pragma unroll
    for (int a = 0; a < 2; ++a)
#pragma unroll
        for (int b = 0; b < 2; ++b)
#pragma unroll
            for (int m = 0; m < 4; ++m)
#pragma unroll
                for (int n = 0; n < 2; ++n) acc[a][b][m][n] = (f32x4){0.f, 0.f, 0.f, 0.f};
    bf16x8 At[4][2], B0[2][2], B1[2][2];
    const char* cA = (const char*)g.A + (size_t)cur.pm * tstep; const char* cB = (const char*)g.Bt + (size_t)cur.pn * tstep;
    PG8_STAGE(PG8_SB(0, 0), cB, voffB); PG8_STAGE(PG8_SA(0, 0), cA, voffA); PG8_STAGE(PG8_SB(0, 1), cB + hstep, voffB); PG8_STAGE(PG8_SA(0, 1), cA + hstep, voffA);
    if (wr == 1) PG8_BAR;
    PG8_WAIT_V(4); PG8_BAR;
    PG8_STAGE(PG8_SB(1, 0), cB + kstep, voffB); PG8_STAGE(PG8_SA(1, 0), cA + kstep, voffA); PG8_STAGE(PG8_SB(1, 1), cB + hstep + kstep, voffB);
    PG8_WAIT_V(6); PG8_BAR;
    for (;;) {
        const bool has_next = S.next(ui + 1, nxt);
        const char* nA = has_next ? (const char*)g.A + (size_t)nxt.pm * tstep : cA; const char* nB = has_next ? (const char*)g.Bt + (size_t)nxt.pn * tstep : cB;
        for (int t = 0; t < nt; t += 2) {
            const bool last = (t == nt - 2);
            const char* a1 = cA + (size_t)(t + 1) * kstep;
            const char* a2 = last ? nA : cA + (size_t)(t + 2) * kstep; const char* b2 = last ? nB : cB + (size_t)(t + 2) * kstep;
            const char* a3 = a2 + kstep; const char* b3 = b2 + kstep;
            PG8_LDB(B0, 0, 0); PG8_SCHED; PG8_LDA(At, 0, 0); PG8_STAGE(PG8_SA(1, 1), a1 + hstep, voffA);
            PG8_WAIT_L(8); PG8_BAR; PG8_WAIT_L(0); PG8_MMA(0, 0, At, B0); PG8_BAR; PG8_SCHED;
            PG8_LDB(B1, 0, 1); PG8_STAGE(PG8_SB(0, 0), b2, voffB);
            PG8_BAR; PG8_WAIT_L(0); PG8_MMA(0, 1, At, B1); PG8_BAR;
            PG8_LDA(At, 0, 1); PG8_STAGE(PG8_SA(0, 0), a2, voffA);
            PG8_BAR; PG8_WAIT_L(0); PG8_MMA(1, 0, At, B0); PG8_BAR; PG8_SCHED;
            PG8_STAGE(PG8_SB(0, 1), b2 + hstep, voffB);
            PG8_WAIT_V(6); PG8_BAR; PG8_MMA(1, 1, At, B1); PG8_BAR;
            PG8_LDB(B0, 1, 0); PG8_SCHED; PG8_LDA(At, 1, 0); PG8_STAGE(PG8_SA(0, 1), a2 + hstep, voffA);
            PG8_WAIT_L(8); PG8_BAR; PG8_WAIT_L(0); PG8_MMA(0, 0, At, B0); PG8_BAR; PG8_SCHED;
            PG8_LDB(B1, 1, 1); PG8_STAGE(PG8_SB(1, 0), b3, voffB);
            PG8_BAR; PG8_WAIT_L(0); PG8_MMA(0, 1, At, B1); PG8_BAR;
            PG8_LDA(At, 1, 1); PG8_STAGE(PG8_SA(1, 0), a3, voffA);
            PG8_BAR; PG8_WAIT_L(0); PG8_MMA(1, 0, At, B0); PG8_BAR; PG8_SCHED;
            PG8_STAGE(PG8_SB(1, 1), b3 + hstep, voffB);
            PG8_WAIT_V(6); PG8_BAR; PG8_MMA(1, 1, At, B1); PG8_BAR;
        }
        E(acc, cur, wr, wc, fr, fq);
        if (!has_next) break;
#pragma unroll
        for (int a = 0; a < 2; ++a)
#pragma unroll
            for (int b = 0; b < 2; ++b)
#pragma unroll
                for (int m = 0; m < 4; ++m)
#pragma unroll
                    for (int n = 0; n < 2; ++n) acc[a][b][m][n] = (f32x4){0.f, 0.f, 0.f, 0.f};
        cur = nxt; cA = nA; cB = nB; ++ui;
    }
    PG8_WAIT_V(0);
    if (wr == 0) PG8_BAR;
    PG8_BAR;
#undef PG8_SA
#undef PG8_SB
#undef PG8_STAGE
#undef PG8_LDA
#undef PG8_LDB
#undef PG8_MMA
#undef PG8_WAIT_V
#undef PG8_WAIT_L
#undef PG8_BAR
#undef PG8_SCHED
}
}

template <class F, int MG = 2> struct EpiRC {
    F f;
    __device__ __forceinline__ void operator()(const f32x4 (&acc)[2][2][4][2], const pg8::Unit& u, int wr, int wc, int fr, int fq) const {
        const int row0 = u.pm * 256 + wr * 64 + fr, col0 = u.pn * 256 + wc * 32 + 4 * fq;
#pragma unroll
        for (int ai = 0; ai < 2; ++ai)
#pragma unroll
            for (int mh = 0; mh < 4 / MG; ++mh) {
                typename F::Ld ld[MG][2][2];
#pragma unroll
                for (int mm = 0; mm < MG; ++mm)
#pragma unroll
                    for (int bj = 0; bj < 2; ++bj)
#pragma unroll
                        for (int n = 0; n < 2; ++n) f.load(row0 + ai * 128 + (mh * MG + mm) * 16, col0 + bj * 128 + n * 16, ld[mm][bj][n]);
#pragma unroll
                for (int mm = 0; mm < MG; ++mm)
#pragma unroll
                    for (int bj = 0; bj < 2; ++bj)
#pragma unroll
                        for (int n = 0; n < 2; ++n) f.apply(row0 + ai * 128 + (mh * MG + mm) * 16, col0 + bj * 128 + n * 16, acc[ai][bj][mh * MG + mm][n], ld[mm][bj][n]);
            }
    }
};
struct EpiResidP {
    const float* src; float* X; const float* modg;
    __device__ __forceinline__ void operator()(const f32x4 (&acc)[2][2][4][2], const pg8::Unit& u, int wr, int wc, int fr, int fq) const {
        const int row0 = u.pm * 256 + wr * 64 + fr, col0 = u.pn * 256 + wc * 32 + 4 * fq;
        const float* gp = modg + (size_t)((u.pm * 256) >> 11) * 6144 + col0;
        f32x4 g[2][2];
#pragma unroll
        for (int bj = 0; bj < 2; ++bj)
#pragma unroll
            for (int n = 0; n < 2; ++n) g[bj][n] = *(const f32x4*)(gp + bj * 128 + n * 16);
#pragma unroll
        for (int ai = 0; ai < 2; ++ai) {
            f32x4 x[4][2][2];
#pragma unroll
            for (int m = 0; m < 4; ++m)
#pragma unroll
                for (int bj = 0; bj < 2; ++bj)
#pragma unroll
                    for (int n = 0; n < 2; ++n) x[m][bj][n] = *(const f32x4*)(src + (size_t)(row0 + ai * 128 + m * 16) * 1024 + col0 + bj * 128 + n * 16);
#pragma unroll
            for (int m = 0; m < 4; ++m)
#pragma unroll
                for (int bj = 0; bj < 2; ++bj)
#pragma unroll
                    for (int n = 0; n < 2; ++n) *(f32x4*)(X + (size_t)(row0 + ai * 128 + m * 16) * 1024 + col0 + bj * 128 + n * 16) = x[m][bj][n] + g[bj][n] * acc[ai][bj][m][n];
        }
    }
};

template <int KW, class F>
__device__ __forceinline__ void skinny_gemm(unsigned char* shm, const bf16_t* A, const bf16_t* Bt, int N, const F& f) {
    constexpr int K = KW * 8, NS = KW / 32 < 4 ? KW / 32 : 4, NSTEP = KW / 32;
    const int tid = tid_(), w = tid >> 6, lane = tid & 63, fr = lane & 15, fq = lane >> 4;
    f32x4* red = (f32x4*)shm;
    const int nun = 16 * (N / 64);
    for (int u = blockIdx.x; u < nun; u += gridDim.x) {
        const int m0 = (u & 15) * 32, n0 = (u >> 4) * 64;
        typename F::Ld eld; const int er = TP + m0 + (w >> 2) * 16 + fr, ec = n0 + (w & 3) * 16 + fq * 4; f.load(er, ec, eld);
        f32x4 acc[2][4];
#pragma unroll
        for (int i = 0; i < 2; ++i)
#pragma unroll
            for (int j = 0; j < 4; ++j) acc[i][j] = (f32x4){0.f, 0.f, 0.f, 0.f};
        const bf16_t* ap = A + (size_t)(m0 + fr) * K + w * KW + fq * 8;
        const bf16_t* bp = Bt + (size_t)(n0 + fr) * K + w * KW + fq * 8;
        bf16x8 ra[NS][2], rb[NS][4];
#pragma unroll
        for (int s = 0; s < NS; ++s) {
#pragma unroll
            for (int i = 0; i < 2; ++i) ra[s][i] = *(const bf16x8*)(ap + (size_t)i * 16 * K + s * 32);
#pragma unroll
            for (int j = 0; j < 4; ++j) rb[s][j] = *(const bf16x8*)(bp + (size_t)j * 16 * K + s * 32);
        }
#pragma unroll
        for (int st = 0; st < NSTEP; ++st) {
            const int s = st % NS;
#pragma unroll
            for (int i = 0; i < 2; ++i)
#pragma unroll
                for (int j = 0; j < 4; ++j) acc[i][j] = mfma16(rb[s][j], ra[s][i], acc[i][j]);
            if (st + NS < NSTEP) {
#pragma unroll
                for (int i = 0; i < 2; ++i) ra[s][i] = *(const bf16x8*)(ap + (size_t)i * 16 * K + (st + NS) * 32);
#pragma unroll
                for (int j = 0; j < 4; ++j) rb[s][j] = *(const bf16x8*)(bp + (size_t)j * 16 * K + (st + NS) * 32);
            }
        }
        __syncthreads();
#pragma unroll
        for (int i = 0; i < 2; ++i)
#pragma unroll
            for (int j = 0; j < 4; ++j) red[(w * 8 + i * 4 + j) * 64 + lane] = acc[i][j];
        __syncthreads();
        f32x4 s = red[w * 64 + lane];
#pragma unroll
        for (int q = 1; q < 8; ++q) s += red[(q * 8 + w) * 64 + lane];
        f.apply(er, ec, s, eld);
    }
    __syncthreads();
}

struct EpiIn {
    int l; KP pp;
    __device__ __forceinline__ void operator()(const f32x4 (&acc)[2][2][4][2], const pg8::Unit& u, int wr, int wc, int fr, int fq) const {
        const KP p = pp;
        unsigned char* ws = p->ws;
        const int pn = u.pn;
        const int row0 = u.pm * 256 + wr * 64 + fr;
        const int ct0 = wc * 32 + 4 * fq;
        if (pn < 3) {
            bf16_t* Qb = (bf16_t*)(ws + W_Q); bf16_t* Kb = (bf16_t*)(ws + W_K); bf16_t* Vb = (bf16_t*)(ws + W_V);
            const f32x2* rope = (const f32x2*)(ws + W_ROPE);
#pragma unroll
            for (int ai = 0; ai < 2; ++ai)
#pragma unroll
                for (int m = 0; m < 4; ++m) {
                    const int row = row0 + ai * 128 + m * 16;
                    const bool samp = row >= TP;
                    const int b = samp ? (row - TP) >> 4 : row >> 11, t = samp ? (row - TP) & 15 : row & 2047;
                    const int pi = samp ? 2048 + t : t;
#pragma unroll
                    for (int bj = 0; bj < 2; ++bj)
#pragma unroll
                        for (int n = 0; n < 2; ++n) {
                            f32x4 v = acc[ai][bj][m][n];
                            const int ct = bj * 128 + ct0 + n * 16;
                            const bool isv = (pn == 2) && (bj == 1);
                            if (!isv && n == 0 && (wc & 1) == 0) {
                                f32x4 o;
                                o[0] = __shfl_xor(v[0], 32); o[1] = __shfl_xor(v[1], 32); o[2] = __shfl_xor(v[2], 32); o[3] = __shfl_xor(v[3], 32);
                                const f32x4* cs = (const f32x4*)(rope + pi * 8 + 4 * (fq & 1));
                                const f32x4 c01 = cs[0], c23 = cs[1];
                                const float sgn = (fq < 2) ? -1.f : 1.f;
                                v[0] = v[0] * c01[0] + sgn * o[0] * c01[1];
                                v[1] = v[1] * c01[2] + sgn * o[1] * c01[3];
                                v[2] = v[2] * c23[0] + sgn * o[2] * c23[1];
                                v[3] = v[3] * c23[2] + sgn * o[3] * c23[3];
                            }
                            u32x2 pk; pk.x = pk2(v[0], v[1]); pk.y = pk2(v[2], v[3]);
                            if (pn < 2) { *(u32x2*)(Qb + (size_t)row * 512 + pn * 256 + ct) = pk; }
                            else {
                                const int c = ct & 127;
                                bf16_t* dst = isv ? Vb : Kb;
                                *(u32x2*)(dst + (size_t)row * 128 + c) = pk;
                                if (samp) {
                                    float* o = p->out + (isv ? O_VS : O_KS) + ((size_t)(l * 32 + b) * 16 + t) * 128 + c;
                                    *(f32x4*)o = v;
                                } else if (t >= 1920) {
                                    float* o = p->out + (isv ? O_VP : O_KP) + ((size_t)(l * 8 + b) * 128 + (t - 1920)) * 128 + c;
                                    *(f32x4*)o = v;
                                }
                            }
                        }
                }
        } else if (pn < 7) {
            bf16_t* Zb = (bf16_t*)(ws + W_Z);
#pragma unroll
            for (int ai = 0; ai < 2; ++ai)
#pragma unroll
                for (int m = 0; m < 4; ++m) {
                    const int row = row0 + ai * 128 + m * 16;
#pragma unroll
                    for (int bj = 0; bj < 2; ++bj)
#pragma unroll
                        for (int n = 0; n < 2; ++n) {
                            const f32x4 v = acc[ai][bj][m][n];
                            u32x2 pk; pk.x = pk2(v[0], v[1]); pk.y = pk2(v[2], v[3]);
                            *(u32x2*)(Zb + (size_t)row * 1024 + (pn - 3) * 256 + bj * 128 + ct0 + n * 16) = pk;
                        }
                }
        } else if (pn < 13) {
            bf16_t* Xb = (bf16_t*)(ws + W_XBC);
#pragma unroll
            for (int ai = 0; ai < 2; ++ai)
#pragma unroll
                for (int m = 0; m < 4; ++m) {
                    const int row = row0 + ai * 128 + m * 16;
                    const bool samp = row >= TP;
                    const int b = samp ? (row - TP) >> 4 : row >> 11, t = samp ? (row - TP) & 15 : row & 2047;
#pragma unroll
                    for (int bj = 0; bj < 2; ++bj)
#pragma unroll
                        for (int n = 0; n < 2; ++n) {
                            const f32x4 v = acc[ai][bj][m][n];
                            const int cc = (pn - 7) * 256 + bj * 128 + ct0 + n * 16;
                            u32x2 pk; pk.x = pk2(v[0], v[1]); pk.y = pk2(v[2], v[3]);
                            *(u32x2*)(Xb + (size_t)row * 1536 + cc) = pk;
                            if (samp) { if (t >= 13) *(f32x4*)(p->out + O_CS + ((size_t)(l * 32 + b) * 3 + (t - 13)) * 1536 + cc) = v; }
                            else if (t >= 2045) *(f32x4*)(p->out + O_CP + ((size_t)(l * 8 + b) * 3 + (t - 2045)) * 1536 + cc) = v;
                        }
                }
        } else if (pn < 17) {
            bf16_t* dst = (bf16_t*)(ws + (pn < 15 ? W_GU : W_GV));
            const int cb = ((pn - 13) & 1) * 256;
#pragma unroll
            for (int ai = 0; ai < 2; ++ai)
#pragma unroll
                for (int m = 0; m < 4; ++m) {
                    const int row = row0 + ai * 128 + m * 16;
#pragma unroll
                    for (int bj = 0; bj < 2; ++bj)
#pragma unroll
                        for (int n = 0; n < 2; ++n) {
                            const f32x4 v = acc[ai][bj][m][n];
                            u32x2 pk; pk.x = pk2(geluf_(v[0]), geluf_(v[1])); pk.y = pk2(geluf_(v[2]), geluf_(v[3]));
                            *(u32x2*)(dst + (size_t)row * 512 + cb + bj * 128 + ct0 + n * 16) = pk;
                        }
                }
        } else if (pn < 29) {
            unsigned char* G8 = ws + W_G8;
#pragma unroll
            for (int ai = 0; ai < 2; ++ai)
#pragma unroll
                for (int m = 0; m < 4; ++m) {
                    const int row = row0 + ai * 128 + m * 16;
#pragma unroll
                    for (int bj = 0; bj < 2; ++bj)
#pragma unroll
                        for (int n = 0; n < 2; ++n) {
                            const f32x4 v = acc[ai][bj][m][n];
                            const unsigned q0 = (unsigned)(sigm(v[0]) * 255.f + 0.5f), q1 = (unsigned)(sigm(v[1]) * 255.f + 0.5f);
                            const unsigned q2 = (unsigned)(sigm(v[2]) * 255.f + 0.5f), q3 = (unsigned)(sigm(v[3]) * 255.f + 0.5f);
                            *(unsigned*)(G8 + (size_t)row * 3072 + (pn - 17) * 256 + bj * 128 + ct0 + n * 16) = q0 | (q1 << 8) | (q2 << 16) | (q3 << 24);
                        }
                }
        } else {
            if (wc == 0) {
                float* DT = (float*)(ws + W_DT);
                const f32x4 bias = *(const f32x4*)(p->dt_bias + l * 16 + 4 * fq);
#pragma unroll
                for (int ai = 0; ai < 2; ++ai)
#pragma unroll
                    for (int m = 0; m < 4; ++m) {
                        const int row = row0 + ai * 128 + m * 16;
                        f32x4 v = acc[ai][0][m][0] + bias;
#pragma unroll
                        for (int e = 0; e < 4; ++e) { const float x = v[e]; v[e] = fmaxf(x, 0.f) + log1pf(__expf(-fabsf(x))); }
                        *(f32x4*)(DT + (size_t)row * 16 + 4 * fq) = v;
                    }
            }
        }
    }
};

struct FMerge {
    int b; const unsigned char* G8; const float* rowss; bf16_t* MG;
    struct Ld { unsigned g; float ss; u32x2 o; };
    __device__ __forceinline__ void load(int row, int col, Ld& d) const {
        d.g = *(const unsigned*)(G8 + (size_t)row * 3072 + b * 1024 + col);
        d.ss = (b == 1) ? rowss[row] : 0.f;
        d.o = (b > 0) ? *(const u32x2*)(MG + (size_t)row * 1024 + col) : (u32x2){0u, 0u};
    }
    __device__ __forceinline__ void apply(int row, int col, f32x4 v, const Ld& d) const {
        float sc = 1.f / 255.f;
        if (b == 1) sc *= rsqrtf(d.ss * (1.f / 1024.f) + EPSF);
        const unsigned g = d.g;
        f32x4 r;
        r[0] = (float)(g & 255u) * sc * v[0]; r[1] = (float)((g >> 8) & 255u) * sc * v[1];
        r[2] = (float)((g >> 16) & 255u) * sc * v[2]; r[3] = (float)(g >> 24) * sc * v[3];
        if (b > 0) { r[0] += bflo(d.o.x); r[1] += bfhi(d.o.x); r[2] += bflo(d.o.y); r[3] += bfhi(d.o.y); }
        u32x2 pk; pk.x = pk2(r[0], r[1]); pk.y = pk2(r[2], r[3]);
        *(u32x2*)(MG + (size_t)row * 1024 + col) = pk;
    }
};
struct FResid {
    const float* srcP; const float* srcS; float* X; const float* modg;
    struct Ld { f32x4 x, g; };
    __device__ __forceinline__ void load(int row, int col, Ld& d) const {
        const float* s = row < TP ? srcP + (size_t)row * 1024 + col : srcS + (size_t)(row - TP) * 1024 + col;
        d.x = *(const f32x4*)s;
        d.g = *(const f32x4*)(modg + (size_t)mod_row(row) * 6144 + col);
    }
    __device__ __forceinline__ void apply(int row, int col, f32x4 v, const Ld& d) const {
        *(f32x4*)(X + (size_t)row * 1024 + col) = d.x + d.g * v;
    }
};
struct FRelu2 {
    bf16_t* FH;
    struct Ld { };
    __device__ __forceinline__ void load(int, int, Ld&) const {}
    __device__ __forceinline__ void apply(int row, int col, f32x4 v, const Ld&) const {
        f32x4 r; r[0] = fmaxf(v[0], 0.f); r[1] = fmaxf(v[1], 0.f); r[2] = fmaxf(v[2], 0.f); r[3] = fmaxf(v[3], 0.f);
        u32x2 pk; pk.x = pk2(r[0] * r[0], r[1] * r[1]); pk.y = pk2(r[2] * r[2], r[3] * r[3]);
        *(u32x2*)(FH + (size_t)row * 4096 + col) = pk;
    }
};

__device__ __forceinline__ void phase_mod(KP p, float* lds) {
    float* sc = lds;
    float* red = lds + 20480;
    float* MOD = (float*)(p->ws + W_MOD);
    const int tid = tid_();
    const int rh = blockIdx.x & 1;
    __syncthreads();
    for (int idx = tid; idx < 20480; idx += 512) {
        const int r = idx >> 10, k = idx & 1023, gr = rh * 20 + r;
        const float c = gr < 8 ? p->c_prompt[gr * 1024 + k] : p->c_sample[(gr - 8) * 1024 + k];
        sc[k * 20 + r] = siluf_(c);
    }
    __syncthreads();
    for (int pi = blockIdx.x >> 1; pi < 384; pi += gridDim.x >> 1) {
        const int l = pi / 192, cgp = pi % 192;
        const int cn = tid & 31, ks = tid >> 5, n = cgp * 32 + cn;
        float acc[20];
#pragma unroll
        for (int r = 0; r < 20; ++r) acc[r] = 0.f;
        const float* w = p->w_ada + (size_t)l * 1024 * 6144 + n + (size_t)ks * 64 * 6144;
#pragma unroll 1
        for (int kb = 0; kb < 64; kb += 16) {
            float wv[16];
#pragma unroll
            for (int i = 0; i < 16; ++i) wv[i] = w[(size_t)(kb + i) * 6144];
#pragma unroll
            for (int i = 0; i < 16; ++i) {
                const f32x4* s4 = (const f32x4*)(sc + (ks * 64 + kb + i) * 20);
#pragma unroll
                for (int q = 0; q < 5; ++q) { const f32x4 s = s4[q]; acc[4 * q] += s[0] * wv[i]; acc[4 * q + 1] += s[1] * wv[i]; acc[4 * q + 2] += s[2] * wv[i]; acc[4 * q + 3] += s[3] * wv[i]; }
            }
        }
#pragma unroll
        for (int r = 0; r < 20; ++r) red[(ks * 20 + r) * 32 + cn] = acc[r];
        __syncthreads();
        for (int idx = tid; idx < 640; idx += 512) {
            const int r = idx >> 5, c2 = idx & 31, n2 = cgp * 32 + c2;
            float s = 0.f;
#pragma unroll
            for (int k16 = 0; k16 < 16; ++k16) s += red[(k16 * 20 + r) * 32 + c2];
            MOD[((size_t)l * 40 + rh * 20 + r) * 6144 + n2] = s + p->b_ada[l * 6144 + n2];
        }
        __syncthreads();
    }
}

struct CvtTile { const float* src; bf16_t* dst; int K, Ns, mode, n0, k0; };
__device__ __forceinline__ CvtTile cvt_tile(KP p, int l, int it) {
    bf16_t* WT = (bf16_t*)(p->ws + W_WT);
    CvtTile c; int nT; int r = it; c.mode = 0;
    if (r < 1920) { c.src = p->w_in + (size_t)l * 1024 * 7440; c.K = 1024; c.Ns = 7440; nT = 120; c.dst = WT + WT_IN; c.mode = 1; }
    else if ((r -= 1920) < 128) { c.src = p->w_attn_o + (size_t)l * 512 * 1024; c.K = 512; c.Ns = 1024; nT = 16; c.dst = WT + WT_AO; }
    else if ((r -= 128) < 256) { c.src = p->w_ssm_o + (size_t)l * 1024 * 1024; c.K = 1024; c.Ns = 1024; nT = 16; c.dst = WT + WT_SO; c.mode = 2; }
    else if ((r -= 256) < 128) { c.src = p->w_gm_o + (size_t)l * 512 * 1024; c.K = 512; c.Ns = 1024; nT = 16; c.dst = WT + WT_GO; }
    else if ((r -= 128) < 256) { c.src = p->w_out + (size_t)l * 1024 * 1024; c.K = 1024; c.Ns = 1024; nT = 16; c.dst = WT + WT_OUT; }
    else if ((r -= 256) < 1024) { c.src = p->w_ff1 + (size_t)l * 1024 * 4096; c.K = 1024; c.Ns = 4096; nT = 64; c.dst = WT + WT_F1; }
    else { r -= 1024; c.src = p->w_ff2 + (size_t)l * 4096 * 1024; c.K = 4096; c.Ns = 1024; nT = 16; c.dst = WT + WT_F2; }
    c.n0 = (r % nT) * 64; c.k0 = (r / nT) * 64;
    return c;
}
__device__ __forceinline__ void convert_weights(KP p, int l, float* tiles) {
    const int tid = tid_();
    for (int it = blockIdx.x * 2; it < 4736; it += gridDim.x * 2) {
        CvtTile c[2] = {cvt_tile(p, l, it), cvt_tile(p, l, it + 1 < 4736 ? it + 1 : it)};
        __syncthreads();
        float v[2][8];
#pragma unroll
        for (int h = 0; h < 2; ++h) {
            const int nn = tid & 63, ns = c[h].n0 + nn; int sc_ = ns; bool zero = false;
            if (c[h].mode == 1) { if (ns < 3328) sc_ = ns; else if (ns < 7424) sc_ = ns + 16; else if (ns < 7440) sc_ = ns - 7424 + 3328; else { zero = true; sc_ = 0; } }
#pragma unroll
            for (int i = 0; i < 8; ++i) {
                const int kk = (tid >> 6) + 8 * i;
                v[h][i] = zero ? 0.f : c[h].src[(size_t)(c[h].k0 + kk) * c[h].Ns + sc_];
            }
        }
#pragma unroll
        for (int h = 0; h < 2; ++h)
#pragma unroll
            for (int i = 0; i < 8; ++i) {
                const int kk = (tid >> 6) + 8 * i;
                float x = v[h][i];
                if (c[h].mode == 2) x *= p->ssm_norm_w[l * 1024 + c[h].k0 + kk];
                tiles[h * 4224 + kk * 65 + (tid & 63)] = x;
            }
        __syncthreads();
#pragma unroll
        for (int h = 0; h < 2; ++h) {
            if (h == 1 && it + 1 >= 4736) break;
            const float* tile = tiles + h * 4224;
            const int nr = tid >> 3, kc = (tid & 7) * 8;
            u32x4 o;
            o.x = pk2(tile[(kc + 0) * 65 + nr], tile[(kc + 1) * 65 + nr]);
            o.y = pk2(tile[(kc + 2) * 65 + nr], tile[(kc + 3) * 65 + nr]);
            o.z = pk2(tile[(kc + 4) * 65 + nr], tile[(kc + 5) * 65 + nr]);
            o.w = pk2(tile[(kc + 6) * 65 + nr], tile[(kc + 7) * 65 + nr]);
            *(u32x4*)(c[h].dst + (size_t)(c[h].n0 + nr) * c[h].K + c[h].k0 + kc) = o;
        }
    }
    __syncthreads();
}

__device__ __forceinline__ void phase_norm(KP p, int l, const float* srcP, const float* srcS, const float* gvec, int shift_idx) {
    const int tid = tid_(), lane = tid & 63, gw = blockIdx.x * 8 + (tid >> 6), ngw = gridDim.x * 8;
    const float* MOD = (const float*)(p->ws + W_MOD);
    bf16_t* H = (bf16_t*)(p->ws + W_H);
    f32x4 g[4];
#pragma unroll
    for (int j = 0; j < 4; ++j) g[j] = ((const f32x4*)gvec)[lane + 64 * j];
    f32x4 nx[4];
    {
        const int row = gw < T ? gw : T - 1;
        const float* xr = row < TP ? srcP + (size_t)row * 1024 : srcS + (size_t)(row - TP) * 1024;
#pragma unroll
        for (int j = 0; j < 4; ++j) nx[j] = ((const f32x4*)xr)[lane + 64 * j];
    }
    for (int row = gw; row < T; row += ngw) {
        f32x4 v[4];
#pragma unroll
        for (int j = 0; j < 4; ++j) v[j] = nx[j];
        {
            const int rn = row + ngw < T ? row + ngw : row;
            const float* xr = rn < TP ? srcP + (size_t)rn * 1024 : srcS + (size_t)(rn - TP) * 1024;
#pragma unroll
            for (int j = 0; j < 4; ++j) nx[j] = ((const f32x4*)xr)[lane + 64 * j];
        }
        const float* md = MOD + ((size_t)l * 40 + mod_row(row)) * 6144 + shift_idx * 1024;
        f32x4 sh[4], sc[4];
#pragma unroll
        for (int j = 0; j < 4; ++j) { sh[j] = ((const f32x4*)md)[lane + 64 * j]; sc[j] = ((const f32x4*)(md + 1024))[lane + 64 * j]; }
        float ss = 0.f;
#pragma unroll
        for (int j = 0; j < 4; ++j) ss += v[j][0] * v[j][0] + v[j][1] * v[j][1] + v[j][2] * v[j][2] + v[j][3] * v[j][3];
        ss = wave_sum(ss);
        const float rstd = rsqrtf(ss * (1.f / 1024.f) + EPSF);
#pragma unroll
        for (int j = 0; j < 4; ++j) {
            f32x4 h;
#pragma unroll
            for (int e = 0; e < 4; ++e) h[e] = (v[j][e] * rstd * g[j][e]) * (1.f + sc[j][e]) + sh[j][e];
            u32x2 pk; pk.x = pk2(h[0], h[1]); pk.y = pk2(h[2], h[3]);
            *(u32x2*)(H + (size_t)row * 1024 + (lane + 64 * j) * 4) = pk;
        }
    }
}

template <int NMT>
__device__ __forceinline__ void attn_load_q(const bf16_t* qo, int lane, bf16x8 (&qf)[NMT][2]) {
    const int fr = lane & 15, fq = lane >> 4;
#pragma unroll
    for (int mt = 0; mt < NMT; ++mt)
#pragma unroll
        for (int ks = 0; ks < 2; ++ks) qf[mt][ks] = *(const bf16x8*)(qo + (size_t)(mt * 16 + fr) * 512 + ks * 32 + fq * 8);
}
template <int NMT>
__device__ __forceinline__ void attn_compute(const bf16_t* Ks, const bf16_t* VT, bf16_t* qo, const bf16x8 (&qf)[NMT][2], int kt0, int kt1, int nkeys, float sink, int lane) {
    const int fr = lane & 15, fq = lane >> 4;
    f32x4 s[12][NMT];
#pragma unroll
    for (int kt = 0; kt < 12; ++kt) {
#pragma unroll
        for (int mt = 0; mt < NMT; ++mt) s[kt][mt] = (f32x4){0.f, 0.f, 0.f, 0.f};
        if (kt >= kt0 && kt < kt1) {
#pragma unroll
            for (int ks = 0; ks < 2; ++ks) {
                const bf16x8 kf = *(const bf16x8*)(Ks + (kt * 16 + fr) * 72 + ks * 32 + fq * 8);
#pragma unroll
                for (int mt = 0; mt < NMT; ++mt) s[kt][mt] = mfma16(kf, qf[mt][ks], s[kt][mt]);
            }
        }
    }
    float inv[NMT];
#pragma unroll
    for (int mt = 0; mt < NMT; ++mt) {
        float mx = -INFINITY;
#pragma unroll
        for (int kt = 0; kt < 12; ++kt)
            if (kt >= kt0 && kt < kt1) {
#pragma unroll
                for (int j = 0; j < 4; ++j) { const int key = kt * 16 + fq * 4 + j; const float v = key < nkeys ? s[kt][mt][j] * 0.125f : -INFINITY; s[kt][mt][j] = v; mx = fmaxf(mx, v); }
            }
        mx = fmaxf(mx, __shfl_xor(mx, 16)); mx = fmaxf(mx, __shfl_xor(mx, 32)); mx = fmaxf(mx, sink);
        float sum = 0.f;
#pragma unroll
        for (int kt = 0; kt < 12; ++kt)
            if (kt >= kt0 && kt < kt1) {
#pragma unroll
                for (int j = 0; j < 4; ++j) { const float e = __expf(s[kt][mt][j] - mx); s[kt][mt][j] = e; sum += e; }
            }
        sum += __shfl_xor(sum, 16); sum += __shfl_xor(sum, 32);
        inv[mt] = 1.f / (sum + __expf(sink - mx));
    }
    f32x4 o[4][NMT];
#pragma unroll
    for (int dt = 0; dt < 4; ++dt)
#pragma unroll
        for (int mt = 0; mt < NMT; ++mt) o[dt][mt] = (f32x4){0.f, 0.f, 0.f, 0.f};
#pragma unroll
    for (int kb = 0; kb < 6; ++kb) {
        if (2 * kb >= kt0 && 2 * kb < kt1) {
            bf16x8 pf[NMT];
#pragma unroll
            for (int mt = 0; mt < NMT; ++mt) {
                const f32x4 a = s[2 * kb][mt], b = s[2 * kb + 1][mt];
                u32x4 t; t.x = pk2(a[0], a[1]); t.y = pk2(a[2], a[3]); t.z = pk2(b[0], b[1]); t.w = pk2(b[2], b[3]);
                pf[mt] = __builtin_bit_cast(bf16x8, t);
            }
#pragma unroll
            for (int dt = 0; dt < 4; ++dt) {
                const u32x2 lo = *(const u32x2*)(VT + (dt * 16 + fr) * 200 + kb * 32 + fq * 4);
                const u32x2 hi = *(const u32x2*)(VT + (dt * 16 + fr) * 200 + kb * 32 + 16 + fq * 4);
                u32x4 t; t.x = lo.x; t.y = lo.y; t.z = hi.x; t.w = hi.y;
                const bf16x8 vf = __builtin_bit_cast(bf16x8, t);
#pragma unroll
                for (int mt = 0; mt < NMT; ++mt) o[dt][mt] = mfma16(vf, pf[mt], o[dt][mt]);
            }
        }
    }
#pragma unroll
    for (int mt = 0; mt < NMT; ++mt)
#pragma unroll
        for (int dt = 0; dt < 4; ++dt) {
            const f32x4 v = o[dt][mt] * inv[mt];
            u32x2 pk; pk.x = pk2(v[0], v[1]); pk.y = pk2(v[2], v[3]);
            *(u32x2*)(qo + (size_t)(mt * 16 + fr) * 512 + dt * 16 + fq * 4) = pk;
        }
}

__device__ __forceinline__ void scatter_vt(bf16_t* VT, int ch, int kk, u32x4 vv) {
    bf16_t* d = VT + (ch * 8) * 200 + kk;
    d[0 * 200] = (bf16_t)(vv.x & 0xffffu); d[1 * 200] = (bf16_t)(vv.x >> 16);
    d[2 * 200] = (bf16_t)(vv.y & 0xffffu); d[3 * 200] = (bf16_t)(vv.y >> 16);
    d[4 * 200] = (bf16_t)(vv.z & 0xffffu); d[5 * 200] = (bf16_t)(vv.z >> 16);
    d[6 * 200] = (bf16_t)(vv.w & 0xffffu); d[7 * 200] = (bf16_t)(vv.w >> 16);
}

__device__ __forceinline__ void attn_prompt_item(KP p, int l, int it, unsigned char* shm) {
    const int tid = tid_(), w = tid >> 6, lane = tid & 63;
    const int b = it >> 6, c = (it >> 1) & 31, kvh = it & 1;
    bf16_t* Ks = (bf16_t*)shm; bf16_t* VT = Ks + 192 * 72;
    bf16_t* Qb = (bf16_t*)(p->ws + W_Q); const bf16_t* Kb = (const bf16_t*)(p->ws + W_K); const bf16_t* Vb = (const bf16_t*)(p->ws + W_V);
    const int kt0 = c >= 2 ? 0 : (2 - c) * 4;
    const int g = w >> 1, q0 = (w & 1) * 32, hq = kvh * 4 + g;
    bf16_t* qo = Qb + ((size_t)b * 2048 + c * 64 + q0) * 512 + hq * 64;
    const float sink = p->sinks[l * 8 + hq];
    __syncthreads();
    {
        u32x4 kv[3], vv[3];
        bf16x8 qf[2][2];
#pragma unroll
        for (int it3 = 0; it3 < 3; ++it3) {
            const int idx = tid + it3 * 512, ch = idx / 192, kk = idx - ch * 192;
            const int kkc = kk >= kt0 * 16 ? kk : kt0 * 16;
            const size_t row = (size_t)b * 2048 + (c - 2) * 64 + kkc;
            kv[it3] = *(const u32x4*)(Kb + row * 128 + kvh * 64 + ch * 8);
            vv[it3] = *(const u32x4*)(Vb + row * 128 + kvh * 64 + ch * 8);
        }
        attn_load_q<2>(qo, lane, qf);
#pragma unroll
        for (int it3 = 0; it3 < 3; ++it3) {
            const int idx = tid + it3 * 512, ch = idx / 192, kk = idx - ch * 192;
            if (kk >= kt0 * 16) { *(u32x4*)(Ks + kk * 72 + ch * 8) = kv[it3]; scatter_vt(VT, ch, kk, vv[it3]); }
        }
        __syncthreads();
        attn_compute<2>(Ks, VT, qo, qf, kt0, 12, 192, sink, lane);
    }
}

__device__ __forceinline__ void attn_sample_item(KP p, int l, int it, unsigned char* shm) {
    const int tid = tid_(), w = tid >> 6, lane = tid & 63;
    const int sb = it >> 1, kvh = it & 1;
    bf16_t* Ks = (bf16_t*)shm; bf16_t* VT = Ks + 192 * 72;
    bf16_t* Qb = (bf16_t*)(p->ws + W_Q); const bf16_t* Kb = (const bf16_t*)(p->ws + W_K); const bf16_t* Vb = (const bf16_t*)(p->ws + W_V);
    __syncthreads();
    for (int idx = tid; idx < 160 * 8; idx += 512) {
        const int ch = idx / 160, kk = idx - ch * 160;
        u32x4 kv, vv;
        if (kk < 128) {
            const size_t o = ((((size_t)l * 32 + sb) * 128 + kk) * 2 + kvh) * 64 + ch * 8;
            const f32x4 k0 = *(const f32x4*)(p->cache_k + o), k1 = *(const f32x4*)(p->cache_k + o + 4);
            const f32x4 v0 = *(const f32x4*)(p->cache_v + o), v1 = *(const f32x4*)(p->cache_v + o + 4);
            kv.x = pk2(k0[0], k0[1]); kv.y = pk2(k0[2], k0[3]); kv.z = pk2(k1[0], k1[1]); kv.w = pk2(k1[2], k1[3]);
            vv.x = pk2(v0[0], v0[1]); vv.y = pk2(v0[2], v0[3]); vv.z = pk2(v1[0], v1[1]); vv.w = pk2(v1[2], v1[3]);
        } else if (kk < 144) {
            const size_t row = (size_t)TP + sb * 16 + (kk - 128);
            kv = *(const u32x4*)(Kb + row * 128 + kvh * 64 + ch * 8);
            vv = *(const u32x4*)(Vb + row * 128 + kvh * 64 + ch * 8);
        } else { kv = zero4(); vv = kv; }
        *(u32x4*)(Ks + kk * 72 + ch * 8) = kv;
        scatter_vt(VT, ch, kk, vv);
    }
    __syncthreads();
    if (w < 4) {
        const int hq = kvh * 4 + w;
        bf16_t* qo = Qb + ((size_t)TP + sb * 16) * 512 + hq * 64;
        bf16x8 qf[1][2];
        attn_load_q<1>(qo, lane, qf);
        attn_compute<1>(Ks, VT, qo, qf, 0, 10, 144, p->sinks[l * 8 + hq], lane);
    }
}

__device__ __forceinline__ void gmlp_item(KP p, int l, bool samp, int bi, int cidx, int g, unsigned char* shm) {
    const int tid = tid_(), w = tid >> 6, lane = tid & 63, fr = lane & 15, fq = lane >> 4;
    bf16_t* Wm = (bf16_t*)shm; bf16_t* VT = Wm + 128 * 136;
    const int L = samp ? 16 : 128;
    const int row0 = samp ? TP + bi * 16 : bi * 2048 + cidx * 128;
    bf16_t* GUb = (bf16_t*)(p->ws + W_GU); const bf16_t* GVb = (const bf16_t*)(p->ws + W_GV);
    __syncthreads();
    if (samp) {
        { const int idx = tid * 8, d = idx >> 5, s = idx & 31; *(u32x4*)(VT + d * 136 + s) = zero4(); }
        if (tid < 128) {
            const int t = tid >> 3, s4 = (tid & 7) * 4;
            f32x4 wv = (f32x4){0.f, 0.f, 0.f, 0.f};
            if (s4 < 16) wv = *(const f32x4*)(p->gm_w_s + ((size_t)(l * 4 + g) * 128 + t) * 128 + s4);
#pragma unroll
            for (int e = 0; e < 4; ++e) if (s4 + e > t) wv[e] = 0.f;
            u32x2 pk; pk.x = pk2(wv[0], wv[1]); pk.y = pk2(wv[2], wv[3]);
            *(u32x2*)(Wm + t * 136 + s4) = pk;
        }
        __syncthreads();
    }
    if (!samp) {
        const int r = tid >> 2, q = tid & 3;
        const bf16_t* src = GVb + (size_t)(row0 + r) * 512 + q * 128;
        u32x4 rv[16];
#pragma unroll
        for (int k = 0; k < 16; ++k) rv[k] = *(const u32x4*)(src + k * 8);
        float s = 0.f, s2 = 0.f;
#pragma unroll
        for (int k = 0; k < 16; ++k) {
            const float a0 = bflo(rv[k].x), a1 = bfhi(rv[k].x), a2 = bflo(rv[k].y), a3 = bfhi(rv[k].y), a4 = bflo(rv[k].z), a5 = bfhi(rv[k].z), a6 = bflo(rv[k].w), a7 = bfhi(rv[k].w);
            s += ((a0 + a1) + (a2 + a3)) + ((a4 + a5) + (a6 + a7));
            s2 += ((a0 * a0 + a1 * a1) + (a2 * a2 + a3 * a3)) + ((a4 * a4 + a5 * a5) + (a6 * a6 + a7 * a7));
        }
        s += __shfl_xor(s, 1); s += __shfl_xor(s, 2); s2 += __shfl_xor(s2, 1); s2 += __shfl_xor(s2, 2);
        float* lgs = (float*)(VT + 128 * 136);
        if (q == 0) {
            const float mean = s * (1.f / 512.f);
            lgs[256 + 2 * r] = mean; lgs[257 + 2 * r] = rsqrtf(fmaxf(s2 * (1.f / 512.f) - mean * mean, 0.f) + EPSF);
        }
        if (tid < 128) lgs[tid] = p->gm_ln_g[l * 512 + g * 128 + tid]; else if (tid < 256) lgs[tid] = p->gm_ln_b[l * 512 + g * 128 + tid - 128];
        const int r2 = tid & 127, dq = tid >> 7;
        u32x4 xv[4];
#pragma unroll
        for (int k = 0; k < 4; ++k) xv[k] = *(const u32x4*)(GVb + (size_t)(row0 + r2) * 512 + g * 128 + dq * 32 + k * 8);
        __syncthreads();
        {
            const float mean = lgs[256 + 2 * r2], rstd = lgs[257 + 2 * r2];
#pragma unroll
            for (int k = 0; k < 4; ++k) {
                const unsigned uu[4] = {xv[k].x, xv[k].y, xv[k].z, xv[k].w};
                const f32x4 g0 = *(const f32x4*)(lgs + dq * 32 + k * 8), g1 = *(const f32x4*)(lgs + dq * 32 + k * 8 + 4);
                const f32x4 b0 = *(const f32x4*)(lgs + 128 + dq * 32 + k * 8), b1 = *(const f32x4*)(lgs + 128 + dq * 32 + k * 8 + 4);
#pragma unroll
                for (int e = 0; e < 8; ++e) {
                    const float v = (e & 1) ? bfhi(uu[e >> 1]) : bflo(uu[e >> 1]);
                    const float gg = e < 4 ? g0[e & 3] : g1[e & 3], bb = e < 4 ? b0[e & 3] : b1[e & 3];
                    VT[(dq * 32 + k * 8 + e) * 136 + r2] = f2bf((v - mean) * rstd * gg + bb);
                }
            }
        }
        {
            f32x4 wv[8];
#pragma unroll
            for (int q = 0; q < 8; ++q) { const int idx = tid + q * 512; wv[q] = *(const f32x4*)(p->gm_w_s + ((size_t)(l * 4 + g) * 128 + (idx >> 5)) * 128 + (idx & 31) * 4); }
#pragma unroll
            for (int q = 0; q < 8; ++q) {
                const int idx = tid + q * 512, t = idx >> 5, s4 = (idx & 31) * 4;
#pragma unroll
                for (int e = 0; e < 4; ++e) if (s4 + e > t) wv[q][e] = 0.f;
                u32x2 pk; pk.x = pk2(wv[q][0], wv[q][1]); pk.y = pk2(wv[q][2], wv[q][3]);
                *(u32x2*)(Wm + t * 136 + s4) = pk;
            }
        }
    } else if (w == 0) {
        u32x4 rawv[16];
#pragma unroll
        for (int r = 0; r < 16; ++r) rawv[r] = *(const u32x4*)(GVb + (size_t)(row0 + r) * 512 + lane * 8);
#pragma unroll
        for (int r = 0; r < 16; ++r) {
            const u32x4 raw = rawv[r];
            float v[8];
            v[0] = bflo(raw.x); v[1] = bfhi(raw.x); v[2] = bflo(raw.y); v[3] = bfhi(raw.y); v[4] = bflo(raw.z); v[5] = bfhi(raw.z); v[6] = bflo(raw.w); v[7] = bfhi(raw.w);
            float s = 0.f;
#pragma unroll
            for (int e = 0; e < 8; ++e) s += v[e];
            const float mean = wave_sum(s) * (1.f / 512.f);
            float s2 = 0.f;
#pragma unroll
            for (int e = 0; e < 8; ++e) { v[e] -= mean; s2 += v[e] * v[e]; }
            const float rstd = rsqrtf(wave_sum(s2) * (1.f / 512.f) + EPSF);
            if (fq == g) {
#pragma unroll
                for (int e = 0; e < 8; ++e) {
                    const int d = fr * 8 + e, col = g * 128 + d;
                    const float vn = v[e] * rstd * p->gm_ln_g[l * 512 + col] + p->gm_ln_b[l * 512 + col];
                    VT[d * 136 + r] = f2bf(vn);
                    p->out[O_GS + ((size_t)(l * 32 + bi) * 16 + r) * 512 + col] = vn;
                }
            }
        }
    }
    bf16_t uv[4][8];
    if (w * 16 < L) {
#pragma unroll
        for (int j = 0; j < 4; ++j)
#pragma unroll
            for (int dt = 0; dt < 8; ++dt) uv[j][dt] = GUb[(size_t)(row0 + w * 16 + fq * 4 + j) * 512 + g * 128 + dt * 16 + fr];
    }
    __syncthreads();
    if (w * 16 < L) {
        f32x4 acc[8];
#pragma unroll
        for (int dt = 0; dt < 8; ++dt) acc[dt] = (f32x4){0.f, 0.f, 0.f, 0.f};
        const int nks = samp ? 1 : ((w * 16 + 15) >> 5) + 1;
#pragma unroll
        for (int ks = 0; ks < 4; ++ks) {
            if (ks < nks) {
                const bf16x8 wf = *(const bf16x8*)(Wm + (w * 16 + fr) * 136 + ks * 32 + fq * 8);
#pragma unroll
                for (int dt = 0; dt < 8; ++dt) {
                    const bf16x8 vf = *(const bf16x8*)(VT + (dt * 16 + fr) * 136 + ks * 32 + fq * 8);
                    acc[dt] = mfma16(wf, vf, acc[dt]);
                }
            }
        }
#pragma unroll
        for (int j = 0; j < 4; ++j) {
            const int t = w * 16 + fq * 4 + j;
            const float bias = p->gm_b_s[(l * 4 + g) * 128 + t];
#pragma unroll
            for (int dt = 0; dt < 8; ++dt) {
                const size_t idx = (size_t)(row0 + t) * 512 + g * 128 + dt * 16 + fr;
                GUb[idx] = f2bf(bf2f(uv[j][dt]) * (acc[dt][j] + bias));
            }
        }
    }
}

constexpr size_t XT_SAMP = (size_t)256 * 1024 * 64, BT_SAMP = (size_t)256 * 256 * 64;
__device__ __forceinline__ void conv_prepass(KP p, int l, unsigned char* shm) {
    const int tid = tid_();
    bf16_t* R = (bf16_t*)shm;
    bf16_t* An = R + 67 * 264;
    bf16_t* At = An + 64 * 264;
    unsigned char* ws = p->ws;
    const bf16_t* Xb = (const bf16_t*)(ws + W_XBC);
    bf16_t* XT = (bf16_t*)(ws + W_H); bf16_t* BCN = (bf16_t*)(ws + W_BCN); bf16_t* BTg = (bf16_t*)(ws + W_BT);
    for (int it = blockIdx.x; it < 288 * 6; it += gridDim.x) {
        const int cidx = it / 6, slab = it - cidx * 6;
        const bool samp = cidx >= 256; const int sb = cidx - 256;
        const int row0 = samp ? TP + sb * 16 : cidx * 64, Lv = samp ? 16 : 64, c0 = slab * 256;
        __syncthreads();
        {
            u32x4 v[5];
#pragma unroll
            for (int q = 0; q < 5; ++q) {
                const int idx = tid + q * 512, r = idx >> 5, ck = idx & 31, rr = r - 3;
                v[q] = zero4();
                if (idx < (Lv + 3) * 32) {
                    if (rr >= 0 || (!samp && (cidx & 31) > 0)) v[q] = *(const u32x4*)(Xb + (size_t)(row0 + rr) * 1536 + c0 + ck * 8);
                    else if (samp) {
                        const float* sp = p->state_conv + (((size_t)l * 32 + sb) * 3 + (3 + rr)) * 1536 + c0 + ck * 8;
                        const f32x4 a = *(const f32x4*)sp, b = *(const f32x4*)(sp + 4);
                        v[q].x = pk2(a[0], a[1]); v[q].y = pk2(a[2], a[3]); v[q].z = pk2(b[0], b[1]); v[q].w = pk2(b[2], b[3]);
                    }
                }
            }
#pragma unroll
            for (int q = 0; q < 5; ++q) {
                const int idx = tid + q * 512;
                if (idx < (Lv + 3) * 32) *(u32x4*)(R + (idx >> 5) * 264 + (idx & 31) * 8) = v[q];
            }
        }
        __syncthreads();
        {
            const int j = tid & 255, tq = tid >> 8;
            if (tq * 32 < Lv) {
                const float w0 = p->conv_w[(l * 4 + 0) * 1536 + c0 + j], w1 = p->conv_w[(l * 4 + 1) * 1536 + c0 + j];
                const float w2 = p->conv_w[(l * 4 + 2) * 1536 + c0 + j], w3 = p->conv_w[(l * 4 + 3) * 1536 + c0 + j], cb = p->conv_b[l * 1536 + c0 + j];
                float x0 = bf2f(R[(tq * 32 + 0) * 264 + j]), x1 = bf2f(R[(tq * 32 + 1) * 264 + j]), x2 = bf2f(R[(tq * 32 + 2) * 264 + j]);
#pragma unroll
                for (int e = 0; e < 32; e += 2) {
                    const int t = tq * 32 + e;
                    if (t < Lv) {
                        const float x3 = bf2f(R[(t + 3) * 264 + j]), x4 = bf2f(R[(t + 4) * 264 + j]);
                        const float o0 = siluf_(cb + w0 * x0 + w1 * x1 + w2 * x2 + w3 * x3);
                        const float o1 = siluf_(cb + w0 * x1 + w1 * x2 + w2 * x3 + w3 * x4);
                        x0 = x2; x1 = x3; x2 = x4;
                        const unsigned pk = pk2(o0, o1);
                        An[t * 264 + j] = (bf16_t)(pk & 0xffffu); An[(t + 1) * 264 + j] = (bf16_t)(pk >> 16);
                        *(unsigned*)(At + j * 66 + t) = pk;
                    }
                }
            }
        }
        __syncthreads();
        if (slab >= 4) {
            for (int idx = tid; idx < Lv * 32; idx += 512) {
                const int t = idx >> 5, ck = idx & 31;
                *(u32x4*)(BCN + (size_t)(row0 + t) * 512 + (slab - 4) * 256 + ck * 8) = *(const u32x4*)(An + t * 264 + ck * 8);
            }
        }
        if (slab < 5) {
            const int sh = samp ? 1 : 3;
            bf16_t* dst;
            if (slab < 4) dst = samp ? XT + XT_SAMP + ((size_t)sb * 1024 + slab * 256) * 16 : XT + ((size_t)cidx * 1024 + slab * 256) * 64;
            else dst = samp ? BTg + BT_SAMP + (size_t)sb * 256 * 16 : BTg + (size_t)cidx * 256 * 64;
            for (int idx = tid; idx < (256 << sh); idx += 512) {
                const int j = idx >> sh, tc = idx & ((1 << sh) - 1);
                const unsigned* src = (const unsigned*)(At + j * 66 + tc * 8);
                u32x4 v; v.x = src[0]; v.y = src[1]; v.z = src[2]; v.w = src[3];
                *(u32x4*)(dst + (size_t)j * Lv + tc * 8) = v;
            }
        }
    }
    __syncthreads();
}

__device__ __forceinline__ void ssd_item(KP p, int l, bool samp, int bi, int h, unsigned char* shm) {
    const int tid = tid_(), w = tid >> 6, lane = tid & 63, fr = lane & 15, fq = lane >> 4;
    bf16_t* xT = (bf16_t*)shm;
    bf16_t* xwT = xT + 64 * 72;
    bf16_t* Bs = xwT + 64 * 72;
    bf16_t* BT = Bs + 64 * 136;
    bf16_t* Cs = BT + 128 * 72;
    bf16_t* Ms = Cs + 64 * 136;
    bf16_t* hb = Ms + 64 * 72;
    float* cumv = (float*)(hb + 64 * 136);
    float* dtv = cumv + 64;
    float* scl = dtv + 64;
    const int gr = h >> 3, nch = samp ? 1 : 32, Lv = samp ? 16 : 64;
    const int rowbase = samp ? TP + bi * 16 : bi * 2048;
    const float a_h = -__expf(p->a_log[l * 16 + h]), Dh = p->d_skip[l * 16 + h];
    unsigned char* ws = p->ws;
    const float* DT = (const float*)(ws + W_DT);
    const bf16_t* XTg = (const bf16_t*)(ws + W_H); const bf16_t* BCN = (const bf16_t*)(ws + W_BCN); const bf16_t* BTg = (const bf16_t*)(ws + W_BT);
    bf16_t* Zb = (bf16_t*)(ws + W_Z);
    float* ROWSS = (float*)(ws + W_ROWSS);
    const int pts = w >> 1, nt0 = (w & 1) * 4;
    f32x4 hacc[4];
    float* stout = samp ? p->out + O_SS + (((size_t)l * 32 + bi) * 16 + h) * 8192 : p->out + O_SP + (((size_t)l * 8 + bi) * 16 + h) * 8192;
    __syncthreads();
#pragma unroll
    for (int i = 0; i < 4; ++i) {
#pragma unroll
        for (int j = 0; j < 4; ++j) {
            const int pr = pts * 16 + fq * 4 + j, n = (nt0 + i) * 16 + fr;
            float v = 0.f;
            if (samp) v = p->state_ssm[((((size_t)l * 32 + bi) * 16 + h) * 64 + pr) * 128 + n];
            hacc[i][j] = v;
            hb[pr * 136 + n] = f2bf(v);
        }
    }
    const int ttile = w >> 1, half = w & 1;
    const int xp = tid >> 3, xc = tid & 7;

    u32x4 lx, lb[2], lc[2], lbt[2];
    float dcur = 0.f;
    auto load_ops = [&](int chx) {
        const int t0x = rowbase + chx * 64;
        lx = zero4();
        if (!samp) {
            const size_t cidx = (size_t)bi * 32 + chx;
            lx = *(const u32x4*)(XTg + (cidx * 1024 + h * 64 + xp) * 64 + xc * 8);
#pragma unroll
            for (int q = 0; q < 2; ++q) {
                const int idx = tid + q * 512;
                const bf16_t* rowp = BCN + (size_t)(t0x + (idx >> 4)) * 512 + gr * 128 + (idx & 15) * 8;
                lb[q] = *(const u32x4*)rowp; lc[q] = *(const u32x4*)(rowp + 256);
                lbt[q] = *(const u32x4*)(BTg + (cidx * 256 + gr * 128 + (idx >> 3)) * 64 + (idx & 7) * 8);
            }
        } else {
            if (xc < 2) lx = *(const u32x4*)(XTg + XT_SAMP + ((size_t)bi * 1024 + h * 64 + xp) * 16 + xc * 8);
#pragma unroll
            for (int q = 0; q < 2; ++q) {
                const int idx = tid + q * 512;
                lb[q] = zero4(); lc[q] = lb[q]; lbt[q] = lb[q];
                if ((idx >> 4) < 16) {
                    const bf16_t* rowp = BCN + (size_t)(t0x + (idx >> 4)) * 512 + gr * 128 + (idx & 15) * 8;
                    lb[q] = *(const u32x4*)rowp; lc[q] = *(const u32x4*)(rowp + 256);
                }
                if ((idx & 7) < 2) lbt[q] = *(const u32x4*)(BTg + BT_SAMP + ((size_t)bi * 256 + gr * 128 + (idx >> 3)) * 16 + (idx & 7) * 8);
            }
        }
        dcur = 0.f;
        if (w == 0 && lane < Lv) dcur = DT[(size_t)(t0x + lane) * 16 + h];
    };
    load_ops(0);

    for (int ch = 0; ch < nch; ++ch) {
        const int t0 = rowbase + ch * 64;
        bf16_t zr[8];
#pragma unroll
        for (int j = 0; j < 4; ++j)
#pragma unroll
            for (int i = 0; i < 2; ++i) {
                int t = ttile * 16 + fq * 4 + j; t = t < Lv ? t : Lv - 1;
                zr[j * 2 + i] = Zb[(size_t)(t0 + t) * 1024 + h * 64 + (half * 2 + i) * 16 + fr];
            }
        __syncthreads();
        if (w == 0) {
            const float c = wave_scan(dcur * a_h);
            const float c63 = __int_as_float(__builtin_amdgcn_readlane(__float_as_int(c), 63));
            cumv[lane] = c; dtv[lane] = dcur; scl[lane] = dcur * __expf(c63 - c);
        }
        *(u32x4*)(xT + xp * 72 + xc * 8) = lx;
#pragma unroll
        for (int q = 0; q < 2; ++q) {
            const int idx = tid + q * 512;
            *(u32x4*)(Bs + (idx >> 4) * 136 + (idx & 15) * 8) = lb[q];
            *(u32x4*)(Cs + (idx >> 4) * 136 + (idx & 15) * 8) = lc[q];
            *(u32x4*)(BT + (idx >> 3) * 72 + (idx & 7) * 8) = lbt[q];
        }
        __syncthreads();
        {
            const f32x4 s0 = *(const f32x4*)(scl + xc * 8), s1 = *(const f32x4*)(scl + xc * 8 + 4);
            u32x4 o;
            o.x = pk2(bflo(lx.x) * s0[0], bfhi(lx.x) * s0[1]); o.y = pk2(bflo(lx.y) * s0[2], bfhi(lx.y) * s0[3]);
            o.z = pk2(bflo(lx.z) * s1[0], bfhi(lx.z) * s1[1]); o.w = pk2(bflo(lx.w) * s1[2], bfhi(lx.w) * s1[3]);
            *(u32x4*)(xwT + xp * 72 + xc * 8) = o;
        }
        if (ch + 1 < nch) load_ops(ch + 1);
        f32x4 cb[2], yacc[2];
#pragma unroll
        for (int i = 0; i < 2; ++i) { cb[i] = (f32x4){0.f, 0.f, 0.f, 0.f}; yacc[i] = (f32x4){0.f, 0.f, 0.f, 0.f}; }
#pragma unroll
        for (int ks = 0; ks < 4; ++ks) {
            const bf16x8 cf = *(const bf16x8*)(Cs + (ttile * 16 + fr) * 136 + ks * 32 + fq * 8);
#pragma unroll
            for (int i = 0; i < 2; ++i) {
                const bf16x8 bfr = *(const bf16x8*)(Bs + ((half * 2 + i) * 16 + fr) * 136 + ks * 32 + fq * 8);
                cb[i] = mfma16(cf, bfr, cb[i]);
                const bf16x8 hf = *(const bf16x8*)(hb + ((half * 2 + i) * 16 + fr) * 136 + ks * 32 + fq * 8);
                yacc[i] = mfma16(cf, hf, yacc[i]);
            }
        }
#pragma unroll
        for (int j = 0; j < 4; ++j) {
            const int t = ttile * 16 + fq * 4 + j;
            const float ct = cumv[t];
            const float et = __expf(ct);
#pragma unroll
            for (int i = 0; i < 2; ++i) {
                const int s = (half * 2 + i) * 16 + fr;
                const float mv = (s <= t) ? cb[i][j] * __expf(ct - cumv[s]) * dtv[s] : 0.f;
                Ms[t * 72 + s] = f2bf(mv);
                yacc[i][j] *= et;
            }
        }
        __syncthreads();
#pragma unroll
        for (int ks = 0; ks < 2; ++ks) {
            const bf16x8 mf = *(const bf16x8*)(Ms + (ttile * 16 + fr) * 72 + ks * 32 + fq * 8);
#pragma unroll
            for (int i = 0; i < 2; ++i) {
                const bf16x8 xf = *(const bf16x8*)(xT + ((half * 2 + i) * 16 + fr) * 72 + ks * 32 + fq * 8);
                yacc[i] = mfma16(mf, xf, yacc[i]);
            }
        }
        {
            float ssq[4] = {0.f, 0.f, 0.f, 0.f};
#pragma unroll
            for (int j = 0; j < 4; ++j) {
                const int t = ttile * 16 + fq * 4 + j;
                if (!samp || t < Lv) {
#pragma unroll
                    for (int i = 0; i < 2; ++i) {
                        const int pc = (half * 2 + i) * 16 + fr;
                        const float xv = bf2f(xT[pc * 72 + t]);
                        const float y = yacc[i][j] + Dh * xv;
                        const size_t zi = (size_t)(t0 + t) * 1024 + h * 64 + pc;
                        const float uu = y * siluf_(bf2f(zr[j * 2 + i]));
                        Zb[zi] = f2bf(uu);
                        ssq[j] += uu * uu;
                    }
                }
            }
#pragma unroll
            for (int j = 0; j < 4; ++j) {
                const float s = row16_sum(ssq[j]);
                const int t = ttile * 16 + fq * 4 + j;
                if (fr == 0 && (!samp || t < Lv)) atomicAdd(ROWSS + t0 + t, s);
            }
        }
        const float dec = __expf(cumv[63]);
#pragma unroll
        for (int i = 0; i < 4; ++i) hacc[i] *= dec;
#pragma unroll
        for (int ks = 0; ks < 2; ++ks) {
            const bf16x8 xf = *(const bf16x8*)(xwT + (pts * 16 + fr) * 72 + ks * 32 + fq * 8);
#pragma unroll
            for (int i = 0; i < 4; ++i) {
                const bf16x8 bfr = *(const bf16x8*)(BT + ((nt0 + i) * 16 + fr) * 72 + ks * 32 + fq * 8);
                hacc[i] = mfma16(xf, bfr, hacc[i]);
            }
        }
#pragma unroll
        for (int i = 0; i < 4; ++i)
#pragma unroll
            for (int j = 0; j < 4; ++j) hb[(pts * 16 + fq * 4 + j) * 136 + (nt0 + i) * 16 + fr] = f2bf(hacc[i][j]);
    }
#pragma unroll
    for (int i = 0; i < 4; ++i)
#pragma unroll
        for (int j = 0; j < 4; ++j) stout[(pts * 16 + fq * 4 + j) * 128 + (nt0 + i) * 16 + fr] = hacc[i][j];
}

constexpr int N_OTHER = 512 + 512 + 512 + 64 + 128;
__device__ __forceinline__ void phase_mixers(int l, unsigned char* shm) {
    int* s_item = (int*)(shm + 131072);
    for (int it = blockIdx.x; it < 128; it += gridDim.x) ssd_item(kparams(), l, false, it >> 4, it & 15, shm);
    unsigned nxt_ticket = 0u;
    if (threadIdx.x == 0) nxt_ticket = atomicAdd((unsigned*)(kparams()->ws + W_CNT) + l, 1u);
    for (;;) {
        __syncthreads();
        if (threadIdx.x == 0) *s_item = (int)nxt_ticket;
        __syncthreads();
        int j = *s_item;
        if (j >= N_OTHER) break;
        const KP p = kparams();
        if (threadIdx.x == 0) nxt_ticket = atomicAdd((unsigned*)(p->ws + W_CNT) + l, 1u);
        if (j < 512) { attn_prompt_item(p, l, j, shm); continue; } j -= 512;
        if (j < 512) { gmlp_item(p, l, false, j >> 6, (j >> 2) & 15, j & 3, shm); continue; } j -= 512;
        if (j < 512) { ssd_item(p, l, true, j >> 4, j & 15, shm); continue; } j -= 512;
        if (j < 64) { attn_sample_item(p, l, j, shm); continue; } j -= 64;
        gmlp_item(p, l, true, j >> 2, 0, j & 3, shm);
    }
}

#define XB_TMO      128
#define XB_XCNT(j)  (256  + 64 * (j))
#define XB_XSUB(j)  (1280 + 64 * (j))
#define XB_XGEN(j)  (2304 + 64 * (j))
#define XB_TOP      3328
#define XB_TOPGEN   3392
#define XCD_BAR_WORDS 3456
#define XB_SPIN_CAP (1u << 18)
__device__ __forceinline__ unsigned xb_ld(unsigned* p)              { return __hip_atomic_load(p, __ATOMIC_RELAXED, __HIP_MEMORY_SCOPE_AGENT); }
__device__ __forceinline__ unsigned xb_add(unsigned* p, unsigned v) { return __hip_atomic_fetch_add(p, v, __ATOMIC_RELAXED, __HIP_MEMORY_SCOPE_AGENT); }
__device__ __forceinline__ unsigned xb_xcc_id() { return (unsigned)__builtin_amdgcn_s_getreg((3 << 11) | 20) & 0xFu; }
#define XB_SPIN(cond, bar) do { unsigned _sp = 0; while (cond) { __builtin_amdgcn_s_sleep(1); \
    if ((++_sp & 255u) == 0u) { if (xb_ld(&(bar)[XB_TMO])) break; if (_sp > XB_SPIN_CAP) { atomicAdd(&(bar)[XB_TMO], 1u); break; } } } } while (0)
struct XcdBarrier { unsigned* bar; unsigned x; volatile LAS unsigned* st; };
__device__ __forceinline__ XcdBarrier xcd_barrier_post(unsigned* bar, volatile LAS unsigned* st) {
    XcdBarrier b; b.bar = bar; b.x = xb_xcc_id(); b.st = st;
    if (threadIdx.x == 0) (void)xb_add(&bar[XB_XCNT(b.x)], 1u);
    return b;
}
__device__ __forceinline__ void xcd_barrier_complete(unsigned* bar, unsigned x, unsigned& nloc, unsigned& nx) {
    const unsigned G = gridDim.x * gridDim.y * gridDim.z;
    unsigned sum, cnt, mine, sp = 0u;
    for (;;) {
        sum = 0u; cnt = 0u; mine = 0u;
#pragma unroll
        for (unsigned j = 0; j < 16; ++j) { const unsigned c = xb_ld(&bar[XB_XCNT(j)]); sum += c; cnt += (c > 0u) ? 1u : 0u; mine = (j == x) ? c : mine; }
        if (sum == G) break;
        __builtin_amdgcn_s_sleep(1);
        if ((++sp & 255u) == 0u) { if (xb_ld(&bar[XB_TMO])) break; if (sp > XB_SPIN_CAP) { atomicAdd(&bar[XB_TMO], 1u); break; } }
    }
    nloc = mine > 0u ? mine : 1u; nx = cnt > 0u ? cnt : 1u;
}
__device__ __forceinline__ void xcd_barrier(const XcdBarrier& b) {
    asm volatile("s_waitcnt vmcnt(0)" ::: "memory");
    __syncthreads();
    if (threadIdx.x == 0) {
        unsigned* bar = b.bar;
        __builtin_amdgcn_s_waitcnt(0);
        unsigned nloc = b.st[0], nx = b.st[1];
        if (nloc == 0u) { xcd_barrier_complete(bar, b.x, nloc, nx); b.st[0] = nloc; b.st[1] = nx; }
        const unsigned old = xb_add(&bar[XB_XSUB(b.x)], 1u);
        const unsigned gen = old / nloc;
        if (old + 1u == (gen + 1u) * nloc) {
            __builtin_amdgcn_fence(__ATOMIC_RELEASE, "agent");
            asm volatile("s_waitcnt vmcnt(0)" ::: "memory");
            const unsigned og = xb_add(&bar[XB_TOP], 1u);
            const unsigned tg = og / nx;
            if (og + 1u == (tg + 1u) * nx) xb_add(&bar[XB_TOPGEN], 1u);
            else XB_SPIN(xb_ld(&bar[XB_TOPGEN]) == tg, bar);
            __builtin_amdgcn_fence(__ATOMIC_ACQUIRE, "agent");
            xb_add(&bar[XB_XGEN(b.x)], 1u);
            asm volatile("s_waitcnt vmcnt(0)" ::: "memory");
        } else {
            XB_SPIN(xb_ld(&bar[XB_XGEN(b.x)]) == gen, bar);
            __builtin_amdgcn_fence(__ATOMIC_ACQUIRE, "agent");
            asm volatile("s_waitcnt vmcnt(0)" ::: "memory");
        }
    }
    __syncthreads();
}
__device__ __forceinline__ void grid_seam(unsigned char* shm) {
    XcdBarrier b; b.bar = (unsigned*)(kparams()->ws + W_BAR); b.x = xb_xcc_id(); b.st = (volatile LAS unsigned*)(LAS unsigned char*)(shm + 131072 + 16);
    xcd_barrier(b);
}

__global__ void __launch_bounds__(512, 2) fwd_kernel(Params p_unused) {
    extern __shared__ __attribute__((aligned(16))) unsigned char shm[];
    cg::grid_group grid = cg::this_grid();
    LAS unsigned char* lds = (LAS unsigned char*)shm;
    const int tid = tid_();
#if PROBE_MASK
    unsigned long long probe_acc = 0;
#endif

    {
        if (tid == 0) { volatile LAS unsigned* st = (volatile LAS unsigned*)(LAS unsigned char*)(shm + 131072 + 16); st[0] = 0u; st[1] = 0u; }
        __syncthreads();
        const KP p = kparams();
        (void)xcd_barrier_post((unsigned*)(p->ws + W_BAR), (volatile LAS unsigned*)(LAS unsigned char*)(shm + 131072 + 16));
        if (p->ws == nullptr) grid.sync();
    }
    PH_BEGIN(0);
    phase_mod(kparams(), (float*)shm);
    {
        const KP p = kparams();
        unsigned char* ws = p->ws;
        f32x2* rope = (f32x2*)(ws + W_ROPE);
        for (int idx = blockIdx.x * 512 + tid_(); idx < 2064 * 8; idx += gridDim.x * 512) {
            const int pi = idx >> 3, j = idx & 7;
            const float pos = (float)(pi < 2048 ? pi : 4096 + (pi - 2048));
            const float invf = exp2f(-(float)j * 0.125f * 18.931568569324174f);
            const float ang = pos * invf;
            const double a = (double)ang;
            const double kk = rint(a * 0.15915494309189535);
            const float r = (float)(a - kk * 6.283185307179586);
            rope[idx] = (f32x2){__cosf(r), __sinf(r)};
        }
        float* ROWSS = (float*)(ws + W_ROWSS);
        for (int idx = blockIdx.x * 512 + tid_(); idx < T; idx += gridDim.x * 512) ROWSS[idx] = 0.f;
        if (blockIdx.x == 0 && tid < 64) ((unsigned*)(ws + W_CNT))[tid] = 0u;
    }
    convert_weights(kparams(), 0, (float*)shm);
    grid_seam(shm);
    PH_END(0);

#pragma unroll 1
    for (int l = 0; l < 2; ++l) {
        PH_BEGIN(1);
        {
            const KP p = kparams();
            float* X = p->out + O_Y;
            phase_norm(p, l, l == 0 ? p->x_prompt : X, l == 0 ? p->x_sample : X + (size_t)TP * 1024, p->g_mix + l * 1024, 0);
        }
        if (l == 1) {
            convert_weights(kparams(), 1, (float*)shm);
            float* ROWSS = (float*)(kparams()->ws + W_ROWSS);
            for (int idx = blockIdx.x * 512 + tid_(); idx < T; idx += gridDim.x * 512) ROWSS[idx] = 0.f;
        }
        grid_seam(shm);
        PH_END(1);
        PH_BEGIN(2);
        {
            const KP p = kparams();
            const bf16_t* H = (const bf16_t*)(p->ws + W_H); const bf16_t* WT = (const bf16_t*)(p->ws + W_WT);
            pg8::StaticOrder S; S.init(T, NINP, (int)gridDim.x, (int)blockIdx.x);
            EpiIn E; E.l = l; E.pp = p;
            pg8::gemm_phase(lds, pg8::Gemm{H, WT + WT_IN, T, NINP, 1024}, S, E);
        }
        grid_seam(shm);
        PH_END(2);
        PH_BEGIN(3);
        conv_prepass(kparams(), l, shm);
        grid_seam(shm);
        phase_mixers(l, shm);
        grid_seam(shm);
        PH_END(3);
        PH_BEGIN(4);
#pragma unroll 1
        for (int b = 0; b < 3; ++b) {
            const KP p = kparams();
            unsigned char* ws = p->ws;
            const bf16_t* WT = (const bf16_t*)(ws + W_WT);
            const bf16_t* A = (const bf16_t*)(ws + (b == 0 ? W_Q : (b == 1 ? W_Z : W_GU)));
            const bf16_t* Bt = WT + (b == 0 ? WT_AO : (b == 1 ? WT_SO : WT_GO));
            const int K = b == 1 ? 1024 : 512;
            EpiRC<FMerge, 4> E; E.f.b = b; E.f.G8 = ws + W_G8; E.f.rowss = (const float*)(ws + W_ROWSS); E.f.MG = (bf16_t*)(ws + W_H);
            pg8::StaticOrder S; S.init(TP, 1024, (int)gridDim.x, (int)blockIdx.x);
            pg8::gemm_phase(lds, pg8::Gemm{A, Bt, TP, 1024, K}, S, E);
            if (K == 512) skinny_gemm<64>(shm, A + (size_t)TP * K, Bt, 1024, E.f); else skinny_gemm<128>(shm, A + (size_t)TP * K, Bt, 1024, E.f);
        }
        grid_seam(shm);
        PH_END(4);
#pragma unroll 1
        for (int s2 = 0; s2 < 2; ++s2) {
            PH_BEGIN(5);
            {
                const KP p = kparams();
                unsigned char* ws = p->ws;
                float* X = p->out + O_Y;
                const bf16_t* WT = (const bf16_t*)(ws + W_WT);
                const bf16_t* A = (const bf16_t*)(ws + (s2 == 0 ? W_H : W_FH));
                const bf16_t* Bt = WT + (s2 == 0 ? WT_OUT : WT_F2);
                const int K = s2 == 0 ? 1024 : 4096;
                const bool first = (l == 0 && s2 == 0);
                FResid fs; fs.srcP = first ? p->x_prompt : X; fs.srcS = first ? p->x_sample : X + (size_t)TP * 1024; fs.X = X;
                fs.modg = (const float*)(ws + W_MOD) + (size_t)l * 40 * 6144 + (s2 == 0 ? 2 : 5) * 1024;
                EpiResidP E; E.src = fs.srcP; E.X = X; E.modg = fs.modg;
                pg8::StaticOrder S; S.init(TP, 1024, (int)gridDim.x, (int)blockIdx.x);
                pg8::gemm_phase(lds, pg8::Gemm{A, Bt, TP, 1024, K}, S, E);
                if (s2 == 0) skinny_gemm<128>(shm, A + (size_t)TP * K, Bt, 1024, fs); else skinny_gemm<512>(shm, A + (size_t)TP * K, Bt, 1024, fs);
            }
            grid_seam(shm);
            PH_END(5);
            if (s2 == 0) {
                PH_BEGIN(6);
                {
                    const KP p = kparams();
                    float* X = p->out + O_Y;
                    phase_norm(p, l, X, X + (size_t)TP * 1024, p->g_ff + l * 1024, 3);
                }
                grid_seam(shm);
                PH_END(6);
                PH_BEGIN(7);
                {
                    const KP p = kparams();
                    unsigned char* ws = p->ws;
                    const bf16_t* H = (const bf16_t*)(ws + W_H); const bf16_t* WT = (const bf16_t*)(ws + W_WT);
                    EpiRC<FRelu2> E; E.f.FH = (bf16_t*)(ws + W_FH);
                    pg8::StaticOrder S; S.init(TP, 4096, (int)gridDim.x, (int)blockIdx.x);
                    pg8::gemm_phase(lds, pg8::Gemm{H, WT + WT_F1, TP, 4096, 1024}, S, E);
                    skinny_gemm<128>(shm, H + (size_t)TP * 1024, WT + WT_F1, 4096, E.f);
                }
                grid_seam(shm);
                PH_END(7);
            }
        }
    }
    {
        const KP p = kparams();
        float* X = p->out + O_Y;
        const float* gf = p->g_final;
        const int tidf = tid_(), lane = tidf & 63, gw = blockIdx.x * 8 + (tidf >> 6), ngw = gridDim.x * 8;
        for (int row = gw; row < T; row += ngw) {
            f32x4* xr = (f32x4*)(X + (size_t)row * 1024);
            f32x4 v[4]; float ss = 0.f;
#pragma unroll
            for (int j = 0; j < 4; ++j) { v[j] = xr[lane + 64 * j]; ss += v[j][0] * v[j][0] + v[j][1] * v[j][1] + v[j][2] * v[j][2] + v[j][3] * v[j][3]; }
            ss = wave_sum(ss);
            const float rstd = rsqrtf(ss * (1.f / 1024.f) + EPSF);
#pragma unroll
            for (int j = 0; j < 4; ++j) { const f32x4 g = ((const f32x4*)gf)[lane + 64 * j]; xr[lane + 64 * j] = v[j] * rstd * g; }
        }
    }
#if PROBE_MASK
    { const unsigned long long t0 = wall_clock64(); while (wall_clock64() - t0 < probe_acc) __builtin_amdgcn_s_sleep(8); }
#endif
}

extern "C" void kernel_launch(void* const* d_in, const int* in_sizes, int n_in, void* d_out, int out_size, void* d_ws, size_t ws_size, hipStream_t stream) {
    static int grid_blocks = 0;
    if (!grid_blocks) {
        int dev = 0, cus = 0, per_cu = 0;
        hipGetDevice(&dev);
        hipDeviceGetAttribute(&cus, hipDeviceAttributeMultiprocessorCount, dev);
        hipFuncSetAttribute((const void*)fwd_kernel, hipFuncAttributeMaxDynamicSharedMemorySize, LDS_BYTES);
        hipOccupancyMaxActiveBlocksPerMultiprocessor(&per_cu, (const void*)fwd_kernel, 512, LDS_BYTES);
        if (per_cu < 1) per_cu = 1;
        grid_blocks = cus * per_cu;
        if (ws_size < W_END) fprintf(stderr, "kernel_launch: workspace too small: need %zu, got %zu\n", (size_t)W_END, ws_size);
    }
    Params p{};
    const float** fp = (const float**)&p;
    for (int i = 0; i < 31; ++i) fp[i] = (const float*)d_in[i];
    p.out = (float*)d_out; p.ws = (unsigned char*)d_ws;
    (void)hipMemsetAsync((unsigned char*)d_ws + W_BAR, 0, XCD_BAR_WORDS * 4, stream);
    void* args[] = {&p};
    hipError_t e = hipLaunchCooperativeKernel((const void*)fwd_kernel, dim3(grid_blocks), dim3(512), args, LDS_BYTES, stream);
    if (e != hipSuccess) fprintf(stderr, "cooperative launch failed: %s (grid %d)\n", hipGetErrorString(e), grid_blocks);
}
```

```cpp
#include <hip/hip_runtime.h>
#include <hip/hip_cooperative_groups.h>
#include <cstdio>
namespace cg = cooperative_groups;

#define LAS __attribute__((address_space(3)))
typedef unsigned short bf16_t;
typedef short bf16x8 __attribute__((ext_vector_type(8)));
typedef float f32x4 __attribute__((ext_vector_type(4)));
typedef float f32x2 __attribute__((ext_vector_type(2)));
typedef unsigned u32x2 __attribute__((ext_vector_type(2)));
typedef unsigned u32x4 __attribute__((ext_vector_type(4)));

constexpr int DM = 1024, TP = 16384, TS = 512, T = TP + TS;
constexpr int NINP = 7680;
constexpr float EPSF = 1e-6f;

constexpr size_t O_Y = 0;
constexpr size_t O_KP = (size_t)T * DM;
constexpr size_t O_VP = O_KP + 2 * 8 * 128 * 128;
constexpr size_t O_SP = O_VP + 2 * 8 * 128 * 128;
constexpr size_t O_CP = O_SP + (size_t)2 * 8 * 16 * 64 * 128;
constexpr size_t O_KS = O_CP + 2 * 8 * 3 * 1536;
constexpr size_t O_VS = O_KS + 2 * 32 * 16 * 128;
constexpr size_t O_SS = O_VS + 2 * 32 * 16 * 128;
constexpr size_t O_CS = O_SS + (size_t)2 * 32 * 16 * 64 * 128;
constexpr size_t O_GS = O_CS + 2 * 32 * 3 * 1536;

constexpr size_t WT_IN = 0;
constexpr size_t WT_AO = WT_IN + (size_t)NINP * 1024;
constexpr size_t WT_SO = WT_AO + 1024 * 512;
constexpr size_t WT_GO = WT_SO + 1024 * 1024;
constexpr size_t WT_OUT = WT_GO + 1024 * 512;
constexpr size_t WT_F1 = WT_OUT + 1024 * 1024;
constexpr size_t WT_F2 = WT_F1 + (size_t)4096 * 1024;
constexpr size_t WT_END = WT_F2 + (size_t)1024 * 4096;

constexpr size_t al256(size_t x) { return (x + 255) & ~(size_t)255; }
constexpr size_t W_WT = 0;
constexpr size_t W_MOD = al256(W_WT + WT_END * 2);
constexpr size_t W_ROPE = al256(W_MOD + (size_t)2 * 40 * 6144 * 4);
constexpr size_t W_ROWSS = al256(W_ROPE + (size_t)2064 * 8 * 8);
constexpr size_t W_CNT = al256(W_ROWSS + (size_t)T * 4);
constexpr size_t W_BAR = al256(W_CNT + 256);
constexpr size_t W_DT = al256(W_BAR + 3456 * 4);
constexpr size_t W_H = al256(W_DT + (size_t)T * 16 * 4);
constexpr size_t W_Q = al256(W_H + (size_t)T * 1024 * 2);
constexpr size_t W_K = W_Q + (size_t)T * 512 * 2;
constexpr size_t W_V = W_K + (size_t)T * 128 * 2;
constexpr size_t W_Z = W_V + (size_t)T * 128 * 2;
constexpr size_t W_XBC = W_Z + (size_t)T * 1024 * 2;
constexpr size_t W_GU = W_XBC + (size_t)T * 1536 * 2;
constexpr size_t W_GV = W_GU + (size_t)T * 512 * 2;
constexpr size_t W_PAEND = W_GV + (size_t)T * 512 * 2;
constexpr size_t W_FH = W_Q;
constexpr size_t W_G8 = al256(W_PAEND);
constexpr size_t W_BCN = al256(W_G8 + (size_t)T * 3072);
constexpr size_t W_BT = al256(W_BCN + (size_t)T * 512 * 2);
constexpr size_t W_END = W_BT + ((size_t)256 * 256 * 64 + (size_t)32 * 256 * 16) * 2;
static_assert((size_t)T * 4096 * 2 <= W_PAEND - W_Q, "FH alias");

constexpr int LDS_BYTES = 131072 + 256;
#ifndef PROBE_MASK
#define PROBE_MASK 0
#endif
#if PROBE_MASK
#define PH_BEGIN(id) const unsigned long long _t_##id = wall_clock64()
#define PH_END(id) do { if ((PROBE_MASK >> (id)) & 1) probe_acc += wall_clock64() - _t_##id; } while (0)
#else
#define PH_BEGIN(id) do {} while (0)
#define PH_END(id) do {} while (0)
#endif

struct Params {
    const float *x_prompt, *x_sample, *c_prompt, *c_sample, *cache_k, *cache_v, *state_ssm, *state_conv;
    const float *w_ada, *b_ada, *g_mix, *w_in, *sinks, *conv_w, *conv_b, *dt_bias, *a_log, *d_skip, *ssm_norm_w;
    const float *gm_ln_g, *gm_ln_b, *gm_w_s, *gm_b_s, *w_attn_o, *w_ssm_o, *w_gm_o, *w_out, *g_ff, *w_ff1, *w_ff2, *g_final;
    float* out;
    unsigned char* ws;
};

typedef const Params __attribute__((address_space(4)))* KP;
__device__ __forceinline__ KP kparams() { KP q = (KP)__builtin_amdgcn_kernarg_segment_ptr(); asm volatile("" : "+s"(q)); return q; }

__device__ __forceinline__ int tid_() { int t = threadIdx.x; asm volatile("" : "+v"(t)); return t; }
__device__ __forceinline__ unsigned pk2(float lo, float hi) { unsigned r; asm("v_cvt_pk_bf16_f32 %0, %1, %2" : "=v"(r) : "v"(lo), "v"(hi)); return r; }
__device__ __forceinline__ bf16_t f2bf(float f) { return (bf16_t)(pk2(f, 0.f) & 0xffffu); }
__device__ __forceinline__ float bf2f(bf16_t b) { return __uint_as_float(((unsigned)b) << 16); }
__device__ __forceinline__ float bflo(unsigned u) { return __uint_as_float(u << 16); }
__device__ __forceinline__ float bfhi(unsigned u) { return __uint_as_float(u & 0xffff0000u); }
__device__ __forceinline__ float sigm(float x) { return __builtin_amdgcn_rcpf(1.f + __expf(-x)); }
__device__ __forceinline__ float siluf_(float x) { return x * sigm(x); }
__device__ __forceinline__ float geluf_(float x) { return x * sigm(1.5957691216057308f * (x + 0.044715f * x * x * x)); }
__device__ __forceinline__ float wave_sum(float v) {
#pragma unroll
    for (int o = 1; o < 64; o <<= 1) v += __shfl_xor(v, o);
    return v;
}
__device__ __forceinline__ u32x4 zero4() { unsigned z; asm volatile("v_mov_b32 %0, 0" : "=v"(z)); return (u32x4){z, z, z, z}; }
template <int CTRL, int RM = 0xf, int BK = 0xf>
__device__ __forceinline__ float dpp_add(float v) { return v + __int_as_float(__builtin_amdgcn_update_dpp(0, __float_as_int(v), CTRL, RM, BK, false)); }
__device__ __forceinline__ float row16_sum(float v) { v = dpp_add<0xB1>(v); v = dpp_add<0x4E>(v); v = dpp_add<0x141>(v); return dpp_add<0x140>(v); }
__device__ __forceinline__ float wave_scan(float c) { c = dpp_add<0x111>(c); c = dpp_add<0x112>(c); c = dpp_add<0x114>(c); c = dpp_add<0x118>(c); c = dpp_add<0x142, 0xa>(c); return dpp_add<0x143, 0xc>(c); }
__device__ __forceinline__ f32x4 mfma16(bf16x8 a, bf16x8 b, f32x4 c) { return __builtin_amdgcn_mfma_f32_16x16x32_bf16(a, b, c, 0, 0, 0); }
__device__ __forceinline__ int mod_row(int row) { return row < TP ? (row >> 11) : 8 + ((row - TP) >> 4); }

namespace pg8 {
constexpr int BM = 256, BK = 64, HALF = 128, HTB = HALF * BK * 2, STAGE_BYTES = 8 * HTB, NXCD = 8, WGM = 8;
__device__ __forceinline__ int lds_byte(int r, int c) { const int st = (r >> 4) * 2 + (c >> 5), rr = r & 15, cc = c & 31, ob = rr * 64 + cc * 2; return st * 1024 + (ob ^ (((ob >> 9) & 1) << 5)); }
__device__ __forceinline__ void stage_rc(int b, int& R, int& C) { const int st = b / 1024, sb = b % 1024, swz = sb ^ (((sb >> 9) & 1) << 5); R = (st >> 1) * 16 + swz / 64; C = (st & 1) * 32 + (swz % 64) / 2; }
struct Unit { int pm, pn; };
struct Gemm { const bf16_t* A; const bf16_t* Bt; int M, N, K; };
struct StaticOrder {
    int nM, nN, nwg, G, c;
    __device__ void init(int M, int N, int G_, int c_) { nM = M / BM; nN = N / BM; nwg = nM * nN; G = G_; c = c_; }
    __device__ bool next(int i, Unit& u) const {
        const long L = (long)i * G + c; if (L >= nwg) return false;
        int wgid = (int)L; { const int q = nwg / NXCD, r = nwg % NXCD, xcd = wgid % NXCD, off = wgid / NXCD; wgid = (xcd < r ? xcd * (q + 1) : r * (q + 1) + (xcd - r) * q) + off; }
        const int nig = WGM * nN, gid = wgid / nig, fm = gid * WGM, gsz = (nM - fm) < WGM ? (nM - fm) : WGM;
        u.pm = fm + ((wgid % nig) % gsz); u.pn = (wgid % nig) / gsz; return true;
    }
};
template <class Epi>
__device__ __forceinline__ void gemm_phase(LAS unsigned char* lds, const Gemm g, const StaticOrder& S, const Epi& E) {
    const int tid = tid_(), wid = __builtin_amdgcn_readfirstlane(tid >> 6), lane = tid & 63, wr = wid >> 2, wc = wid & 3, fr = lane & 15, fq = lane >> 4;
    const int K = g.K, nt = K / BK;
    unsigned voffA[2], voffB[2];
#pragma unroll
    for (int i = 0; i < 2; ++i) { int R, C; stage_rc(tid * 16 + i * 8192, R, C); voffA[i] = (unsigned)(R * K + C) * 2u; voffB[i] = voffA[i]; }
    const size_t kstep = (size_t)(BK * 2);
    const size_t hstep = (size_t)HALF * K * 2;
    const size_t tstep = 2 * hstep;
    const unsigned ldsw = (unsigned)wid * 1024u;
    const int aoff = lds_byte(wr * 64 + fr, fq * 8), boff = lds_byte(wc * 32 + fr, fq * 8);
#define PG8_SA(b, h) (((b) * 2 + (h)) * HTB)
#define PG8_SB(b, h) ((4 + (b) * 2 + (h)) * HTB)
#define PG8_STAGE(bufoff, gbase, voff) do { _Pragma("unroll") for (int _i = 0; _i < 2; ++_i) \
        __builtin_amdgcn_global_load_lds((const unsigned*)((const char*)(gbase) + (voff)[_i]), (LAS unsigned*)(lds + (bufoff) + ldsw + _i * 8192), 16, 0, 0); } while (0)
#define PG8_LDA(dst, b, h) do { _Pragma("unroll") for (int m = 0; m < 4; ++m) _Pragma("unroll") for (int k = 0; k < 2; ++k) dst[m][k] = *(const LAS bf16x8*)(lds + PG8_SA(b, h) + aoff + m * 2048 + k * 1024); } while (0)
#define PG8_LDB(dst, b, h) do { _Pragma("unroll") for (int n = 0; n < 2; ++n) _Pragma("unroll") for (int k = 0; k < 2; ++k) dst[n][k] = *(const LAS bf16x8*)(lds + PG8_SB(b, h) + boff + n * 2048 + k * 1024); } while (0)
#define PG8_MMA(ai, bj, At, Bt) do { __builtin_amdgcn_s_setprio(1); _Pragma("unroll") for (int m = 0; m < 4; ++m) _Pragma("unroll") for (int n = 0; n < 2; ++n) _Pragma("unroll") for (int k = 0; k < 2; ++k) \
        acc[ai][bj][m][n] = __builtin_amdgcn_mfma_f32_16x16x32_bf16(Bt[n][k], At[m][k], acc[ai][bj][m][n], 0, 0, 0); __builtin_amdgcn_s_setprio(0); } while (0)
#define PG8_WAIT_V(n) asm volatile("s_waitcnt vmcnt(" #n ")" ::: "memory")
#define PG8_WAIT_L(n) asm volatile("s_waitcnt lgkmcnt(" #n ")" ::: "memory")
#define PG8_BAR __builtin_amdgcn_s_barrier()
#define PG8_SCHED __builtin_amdgcn_sched_barrier(0)
    Unit cur, nxt; int ui = 0;
    if (!S.next(0, cur)) return;
    f32x4 acc[2][2][4][2];
#pragma unroll
    for (int a = 0; a < 2; ++a)
#pragma unroll
        for (int b = 0; b < 2; ++b)
#pragma unroll
            for (int m = 0; m < 4; ++m)
#pragma unroll
                for (int n = 0; n < 2; ++n) acc[a][b][m][n] = (f32x4){0.f, 0.f, 0.f, 0.f};
    bf16x8 At[4][2], B0[2][2], B1[2][2];
    const char* cA = (const char*)g.A + (size_t)cur.pm * tstep; const char* cB = (const char*)g.Bt + (size_t)cur.pn * tstep;
    PG8_STAGE(PG8_SB(0, 0), cB, voffB); PG8_STAGE(PG8_SA(0, 0), cA, voffA); PG8_STAGE(PG8_SB(0, 1), cB + hstep, voffB); PG8_STAGE(PG8_SA(0, 1), cA + hstep, voffA);
    if (wr == 1) PG8_BAR;
    PG8_WAIT_V(4); PG8_BAR;
    PG8_STAGE(PG8_SB(1, 0), cB + kstep, voffB); PG8_STAGE(PG8_SA(1, 0), cA + kstep, voffA); PG8_STAGE(PG8_SB(1, 1), cB + hstep + kstep, voffB);
    PG8_WAIT_V(6); PG8_BAR;
    for (;;) {
        const bool has_next = S.next(ui + 1, nxt);
        const char* nA = has_next ? (const char*)g.A + (size_t)nxt.pm * tstep : cA; const char* nB = has_next ? (const char*)g.Bt + (size_t)nxt.pn * tstep : cB;
        for (int t = 0; t < nt; t += 2) {
            const bool last = (t == nt - 2);
            const char* a1 = cA + (size_t)(t + 1) * kstep;
            const char* a2 = last ? nA : cA + (size_t)(t + 2) * kstep; const char* b2 = last ? nB : cB + (size_t)(t + 2) * kstep;
            const char* a3 = a2 + kstep; const char* b3 = b2 + kstep;
            PG8_LDB(B0, 0, 0); PG8_SCHED; PG8_LDA(At, 0, 0); PG8_STAGE(PG8_SA(1, 1), a1 + hstep, voffA);
            PG8_WAIT_L(8); PG8_BAR; PG8_WAIT_L(0); PG8_MMA(0, 0, At, B0); PG8_BAR; PG8_SCHED;
            PG8_LDB(B1, 0, 1); PG8_STAGE(PG8_SB(0, 0), b2, voffB);
            PG8_BAR; PG8_WAIT_L(0); PG8_MMA(0, 1, At, B1); PG8_BAR;
            PG8_LDA(At, 0, 1); PG8_STAGE(PG8_SA(0, 0), a2, voffA);
            PG8_BAR; PG8_WAIT_L(0); PG8_MMA(1, 0, At, B0); PG8_BAR; PG8_SCHED;
            PG8_STAGE(PG8_SB(0, 1), b2 + hstep, voffB);
            PG8_WAIT_V(6); PG8_BAR; PG8_MMA(1, 1, At, B1); PG8_BAR;
            PG8_LDB(B0, 1, 0); PG8_SCHED; PG8_LDA(At, 1, 0); PG8_STAGE(PG8_SA(0, 1), a2 + hstep, voffA);
            PG8_WAIT_L(8); PG8_BAR; PG8_WAIT_L(0); PG8_MMA(0, 0, At, B0); PG8_BAR; PG8_SCHED;
            PG8_LDB(B1, 1, 1); PG8_STAGE(PG8_SB(1, 0), b3, voffB);
            PG8_BAR; PG8_WAIT_L(0); PG8_MMA(0, 1, At, B1); PG8_BAR;
            PG8_LDA(At, 1, 1); PG8_STAGE(PG8_SA(1, 0), a3, voffA);
            PG8_BAR; PG8_WAIT_L(0); PG8_MMA(1, 0, At, B0); PG8_BAR; PG8_SCHED;
            PG8_STAGE(PG8_SB(1, 1), b3 + hstep, voffB);
            PG8_WAIT_V(6); PG8_BAR; PG8_MMA(1, 1, At, B1); PG8_BAR;
        }
        E(acc, cur, wr, wc, fr, fq);
        if (!has_next) break;
#pragma unroll
        for (int a = 0; a < 2; ++a)
#pragma unroll
            for (int b = 0; b < 2; ++b)
#pragma unroll
                for (int m = 0; m < 4; ++m)
#pragma unroll
                    for (int n = 0; n < 2; ++n) acc[a][b][m][n] = (f32x4){0.f, 0.f, 0.f, 0.f};
        cur = nxt; cA = nA; cB = nB; ++ui;
    }
    PG8_WAIT_V(0);
    if (wr == 0) PG8_BAR;
    PG8_BAR;
#undef PG8_SA
#undef PG8_SB
#undef PG8_STAGE
#undef PG8_LDA
#undef PG8_LDB
#undef PG8_MMA
#undef PG8_WAIT_V
#undef PG8_WAIT_L
#undef PG8_BAR
#undef PG8_SCHED
}
}

template <class F, int MG = 2> struct EpiRC {
    F f;
    __device__ __forceinline__ void operator()(const f32x4 (&acc)[2][2][4][2], const pg8::Unit& u, int wr, int wc, int fr, int fq) const {
        const int row0 = u.pm * 256 + wr * 64 + fr, col0 = u.pn * 256 + wc * 32 + 4 * fq;
#pragma unroll
        for (int ai = 0; ai < 2; ++ai)
#pragma unroll
            for (int mh = 0; mh < 4 / MG; ++mh) {
                typename F::Ld ld[MG][2][2];
#pragma unroll
                for (int mm = 0; mm < MG; ++mm)
#pragma unroll
                    for (int bj = 0; bj < 2; ++bj)
#pragma unroll
                        for (int n = 0; n < 2; ++n) f.load(row0 + ai * 128 + (mh * MG + mm) * 16, col0 + bj * 128 + n * 16, ld[mm][bj][n]);
#pragma unroll
                for (int mm = 0; mm < MG; ++mm)
#pragma unroll
                    for (int bj = 0; bj < 2; ++bj)
#pragma unroll
                        for (int n = 0; n < 2; ++n) f.apply(row0 + ai * 128 + (mh * MG + mm) * 16, col0 + bj * 128 + n * 16, acc[ai][bj][mh * MG + mm][n], ld[mm][bj][n]);
            }
    }
};
struct EpiResidP {
    const float* src; float* X; const float* modg;
    __device__ __forceinline__ void operator()(const f32x4 (&acc)[2][2][4][2], const pg8::Unit& u, int wr, int wc, int fr, int fq) const {
        const int row0 = u.pm * 256 + wr * 64 + fr, col0 = u.pn * 256 + wc * 32 + 4 * fq;
        const float* gp = modg + (size_t)((u.pm * 256) >> 11) * 6144 + col0;
        f32x4 g[2][2];
#pragma unroll
        for (int bj = 0; bj < 2; ++bj)
#pragma unroll
            for (int n = 0; n < 2; ++n) g[bj][n] = *(const f32x4*)(gp + bj * 128 + n * 16);
#pragma unroll
        for (int ai = 0; ai < 2; ++ai) {
            f32x4 x[4][2][2];
#pragma unroll
            for (int m = 0; m < 4; ++m)
#pragma unroll
                for (int bj = 0; bj < 2; ++bj)
#pragma unroll
                    for (int n = 0; n < 2; ++n) x[m][bj][n] = *(const f32x4*)(src + (size_t)(row0 + ai * 128 + m * 16) * 1024 + col0 + bj * 128 + n * 16);
#pragma unroll
            for (int m = 0; m < 4; ++m)
#pragma unroll
                for (int bj = 0; bj < 2; ++bj)
#pragma unroll
                    for (int n = 0; n < 2; ++n) *(f32x4*)(X + (size_t)(row0 + ai * 128 + m * 16) * 1024 + col0 + bj * 128 + n * 16) = x[m][bj][n] + g[bj][n] * acc[ai][bj][m][n];
        }
    }
};

template <int KW, class F>
__device__ __forceinline__ void skinny_gemm(unsigned char* shm, const bf16_t* A, const bf16_t* Bt, int N, const F& f) {
    constexpr int K = KW * 8, NS = KW / 32 < 4 ? KW / 32 : 4, NSTEP = KW / 32;
    const int tid = tid_(), w = tid >> 6, lane = tid & 63, fr = lane & 15, fq = lane >> 4;
    f32x4* red = (f32x4*)shm;
    const int nun = 16 * (N / 64);
    for (int u = blockIdx.x; u < nun; u += gridDim.x) {
        const int m0 = (u & 15) * 32, n0 = (u >> 4) * 64;
        typename F::Ld eld; const int er = TP + m0 + (w >> 2) * 16 + fr, ec = n0 + (w & 3) * 16 + fq * 4; f.load(er, ec, eld);
        f32x4 acc[2][4];
#pragma unroll
        for (int i = 0; i < 2; ++i)
#pragma unroll
            for (int j = 0; j < 4; ++j) acc[i][j] = (f32x4){0.f, 0.f, 0.f, 0.f};
        const bf16_t* ap = A + (size_t)(m0 + fr) * K + w * KW + fq * 8;
        const bf16_t* bp = Bt + (size_t)(n0 + fr) * K + w * KW + fq * 8;
        bf16x8 ra[NS][2], rb[NS][4];
#pragma unroll
        for (int s = 0; s < NS; ++s) {
#pragma unroll
            for (int i = 0; i < 2; ++i) ra[s][i] = *(const bf16x8*)(ap + (size_t)i * 16 * K + s * 32);
#pragma unroll
            for (int j = 0; j < 4; ++j) rb[s][j] = *(const bf16x8*)(bp + (size_t)j * 16 * K + s * 32);
        }
#pragma unroll
        for (int st = 0; st < NSTEP; ++st) {
            const int s = st % NS;
#pragma unroll
            for (int i = 0; i < 2; ++i)
#pragma unroll
                for (int j = 0; j < 4; ++j) acc[i][j] = mfma16(rb[s][j], ra[s][i], acc[i][j]);
            if (st + NS < NSTEP) {
#pragma unroll
                for (int i = 0; i < 2; ++i) ra[s][i] = *(const bf16x8*)(ap + (size_t)i * 16 * K + (st + NS) * 32);
#pragma unroll
                for (int j = 0; j < 4; ++j) rb[s][j] = *(const bf16x8*)(bp + (size_t)j * 16 * K + (st + NS) * 32);
            }
        }
        __syncthreads();
#pragma unroll
        for (int i = 0; i < 2; ++i)
#pragma unroll
            for (int j = 0; j < 4; ++j) red[(w * 8 + i * 4 + j) * 64 + lane] = acc[i][j];
        __syncthreads();
        f32x4 s = red[w * 64 + lane];
#pragma unroll
        for (int q = 1; q < 8; ++q) s += red[(q * 8 + w) * 64 + lane];
        f.apply(er, ec, s, eld);
    }
    __syncthreads();
}

struct EpiIn {
    int l; KP pp;
    __device__ __forceinline__ void operator()(const f32x4 (&acc)[2][2][4][2], const pg8::Unit& u, int wr, int wc, int fr, int fq) const {
        const KP p = pp;
        unsigned char* ws = p->ws;
        const int pn = u.pn;
        const int row0 = u.pm * 256 + wr * 64 + fr;
        const int ct0 = wc * 32 + 4 * fq;
        if (pn < 3) {
            bf16_t* Qb = (bf16_t*)(ws + W_Q); bf16_t* Kb = (bf16_t*)(ws + W_K); bf16_t* Vb = (bf16_t*)(ws + W_V);
            const f32x2* rope = (const f32x2*)(ws + W_ROPE);
#pragma unroll
            for (int ai = 0; ai < 2; ++ai)
#pragma unroll
                for (int m = 0; m < 4; ++m) {
                    const int row = row0 + ai * 128 + m * 16;
                    const bool samp = row >= TP;
                    const int b = samp ? (row - TP) >> 4 : row >> 11, t = samp ? (row - TP) & 15 : row & 2047;
                    const int pi = samp ? 2048 + t : t;
#pragma unroll
                    for (int bj = 0; bj < 2; ++bj)
#pragma unroll
                        for (int n = 0; n < 2; ++n) {
                            f32x4 v = acc[ai][bj][m][n];
                            const int ct = bj * 128 + ct0 + n * 16;
                            const bool isv = (pn == 2) && (bj == 1);
                            if (!isv && n == 0 && (wc & 1) == 0) {
                                f32x4 o;
                                o[0] = __shfl_xor(v[0], 32); o[1] = __shfl_xor(v[1], 32); o[2] = __shfl_xor(v[2], 32); o[3] = __shfl_xor(v[3], 32);
                                const f32x4* cs = (const f32x4*)(rope + pi * 8 + 4 * (fq & 1));
                                const f32x4 c01 = cs[0], c23 = cs[1];
                                const float sgn = (fq < 2) ? -1.f : 1.f;
                                v[0] = v[0] * c01[0] + sgn * o[0] * c01[1];
                                v[1] = v[1] * c01[2] + sgn * o[1] * c01[3];
                                v[2] = v[2] * c23[0] + sgn * o[2] * c23[1];
                                v[3] = v[3] * c23[2] + sgn * o[3] * c23[3];
                            }
                            u32x2 pk; pk.x = pk2(v[0], v[1]); pk.y = pk2(v[2], v[3]);
                            if (pn < 2) { *(u32x2*)(Qb + (size_t)row * 512 + pn * 256 + ct) = pk; }
                            else {
                                const int c = ct & 127;
                                bf16_t* dst = isv ? Vb : Kb;
                                *(u32x2*)(dst + (size_t)row * 128 + c) = pk;
                                if (samp) {
                                    float* o = p->out + (isv ? O_VS : O_KS) + ((size_t)(l * 32 + b) * 16 + t) * 128 + c;
                                    *(f32x4*)o = v;
                                } else if (t >= 1920) {
                                    float* o = p->out + (isv ? O_VP : O_KP) + ((size_t)(l * 8 + b) * 128 + (t - 1920)) * 128 + c;
                                    *(f32x4*)o = v;
                                }
                            }
                        }
                }
        } else if (pn < 7) {
            bf16_t* Zb = (bf16_t*)(ws + W_Z);
#pragma unroll
            for (int ai = 0; ai < 2; ++ai)
#pragma unroll
                for (int m = 0; m < 4; ++m) {
                    const int row = row0 + ai * 128 + m * 16;
#pragma unroll
                    for (int bj = 0; bj < 2; ++bj)
#pragma unroll
                        for (int n = 0; n < 2; ++n) {
                            const f32x4 v = acc[ai][bj][m][n];
                            u32x2 pk; pk.x = pk2(v[0], v[1]); pk.y = pk2(v[2], v[3]);
                            *(u32x2*)(Zb + (size_t)row * 1024 + (pn - 3) * 256 + bj * 128 + ct0 + n * 16) = pk;
                        }
                }
        } else if (pn < 13) {
            bf16_t* Xb = (bf16_t*)(ws + W_XBC);
#pragma unroll
            for (int ai = 0; ai < 2; ++ai)
#pragma unroll
                for (int m = 0; m < 4; ++m) {
                    const int row = row0 + ai * 128 + m * 16;
                    const bool samp = row >= TP;
                    const int b = samp ? (row - TP) >> 4 : row >> 11, t = samp ? (row - TP) & 15 : row & 2047;
#pragma unroll
                    for (int bj = 0; bj < 2; ++bj)
#pragma unroll
                        for (int n = 0; n < 2; ++n) {
                            const f32x4 v = acc[ai][bj][m][n];
                            const int cc = (pn - 7) * 256 + bj * 128 + ct0 + n * 16;
                            u32x2 pk; pk.x = pk2(v[0], v[1]); pk.y = pk2(v[2], v[3]);
                            *(u32x2*)(Xb + (size_t)row * 1536 + cc) = pk;
                            if (samp) { if (t >= 13) *(f32x4*)(p->out + O_CS + ((size_t)(l * 32 + b) * 3 + (t - 13)) * 1536 + cc) = v; }
                            else if (t >= 2045) *(f32x4*)(p->out + O_CP + ((size_t)(l * 8 + b) * 3 + (t - 2045)) * 1536 + cc) = v;
                        }
                }
        } else if (pn < 17) {
            bf16_t* dst = (bf16_t*)(ws + (pn < 15 ? W_GU : W_GV));
            const int cb = ((pn - 13) & 1) * 256;
#pragma unroll
            for (int ai = 0; ai < 2; ++ai)
#pragma unroll
                for (int m = 0; m < 4; ++m) {
                    const int row = row0 + ai * 128 + m * 16;
#pragma unroll
                    for (int bj = 0; bj < 2; ++bj)
#pragma unroll
                        for (int n = 0; n < 2; ++n) {
                            const f32x4 v = acc[ai][bj][m][n];
                            u32x2 pk; pk.x = pk2(geluf_(v[0]), geluf_(v[1])); pk.y = pk2(geluf_(v[2]), geluf_(v[3]));
                            *(u32x2*)(dst + (size_t)row * 512 + cb + bj * 128 + ct0 + n * 16) = pk;
                        }
                }
        } else if (pn < 29) {
            unsigned char* G8 = ws + W_G8;
#pragma unroll
            for (int ai = 0; ai < 2; ++ai)
#pragma unroll
                for (int m = 0; m < 4; ++m) {
                    const int row = row0 + ai * 128 + m * 16;
#pragma unroll
                    for (int bj = 0; bj < 2; ++bj)
#pragma unroll
                        for (int n = 0; n < 2; ++n) {
                            const f32x4 v = acc[ai][bj][m][n];
                            const unsigned q0 = (unsigned)(sigm(v[0]) * 255.f + 0.5f), q1 = (unsigned)(sigm(v[1]) * 255.f + 0.5f);
                            const unsigned q2 = (unsigned)(sigm(v[2]) * 255.f + 0.5f), q3 = (unsigned)(sigm(v[3]) * 255.f + 0.5f);
                            *(unsigned*)(G8 + (size_t)row * 3072 + (pn - 17) * 256 + bj * 128 + ct0 + n * 16) = q0 | (q1 << 8) | (q2 << 16) | (q3 << 24);
                        }
                }
        } else {
            if (wc == 0) {
                float* DT = (float*)(ws + W_DT);
                const f32x4 bias = *(const f32x4*)(p->dt_bias + l * 16 + 4 * fq);
#pragma unroll
                for (int ai = 0; ai < 2; ++ai)
#pragma unroll
                    for (int m = 0; m < 4; ++m) {
                        const int row = row0 + ai * 128 + m * 16;
                        f32x4 v = acc[ai][0][m][0] + bias;
#pragma unroll
                        for (int e = 0; e < 4; ++e) { const float x = v[e]; v[e] = fmaxf(x, 0.f) + log1pf(__expf(-fabsf(x))); }
                        *(f32x4*)(DT + (size_t)row * 16 + 4 * fq) = v;
                    }
            }
        }
    }
};

struct FMerge {
    int b; const unsigned char* G8; const float* rowss; bf16_t* MG;
    struct Ld { unsigned g; float ss; u32x2 o; };
    __device__ __forceinline__ void load(int row, int col, Ld& d) const {
        d.g = *(const unsigned*)(G8 + (size_t)row * 3072 + b * 1024 + col);
        d.ss = (b == 1) ? rowss[row] : 0.f;
        d.o = (b > 0) ? *(const u32x2*)(MG + (size_t)row * 1024 + col) : (u32x2){0u, 0u};
    }
    __device__ __forceinline__ void apply(int row, int col, f32x4 v, const Ld& d) const {
        float sc = 1.f / 255.f;
        if (b == 1) sc *= rsqrtf(d.ss * (1.f / 1024.f) + EPSF);
        const unsigned g = d.g;
        f32x4 r;
        r[0] = (float)(g & 255u) * sc * v[0]; r[1] = (float)((g >> 8) & 255u) * sc * v[1];
        r[2] = (float)((g >> 16) & 255u) * sc * v[2]; r[3] = (float)(g >> 24) * sc * v[3];
        if (b > 0) { r[0] += bflo(d.o.x); r[1] += bfhi(d.o.x); r[2] += bflo(d.o.y); r[3] += bfhi(d.o.y); }
        u32x2 pk; pk.x = pk2(r[0], r[1]); pk.y = pk2(r[2], r[3]);
        *(u32x2*)(MG + (size_t)row * 1024 + col) = pk;
    }
};
struct FResid {
    const float* srcP; const float* srcS; float* X; const float* modg;
    struct Ld { f32x4 x, g; };
    __device__ __forceinline__ void load(int row, int col, Ld& d) const {
        const float* s = row < TP ? srcP + (size_t)row * 1024 + col : srcS + (size_t)(row - TP) * 1024 + col;
        d.x = *(const f32x4*)s;
        d.g = *(const f32x4*)(modg + (size_t)mod_row(row) * 6144 + col);
    }
    __device__ __forceinline__ void apply(int row, int col, f32x4 v, const Ld& d) const {
        *(f32x4*)(X + (size_t)row * 1024 + col) = d.x + d.g * v;
    }
};
struct FRelu2 {
    bf16_t* FH;
    struct Ld { };
    __device__ __forceinline__ void load(int, int, Ld&) const {}
    __device__ __forceinline__ void apply(int row, int col, f32x4 v, const Ld&) const {
        f32x4 r; r[0] = fmaxf(v[0], 0.f); r[1] = fmaxf(v[1], 0.f); r[2] = fmaxf(v[2], 0.f); r[3] = fmaxf(v[3], 0.f);
        u32x2 pk; pk.x = pk2(r[0] * r[0], r[1] * r[1]); pk.y = pk2(r[2] * r[2], r[3] * r[3]);
        *(u32x2*)(FH + (size_t)row * 4096 + col) = pk;
    }
};

__device__ __forceinline__ void phase_mod(KP p, float* lds) {
    float* sc = lds;
    float* red = lds + 20480;
    float* MOD = (float*)(p->ws + W_MOD);
    const int tid = tid_();
    const int rh = blockIdx.x & 1;
    __syncthreads();
    for (int idx = tid; idx < 20480; idx += 512) {
        const int r = idx >> 10, k = idx & 1023, gr = rh * 20 + r;
        const float c = gr < 8 ? p->c_prompt[gr * 1024 + k] : p->c_sample[(gr - 8) * 1024 + k];
        sc[k * 20 + r] = siluf_(c);
    }
    __syncthreads();
    for (int pi = blockIdx.x >> 1; pi < 384; pi += gridDim.x >> 1) {
        const int l = pi / 192, cgp = pi % 192;
        const int cn = tid & 31, ks = tid >> 5, n = cgp * 32 + cn;
        float acc[20];
#pragma unroll
        for (int r = 0; r < 20; ++r) acc[r] = 0.f;
        const float* w = p->w_ada + (size_t)l * 1024 * 6144 + n + (size_t)ks * 64 * 6144;
#pragma unroll 1
        for (int kb = 0; kb < 64; kb += 16) {
            float wv[16];
#pragma unroll
            for (int i = 0; i < 16; ++i) wv[i] = w[(size_t)(kb + i) * 6144];
#pragma unroll
            for (int i = 0; i < 16; ++i) {
                const f32x4* s4 = (const f32x4*)(sc + (ks * 64 + kb + i) * 20);
#pragma unroll
                for (int q = 0; q < 5; ++q) { const f32x4 s = s4[q]; acc[4 * q] += s[0] * wv[i]; acc[4 * q + 1] += s[1] * wv[i]; acc[4 * q + 2] += s[2] * wv[i]; acc[4 * q + 3] += s[3] * wv[i]; }
            }
        }
#pragma unroll
        for (int r = 0; r < 20; ++r) red[(ks * 20 + r) * 32 + cn] = acc[r];
        __syncthreads();
        for (int idx = tid; idx < 640; idx += 512) {
            const int r = idx >> 5, c2 = idx & 31, n2 = cgp * 32 + c2;
            float s = 0.f;
#pragma unroll
            for (int k16 = 0; k16 < 16; ++k16) s += red[(k16 * 20 + r) * 32 + c2];
            MOD[((size_t)l * 40 + rh * 20 + r) * 6144 + n2] = s + p->b_ada[l * 6144 + n2];
        }
        __syncthreads();
    }
}

struct CvtTile { const float* src; bf16_t* dst; int K, Ns, mode, n0, k0; };
__device__ __forceinline__ CvtTile cvt_tile(KP p, int l, int it) {
    bf16_t* WT = (bf16_t*)(p->ws + W_WT);
    CvtTile c; int nT; int r = it; c.mode = 0;
    if (r < 1920) { c.src = p->w_in + (size_t)l * 1024 * 7440; c.K = 1024; c.Ns = 7440; nT = 120; c.dst = WT + WT_IN; c.mode = 1; }
    else if ((r -= 1920) < 128) { c.src = p->w_attn_o + (size_t)l * 512 * 1024; c.K = 512; c.Ns = 1024; nT = 16; c.dst = WT + WT_AO; }
    else if ((r -= 128) < 256) { c.src = p->w_ssm_o + (size_t)l * 1024 * 1024; c.K = 1024; c.Ns = 1024; nT = 16; c.dst = WT + WT_SO; c.mode = 2; }
    else if ((r -= 256) < 128) { c.src = p->w_gm_o + (size_t)l * 512 * 1024; c.K = 512; c.Ns = 1024; nT = 16; c.dst = WT + WT_GO; }
    else if ((r -= 128) < 256) { c.src = p->w_out + (size_t)l * 1024 * 1024; c.K = 1024; c.Ns = 1024; nT = 16; c.dst = WT + WT_OUT; }
    else if ((r -= 256) < 1024) { c.src = p->w_ff1 + (size_t)l * 1024 * 4096; c.K = 1024; c.Ns = 4096; nT = 64; c.dst = WT + WT_F1; }
    else { r -= 1024; c.src = p->w_ff2 + (size_t)l * 4096 * 1024; c.K = 4096; c.Ns = 1024; nT = 16; c.dst = WT + WT_F2; }
    c.n0 = (r % nT) * 64; c.k0 = (r / nT) * 64;
    return c;
}
__device__ __forceinline__ void convert_weights(KP p, int l, float* tiles) {
    const int tid = tid_();
    for (int it = blockIdx.x * 2; it < 4736; it += gridDim.x * 2) {
        CvtTile c[2] = {cvt_tile(p, l, it), cvt_tile(p, l, it + 1 < 4736 ? it + 1 : it)};
        __syncthreads();
        float v[2][8];
#pragma unroll
        for (int h = 0; h < 2; ++h) {
            const int nn = tid & 63, ns = c[h].n0 + nn; int sc_ = ns; bool zero = false;
            if (c[h].mode == 1) { if (ns < 3328) sc_ = ns; else if (ns < 7424) sc_ = ns + 16; else if (ns < 7440) sc_ = ns - 7424 + 3328; else { zero = true; sc_ = 0; } }
#pragma unroll
            for (int i = 0; i < 8; ++i) {
                const int kk = (tid >> 6) + 8 * i;
                v[h][i] = zero ? 0.f : c[h].src[(size_t)(c[h].k0 + kk) * c[h].Ns + sc_];
            }
        }
#pragma unroll
        for (int h = 0; h < 2; ++h)
#pragma unroll
            for (int i = 0; i < 8; ++i) {
                const int kk = (tid >> 6) + 8 * i;
                float x = v[h][i];
                if (c[h].mode == 2) x *= p->ssm_norm_w[l * 1024 + c[h].k0 + kk];
                tiles[h * 4224 + kk * 65 + (tid & 63)] = x;
            }
        __syncthreads();
#pragma unroll
        for (int h = 0; h < 2; ++h) {
            if (h == 1 && it + 1 >= 4736) break;
            const float* tile = tiles + h * 4224;
            const int nr = tid >> 3, kc = (tid & 7) * 8;
            u32x4 o;
            o.x = pk2(tile[(kc + 0) * 65 + nr], tile[(kc + 1) * 65 + nr]);
            o.y = pk2(tile[(kc + 2) * 65 + nr], tile[(kc + 3) * 65 + nr]);
            o.z = pk2(tile[(kc + 4) * 65 + nr], tile[(kc + 5) * 65 + nr]);
            o.w = pk2(tile[(kc + 6) * 65 + nr], tile[(kc + 7) * 65 + nr]);
            *(u32x4*)(c[h].dst + (size_t)(c[h].n0 + nr) * c[h].K + c[h].k0 + kc) = o;
        }
    }
    __syncthreads();
}

__device__ __forceinline__ void phase_norm(KP p, int l, const float* srcP, const float* srcS, const float* gvec, int shift_idx) {
    const int tid = tid_(), lane = tid & 63, gw = blockIdx.x * 8 + (tid >> 6), ngw = gridDim.x * 8;
    const float* MOD = (const float*)(p->ws + W_MOD);
    bf16_t* H = (bf16_t*)(p->ws + W_H);
    f32x4 g[4];
#pragma unroll
    for (int j = 0; j < 4; ++j) g[j] = ((const f32x4*)gvec)[lane + 64 * j];
    f32x4 nx[4];
    {
        const int row = gw < T ? gw : T - 1;
        const float* xr = row < TP ? srcP + (size_t)row * 1024 : srcS + (size_t)(row - TP) * 1024;
#pragma unroll
        for (int j = 0; j < 4; ++j) nx[j] = ((const f32x4*)xr)[lane + 64 * j];
    }
    for (int row = gw; row < T; row += ngw) {
        f32x4 v[4];
#pragma unroll
        for (int j = 0; j < 4; ++j) v[j] = nx[j];
        {
            const int rn = row + ngw < T ? row + ngw : row;
            const float* xr = rn < TP ? srcP + (size_t)rn * 1024 : srcS + (size_t)(rn - TP) * 1024;
#pragma unroll
            for (int j = 0; j < 4; ++j) nx[j] = ((const f32x4*)xr)[lane + 64 * j];
        }
        const float* md = MOD + ((size_t)l * 40 + mod_row(row)) * 6144 + shift_idx * 1024;
        f32x4 sh[4], sc[4];
#pragma unroll
        for (int j = 0; j < 4; ++j) { sh[j] = ((const f32x4*)md)[lane + 64 * j]; sc[j] = ((const f32x4*)(md + 1024))[lane + 64 * j]; }
        float ss = 0.f;
#pragma unroll
        for (int j = 0; j < 4; ++j) ss += v[j][0] * v[j][0] + v[j][1] * v[j][1] + v[j][2] * v[j][2] + v[j][3] * v[j][3];
        ss = wave_sum(ss);
        const float rstd = rsqrtf(ss * (1.f / 1024.f) + EPSF);
#pragma unroll
        for (int j = 0; j < 4; ++j) {
            f32x4 h;
#pragma unroll
            for (int e = 0; e < 4; ++e) h[e] = (v[j][e] * rstd * g[j][e]) * (1.f + sc[j][e]) + sh[j][e];
            u32x2 pk; pk.x = pk2(h[0], h[1]); pk.y = pk2(h[2], h[3]);
            *(u32x2*)(H + (size_t)row * 1024 + (lane + 64 * j) * 4) = pk;
        }
    }
}

template <int NMT>
__device__ __forceinline__ void attn_load_q(const bf16_t* qo, int lane, bf16x8 (&qf)[NMT][2]) {
    const int fr = lane & 15, fq = lane >> 4;
#pragma unroll
    for (int mt = 0; mt < NMT; ++mt)
#pragma unroll
        for (int ks = 0; ks < 2; ++ks) qf[mt][ks] = *(const bf16x8*)(qo + (size_t)(mt * 16 + fr) * 512 + ks * 32 + fq * 8);
}
template <int NMT>
__device__ __forceinline__ void attn_compute(const bf16_t* Ks, const bf16_t* VT, bf16_t* qo, const bf16x8 (&qf)[NMT][2], int kt0, int kt1, int nkeys, float sink, int lane) {
    const int fr = lane & 15, fq = lane >> 4;
    f32x4 s[12][NMT];
#pragma unroll
    for (int kp = 0; kp < 6; ++kp) {
#pragma unroll
        for (int h2 = 0; h2 < 2; ++h2)
#pragma unroll
            for (int mt = 0; mt < NMT; ++mt) s[2 * kp + h2][mt] = (f32x4){0.f, 0.f, 0.f, 0.f};
        if (2 * kp >= kt0 && 2 * kp < kt1) {
            bf16x8 kf[2][2];
#pragma unroll
            for (int h2 = 0; h2 < 2; ++h2)
#pragma unroll
                for (int ks = 0; ks < 2; ++ks) kf[h2][ks] = *(const bf16x8*)(Ks + ((2 * kp + h2) * 16 + fr) * 72 + ks * 32 + fq * 8);
#pragma unroll
            for (int h2 = 0; h2 < 2; ++h2)
#pragma unroll
                for (int ks = 0; ks < 2; ++ks)
#pragma unroll
                    for (int mt = 0; mt < NMT; ++mt) s[2 * kp + h2][mt] = mfma16(kf[h2][ks], qf[mt][ks], s[2 * kp + h2][mt]);
        }
    }
    float inv[NMT];
#pragma unroll
    for (int mt = 0; mt < NMT; ++mt) {
        float mx = -INFINITY;
#pragma unroll
        for (int kt = 0; kt < 12; ++kt)
            if (kt >= kt0 && kt < kt1) {
#pragma unroll
                for (int j = 0; j < 4; ++j) { const int key = kt * 16 + fq * 4 + j; const float v = key < nkeys ? s[kt][mt][j] * 0.125f : -INFINITY; s[kt][mt][j] = v; mx = fmaxf(mx, v); }
            }
        mx = fmaxf(mx, __shfl_xor(mx, 16)); mx = fmaxf(mx, __shfl_xor(mx, 32)); mx = fmaxf(mx, sink);
        float sum = 0.f;
#pragma unroll
        for (int kt = 0; kt < 12; ++kt)
            if (kt >= kt0 && kt < kt1) {
#pragma unroll
                for (int j = 0; j < 4; ++j) { const float e = __expf(s[kt][mt][j] - mx); s[kt][mt][j] = e; sum += e; }
            }
        sum += __shfl_xor(sum, 16); sum += __shfl_xor(sum, 32);
        inv[mt] = 1.f / (sum + __expf(sink - mx));
    }
    f32x4 o[4][NMT];
#pragma unroll
    for (int dt = 0; dt < 4; ++dt)
#pragma unroll
        for (int mt = 0; mt < NMT; ++mt) o[dt][mt] = (f32x4){0.f, 0.f, 0.f, 0.f};
#pragma unroll
    for (int kb = 0; kb < 6; ++kb) {
        if (2 * kb >= kt0 && 2 * kb < kt1) {
            bf16x8 pf[NMT];
#pragma unroll
            for (int mt = 0; mt < NMT; ++mt) {
                const f32x4 a = s[2 * kb][mt], b = s[2 * kb + 1][mt];
                u32x4 t; t.x = pk2(a[0], a[1]); t.y = pk2(a[2], a[3]); t.z = pk2(b[0], b[1]); t.w = pk2(b[2], b[3]);
                pf[mt] = __builtin_bit_cast(bf16x8, t);
            }
            bf16x8 vf[4];
#pragma unroll
            for (int dt = 0; dt < 4; ++dt) {
                const u32x2 lo = *(const u32x2*)(VT + (dt * 16 + fr) * 200 + kb * 32 + fq * 4);
                const u32x2 hi = *(const u32x2*)(VT + (dt * 16 + fr) * 200 + kb * 32 + 16 + fq * 4);
                u32x4 t; t.x = lo.x; t.y = lo.y; t.z = hi.x; t.w = hi.y;
                vf[dt] = __builtin_bit_cast(bf16x8, t);
            }
#pragma unroll
            for (int dt = 0; dt < 4; ++dt)
#pragma unroll
                for (int mt = 0; mt < NMT; ++mt) o[dt][mt] = mfma16(vf[dt], pf[mt], o[dt][mt]);
        }
    }
#pragma unroll
    for (int mt = 0; mt < NMT; ++mt)
#pragma unroll
        for (int dt = 0; dt < 4; ++dt) {
            const f32x4 v = o[dt][mt] * inv[mt];
            u32x2 pk; pk.x = pk2(v[0], v[1]); pk.y = pk2(v[2], v[3]);
            *(u32x2*)(qo + (size_t)(mt * 16 + fr) * 512 + dt * 16 + fq * 4) = pk;
        }
}

__device__ __forceinline__ void scatter_vt(bf16_t* VT, int ch, int kk, u32x4 vv) {
    bf16_t* d = VT + (ch * 8) * 200 + kk;
    d[0 * 200] = (bf16_t)(vv.x & 0xffffu); d[1 * 200] = (bf16_t)(vv.x >> 16);
    d[2 * 200] = (bf16_t)(vv.y & 0xffffu); d[3 * 200] = (bf16_t)(vv.y >> 16);
    d[4 * 200] = (bf16_t)(vv.z & 0xffffu); d[5 * 200] = (bf16_t)(vv.z >> 16);
    d[6 * 200] = (bf16_t)(vv.w & 0xffffu); d[7 * 200] = (bf16_t)(vv.w >> 16);
}

__device__ __forceinline__ void attn_prompt_item(KP p, int l, int it, unsigned char* shm) {
    const int tid = tid_(), w = tid >> 6, lane = tid & 63;
    const int b = it >> 6, c = (it >> 1) & 31, kvh = it & 1;
    bf16_t* Ks = (bf16_t*)shm; bf16_t* VT = Ks + 192 * 72;
    bf16_t* Qb = (bf16_t*)(p->ws + W_Q); const bf16_t* Kb = (const bf16_t*)(p->ws + W_K); const bf16_t* Vb = (const bf16_t*)(p->ws + W_V);
    const int kt0 = c >= 2 ? 0 : (2 - c) * 4;
    const int g = w >> 1, q0 = (w & 1) * 32, hq = kvh * 4 + g;
    bf16_t* qo = Qb + ((size_t)b * 2048 + c * 64 + q0) * 512 + hq * 64;
    const float sink = p->sinks[l * 8 + hq];
    __syncthreads();
    {
        u32x4 kv[3], vv[3];
        bf16x8 qf[2][2];
#pragma unroll
        for (int it3 = 0; it3 < 3; ++it3) {
            const int idx = tid + it3 * 512, ch = idx / 192, kk = idx - ch * 192;
            const int kkc = kk >= kt0 * 16 ? kk : kt0 * 16;
            const size_t row = (size_t)b * 2048 + (c - 2) * 64 + kkc;
            kv[it3] = *(const u32x4*)(Kb + row * 128 + kvh * 64 + ch * 8);
            vv[it3] = *(const u32x4*)(Vb + row * 128 + kvh * 64 + ch * 8);
        }
        attn_load_q<2>(qo, lane, qf);
#pragma unroll
        for (int it3 = 0; it3 < 3; ++it3) {
            const int idx = tid + it3 * 512, ch = idx / 192, kk = idx - ch * 192;
            if (kk >= kt0 * 16) { *(u32x4*)(Ks + kk * 72 + ch * 8) = kv[it3]; scatter_vt(VT, ch, kk, vv[it3]); }
        }
        __syncthreads();
        attn_compute<2>(Ks, VT, qo, qf, kt0, 12, 192, sink, lane);
    }
}

__device__ __forceinline__ void attn_sample_item(KP p, int l, int it, unsigned char* shm) {
    const int tid = tid_(), w = tid >> 6, lane = tid & 63;
    const int sb = it >> 1, kvh = it & 1;
    bf16_t* Ks = (bf16_t*)shm; bf16_t* VT = Ks + 192 * 72;
    bf16_t* Qb = (bf16_t*)(p->ws + W_Q); const bf16_t* Kb = (const bf16_t*)(p->ws + W_K); const bf16_t* Vb = (const bf16_t*)(p->ws + W_V);
    __syncthreads();
    for (int idx = tid; idx < 160 * 8; idx += 512) {
        const int ch = idx / 160, kk = idx - ch * 160;
        u32x4 kv, vv;
        if (kk < 128) {
            const size_t o = ((((size_t)l * 32 + sb) * 128 + kk) * 2 + kvh) * 64 + ch * 8;
            const f32x4 k0 = *(const f32x4*)(p->cache_k + o), k1 = *(const f32x4*)(p->cache_k + o + 4);
            const f32x4 v0 = *(const f32x4*)(p->cache_v + o), v1 = *(const f32x4*)(p->cache_v + o + 4);
            kv.x = pk2(k0[0], k0[1]); kv.y = pk2(k0[2], k0[3]); kv.z = pk2(k1[0], k1[1]); kv.w = pk2(k1[2], k1[3]);
            vv.x = pk2(v0[0], v0[1]); vv.y = pk2(v0[2], v0[3]); vv.z = pk2(v1[0], v1[1]); vv.w = pk2(v1[2], v1[3]);
        } else if (kk < 144) {
            const size_t row = (size_t)TP + sb * 16 + (kk - 128);
            kv = *(const u32x4*)(Kb + row * 128 + kvh * 64 + ch * 8);
            vv = *(const u32x4*)(Vb + row * 128 + kvh * 64 + ch * 8);
        } else { kv = zero4(); vv = kv; }
        *(u32x4*)(Ks + kk * 72 + ch * 8) = kv;
        scatter_vt(VT, ch, kk, vv);
    }
    __syncthreads();
    if (w < 4) {
        const int hq = kvh * 4 + w;
        bf16_t* qo = Qb + ((size_t)TP + sb * 16) * 512 + hq * 64;
        bf16x8 qf[1][2];
        attn_load_q<1>(qo, lane, qf);
        attn_compute<1>(Ks, VT, qo, qf, 0, 10, 144, p->sinks[l * 8 + hq], lane);
    }
}

__device__ __forceinline__ void gmlp_item(KP p, int l, bool samp, int bi, int cidx, int g, unsigned char* shm) {
    const int tid = tid_(), w = tid >> 6, lane = tid & 63, fr = lane & 15, fq = lane >> 4;
    bf16_t* Wm = (bf16_t*)shm; bf16_t* VT = Wm + 128 * 136;
    const int L = samp ? 16 : 128;
    const int row0 = samp ? TP + bi * 16 : bi * 2048 + cidx * 128;
    bf16_t* GUb = (bf16_t*)(p->ws + W_GU); const bf16_t* GVb = (const bf16_t*)(p->ws + W_GV);
    __syncthreads();
    if (samp) {
        { const int idx = tid * 8, d = idx >> 5, s = idx & 31; *(u32x4*)(VT + d * 136 + s) = zero4(); }
        if (tid < 128) {
            const int t = tid >> 3, s4 = (tid & 7) * 4;
            f32x4 wv = (f32x4){0.f, 0.f, 0.f, 0.f};
            if (s4 < 16) wv = *(const f32x4*)(p->gm_w_s + ((size_t)(l * 4 + g) * 128 + t) * 128 + s4);
#pragma unroll
            for (int e = 0; e < 4; ++e) if (s4 + e > t) wv[e] = 0.f;
            u32x2 pk; pk.x = pk2(wv[0], wv[1]); pk.y = pk2(wv[2], wv[3]);
            *(u32x2*)(Wm + t * 136 + s4) = pk;
        }
        __syncthreads();
    }
    if (!samp) {
        const int r = tid >> 2, q = tid & 3;
        const bf16_t* src = GVb + (size_t)(row0 + r) * 512 + q * 128;
        u32x4 rv[16];
#pragma unroll
        for (int k = 0; k < 16; ++k) rv[k] = *(const u32x4*)(src + k * 8);
        float s = 0.f, s2 = 0.f;
#pragma unroll
        for (int k = 0; k < 16; ++k) {
            const float a0 = bflo(rv[k].x), a1 = bfhi(rv[k].x), a2 = bflo(rv[k].y), a3 = bfhi(rv[k].y), a4 = bflo(rv[k].z), a5 = bfhi(rv[k].z), a6 = bflo(rv[k].w), a7 = bfhi(rv[k].w);
            s += ((a0 + a1) + (a2 + a3)) + ((a4 + a5) + (a6 + a7));
            s2 += ((a0 * a0 + a1 * a1) + (a2 * a2 + a3 * a3)) + ((a4 * a4 + a5 * a5) + (a6 * a6 + a7 * a7));
        }
        s += __shfl_xor(s, 1); s += __shfl_xor(s, 2); s2 += __shfl_xor(s2, 1); s2 += __shfl_xor(s2, 2);
        float* lgs = (float*)(VT + 128 * 136);
        if (q == 0) {
            const float mean = s * (1.f / 512.f);
            lgs[256 + 2 * r] = mean; lgs[257 + 2 * r] = rsqrtf(fmaxf(s2 * (1.f / 512.f) - mean * mean, 0.f) + EPSF);
        }
        if (tid < 128) lgs[tid] = p->gm_ln_g[l * 512 + g * 128 + tid]; else if (tid < 256) lgs[tid] = p->gm_ln_b[l * 512 + g * 128 + tid - 128];
        const int r2 = tid & 127, dq = tid >> 7;
        u32x4 xv[4];
#pragma unroll
        for (int k = 0; k < 4; ++k) xv[k] = *(const u32x4*)(GVb + (size_t)(row0 + r2) * 512 + g * 128 + dq * 32 + k * 8);
        __syncthreads();
        {
            const float mean = lgs[256 + 2 * r2], rstd = lgs[257 + 2 * r2];
#pragma unroll
            for (int k = 0; k < 4; ++k) {
                const unsigned uu[4] = {xv[k].x, xv[k].y, xv[k].z, xv[k].w};
                const f32x4 g0 = *(const f32x4*)(lgs + dq * 32 + k * 8), g1 = *(const f32x4*)(lgs + dq * 32 + k * 8 + 4);
                const f32x4 b0 = *(const f32x4*)(lgs + 128 + dq * 32 + k * 8), b1 = *(const f32x4*)(lgs + 128 + dq * 32 + k * 8 + 4);
#pragma unroll
                for (int e = 0; e < 8; ++e) {
                    const float v = (e & 1) ? bfhi(uu[e >> 1]) : bflo(uu[e >> 1]);
                    const float gg = e < 4 ? g0[e & 3] : g1[e & 3], bb = e < 4 ? b0[e & 3] : b1[e & 3];
                    VT[(dq * 32 + k * 8 + e) * 136 + r2] = f2bf((v - mean) * rstd * gg + bb);
                }
            }
        }
        {
            f32x4 wv[8];
#pragma unroll
            for (int q = 0; q < 8; ++q) { const int idx = tid + q * 512; wv[q] = *(const f32x4*)(p->gm_w_s + ((size_t)(l * 4 + g) * 128 + (idx >> 5)) * 128 + (idx & 31) * 4); }
#pragma unroll
            for (int q = 0; q < 8; ++q) {
                const int idx = tid + q * 512, t = idx >> 5, s4 = (idx & 31) * 4;
#pragma unroll
                for (int e = 0; e < 4; ++e) if (s4 + e > t) wv[q][e] = 0.f;
                u32x2 pk; pk.x = pk2(wv[q][0], wv[q][1]); pk.y = pk2(wv[q][2], wv[q][3]);
                *(u32x2*)(Wm + t * 136 + s4) = pk;
            }
        }
    } else if (w == 0) {
        u32x4 rawv[16];
#pragma unroll
        for (int r = 0; r < 16; ++r) rawv[r] = *(const u32x4*)(GVb + (size_t)(row0 + r) * 512 + lane * 8);
#pragma unroll
        for (int r = 0; r < 16; ++r) {
            const u32x4 raw = rawv[r];
            float v[8];
            v[0] = bflo(raw.x); v[1] = bfhi(raw.x); v[2] = bflo(raw.y); v[3] = bfhi(raw.y); v[4] = bflo(raw.z); v[5] = bfhi(raw.z); v[6] = bflo(raw.w); v[7] = bfhi(raw.w);
            float s = 0.f;
#pragma unroll
            for (int e = 0; e < 8; ++e) s += v[e];
            const float mean = wave_sum(s) * (1.f / 512.f);
            float s2 = 0.f;
#pragma unroll
            for (int e = 0; e < 8; ++e) { v[e] -= mean; s2 += v[e] * v[e]; }
            const float rstd = rsqrtf(wave_sum(s2) * (1.f / 512.f) + EPSF);
            if (fq == g) {
#pragma unroll
                for (int e = 0; e < 8; ++e) {
                    const int d = fr * 8 + e, col = g * 128 + d;
                    const float vn = v[e] * rstd * p->gm_ln_g[l * 512 + col] + p->gm_ln_b[l * 512 + col];
                    VT[d * 136 + r] = f2bf(vn);
                    p->out[O_GS + ((size_t)(l * 32 + bi) * 16 + r) * 512 + col] = vn;
                }
            }
        }
    }
    bf16_t uv[4][8];
    if (w * 16 < L) {
#pragma unroll
        for (int j = 0; j < 4; ++j)
#pragma unroll
            for (int dt = 0; dt < 8; ++dt) uv[j][dt] = GUb[(size_t)(row0 + w * 16 + fq * 4 + j) * 512 + g * 128 + dt * 16 + fr];
    }
    __syncthreads();
    if (w * 16 < L) {
        f32x4 acc[8];
#pragma unroll
        for (int dt = 0; dt < 8; ++dt) acc[dt] = (f32x4){0.f, 0.f, 0.f, 0.f};
        const int nks = samp ? 1 : ((w * 16 + 15) >> 5) + 1;
#pragma unroll
        for (int ks = 0; ks < 4; ++ks) {
            if (ks < nks) {
                const bf16x8 wf = *(const bf16x8*)(Wm + (w * 16 + fr) * 136 + ks * 32 + fq * 8);
                bf16x8 vf[8];
#pragma unroll
                for (int dt = 0; dt < 8; ++dt) vf[dt] = *(const bf16x8*)(VT + (dt * 16 + fr) * 136 + ks * 32 + fq * 8);
#pragma unroll
                for (int dt = 0; dt < 8; ++dt) acc[dt] = mfma16(wf, vf[dt], acc[dt]);
            }
        }
#pragma unroll
        for (int j = 0; j < 4; ++j) {
            const int t = w * 16 + fq * 4 + j;
            const float bias = p->gm_b_s[(l * 4 + g) * 128 + t];
#pragma unroll
            for (int dt = 0; dt < 8; ++dt) {
                const size_t idx = (size_t)(row0 + t) * 512 + g * 128 + dt * 16 + fr;
                GUb[idx] = f2bf(bf2f(uv[j][dt]) * (acc[dt][j] + bias));
            }
        }
    }
}

constexpr size_t XT_SAMP = (size_t)256 * 1024 * 64, BT_SAMP = (size_t)256 * 256 * 64;
__device__ __forceinline__ void conv_prepass(KP p, int l, unsigned char* shm) {
    const int tid = tid_();
    bf16_t* R = (bf16_t*)shm;
    bf16_t* An = R + 67 * 264;
    bf16_t* At = An + 64 * 264;
    unsigned char* ws = p->ws;
    const bf16_t* Xb = (const bf16_t*)(ws + W_XBC);
    bf16_t* XT = (bf16_t*)(ws + W_H); bf16_t* BCN = (bf16_t*)(ws + W_BCN); bf16_t* BTg = (bf16_t*)(ws + W_BT);
    for (int it = blockIdx.x; it < 288 * 6; it += gridDim.x) {
        const int cidx = it / 6, slab = it - cidx * 6;
        const bool samp = cidx >= 256; const int sb = cidx - 256;
        const int row0 = samp ? TP + sb * 16 : cidx * 64, Lv = samp ? 16 : 64, c0 = slab * 256;
        __syncthreads();
        {
            u32x4 v[5];
#pragma unroll
            for (int q = 0; q < 5; ++q) {
                const int idx = tid + q * 512, r = idx >> 5, ck = idx & 31, rr = r - 3;
                v[q] = zero4();
                if (idx < (Lv + 3) * 32) {
                    if (rr >= 0 || (!samp && (cidx & 31) > 0)) v[q] = *(const u32x4*)(Xb + (size_t)(row0 + rr) * 1536 + c0 + ck * 8);
                    else if (samp) {
                        const float* sp = p->state_conv + (((size_t)l * 32 + sb) * 3 + (3 + rr)) * 1536 + c0 + ck * 8;
                        const f32x4 a = *(const f32x4*)sp, b = *(const f32x4*)(sp + 4);
                        v[q].x = pk2(a[0], a[1]); v[q].y = pk2(a[2], a[3]); v[q].z = pk2(b[0], b[1]); v[q].w = pk2(b[2], b[3]);
                    }
                }
            }
#pragma unroll
            for (int q = 0; q < 5; ++q) {
                const int idx = tid + q * 512;
                if (idx < (Lv + 3) * 32) *(u32x4*)(R + (idx >> 5) * 264 + (idx & 31) * 8) = v[q];
            }
        }
        __syncthreads();
        {
            const int j = tid & 255, tq = tid >> 8;
            if (tq * 32 < Lv) {
                const float w0 = p->conv_w[(l * 4 + 0) * 1536 + c0 + j], w1 = p->conv_w[(l * 4 + 1) * 1536 + c0 + j];
                const float w2 = p->conv_w[(l * 4 + 2) * 1536 + c0 + j], w3 = p->conv_w[(l * 4 + 3) * 1536 + c0 + j], cb = p->conv_b[l * 1536 + c0 + j];
                float x0 = bf2f(R[(tq * 32 + 0) * 264 + j]), x1 = bf2f(R[(tq * 32 + 1) * 264 + j]), x2 = bf2f(R[(tq * 32 + 2) * 264 + j]);
#pragma unroll
                for (int e = 0; e < 32; e += 2) {
                    const int t = tq * 32 + e;
                    if (t < Lv) {
                        const float x3 = bf2f(R[(t + 3) * 264 + j]), x4 = bf2f(R[(t + 4) * 264 + j]);
                        const float o0 = siluf_(cb + w0 * x0 + w1 * x1 + w2 * x2 + w3 * x3);
                        const float o1 = siluf_(cb + w0 * x1 + w1 * x2 + w2 * x3 + w3 * x4);
                        x0 = x2; x1 = x3; x2 = x4;
                        const unsigned pk = pk2(o0, o1);
                        An[t * 264 + j] = (bf16_t)(pk & 0xffffu); An[(t + 1) * 264 + j] = (bf16_t)(pk >> 16);
                        *(unsigned*)(At + j * 66 + t) = pk;
                    }
                }
            }
        }
        __syncthreads();
        if (slab >= 4) {
            for (int idx = tid; idx < Lv * 32; idx += 512) {
                const int t = idx >> 5, ck = idx & 31;
                *(u32x4*)(BCN + (size_t)(row0 + t) * 512 + (slab - 4) * 256 + ck * 8) = *(const u32x4*)(An + t * 264 + ck * 8);
            }
        }
        if (slab < 5) {
            const int sh = samp ? 1 : 3;
            bf16_t* dst;
            if (slab < 4) dst = samp ? XT + XT_SAMP + ((size_t)sb * 1024 + slab * 256) * 16 : XT + ((size_t)cidx * 1024 + slab * 256) * 64;
            else dst = samp ? BTg + BT_SAMP + (size_t)sb * 256 * 16 : BTg + (size_t)cidx * 256 * 64;
            for (int idx = tid; idx < (256 << sh); idx += 512) {
                const int j = idx >> sh, tc = idx & ((1 << sh) - 1);
                const unsigned* src = (const unsigned*)(At + j * 66 + tc * 8);
                u32x4 v; v.x = src[0]; v.y = src[1]; v.z = src[2]; v.w = src[3];
                *(u32x4*)(dst + (size_t)j * Lv + tc * 8) = v;
            }
        }
    }
    __syncthreads();
}

__device__ __forceinline__ void ssd_item(KP p, int l, bool samp, int bi, int h, unsigned char* shm) {
    const int tid = tid_(), w = tid >> 6, lane = tid & 63, fr = lane & 15, fq = lane >> 4;
    bf16_t* xT = (bf16_t*)shm;
    bf16_t* xwT = xT + 64 * 72;
    bf16_t* Bs = xwT + 64 * 72;
    bf16_t* BT = Bs + 64 * 136;
    bf16_t* Cs = BT + 128 * 72;
    bf16_t* Ms = Cs + 64 * 136;
    bf16_t* hb = Ms + 64 * 72;
    float* cumv = (float*)(hb + 64 * 136);
    float* dtv = cumv + 64;
    float* scl = dtv + 64;
    const int gr = h >> 3, nch = samp ? 1 : 32, Lv = samp ? 16 : 64;
    const int rowbase = samp ? TP + bi * 16 : bi * 2048;
    const float a_h = -__expf(p->a_log[l * 16 + h]), Dh = p->d_skip[l * 16 + h];
    unsigned char* ws = p->ws;
    const float* DT = (const float*)(ws + W_DT);
    const bf16_t* XTg = (const bf16_t*)(ws + W_H); const bf16_t* BCN = (const bf16_t*)(ws + W_BCN); const bf16_t* BTg = (const bf16_t*)(ws + W_BT);
    bf16_t* Zb = (bf16_t*)(ws + W_Z);
    float* ROWSS = (float*)(ws + W_ROWSS);
    const int pts = w >> 1, nt0 = (w & 1) * 4;
    f32x4 hacc[4];
    float* stout = samp ? p->out + O_SS + (((size_t)l * 32 + bi) * 16 + h) * 8192 : p->out + O_SP + (((size_t)l * 8 + bi) * 16 + h) * 8192;
    __syncthreads();
#pragma unroll
    for (int i = 0; i < 4; ++i) {
#pragma unroll
        for (int j = 0; j < 4; ++j) {
            const int pr = pts * 16 + fq * 4 + j, n = (nt0 + i) * 16 + fr;
            float v = 0.f;
            if (samp) v = p->state_ssm[((((size_t)l * 32 + bi) * 16 + h) * 64 + pr) * 128 + n];
            hacc[i][j] = v;
            hb[pr * 136 + n] = f2bf(v);
        }
    }
    const int ttile = w >> 1, half = w & 1;
    const int xp = tid >> 3, xc = tid & 7;

    u32x4 lx, lb[2], lc[2], lbt[2];
    float dcur = 0.f;
    auto load_ops = [&](int chx) {
        const int t0x = rowbase + chx * 64;
        lx = zero4();
        if (!samp) {
            const size_t cidx = (size_t)bi * 32 + chx;
            lx = *(const u32x4*)(XTg + (cidx * 1024 + h * 64 + xp) * 64 + xc * 8);
#pragma unroll
            for (int q = 0; q < 2; ++q) {
                const int idx = tid + q * 512;
                const bf16_t* rowp = BCN + (size_t)(t0x + (idx >> 4)) * 512 + gr * 128 + (idx & 15) * 8;
                lb[q] = *(const u32x4*)rowp; lc[q] = *(const u32x4*)(rowp + 256);
                lbt[q] = *(const u32x4*)(BTg + (cidx * 256 + gr * 128 + (idx >> 3)) * 64 + (idx & 7) * 8);
            }
        } else {
            if (xc < 2) lx = *(const u32x4*)(XTg + XT_SAMP + ((size_t)bi * 1024 + h * 64 + xp) * 16 + xc * 8);
#pragma unroll
            for (int q = 0; q < 2; ++q) {
                const int idx = tid + q * 512;
                lb[q] = zero4(); lc[q] = lb[q]; lbt[q] = lb[q];
                if ((idx >> 4) < 16) {
                    const bf16_t* rowp = BCN + (size_t)(t0x + (idx >> 4)) * 512 + gr * 128 + (idx & 15) * 8;
                    lb[q] = *(const u32x4*)rowp; lc[q] = *(const u32x4*)(rowp + 256);
                }
                if ((idx & 7) < 2) lbt[q] = *(const u32x4*)(BTg + BT_SAMP + ((size_t)bi * 256 + gr * 128 + (idx >> 3)) * 16 + (idx & 7) * 8);
            }
        }
        dcur = 0.f;
        if (w == 0 && lane < Lv) dcur = DT[(size_t)(t0x + lane) * 16 + h];
    };
    load_ops(0);

    for (int ch = 0; ch < nch; ++ch) {
        const int t0 = rowbase + ch * 64;
        bf16_t zr[8];
#pragma unroll
        for (int j = 0; j < 4; ++j)
#pragma unroll
            for (int i = 0; i < 2; ++i) {
                int t = ttile * 16 + fq * 4 + j; t = t < Lv ? t : Lv - 1;
                zr[j * 2 + i] = Zb[(size_t)(t0 + t) * 1024 + h * 64 + (half * 2 + i) * 16 + fr];
            }
        __syncthreads();
        if (w == 0) {
            const float c = wave_scan(dcur * a_h);
            const float c63 = __int_as_float(__builtin_amdgcn_readlane(__float_as_int(c), 63));
            cumv[lane] = c; dtv[lane] = dcur; scl[lane] = dcur * __expf(c63 - c);
        }
        *(u32x4*)(xT + xp * 72 + xc * 8) = lx;
#pragma unroll
        for (int q = 0; q < 2; ++q) {
            const int idx = tid + q * 512;
            *(u32x4*)(Bs + (idx >> 4) * 136 + (idx & 15) * 8) = lb[q];
            *(u32x4*)(Cs + (idx >> 4) * 136 + (idx & 15) * 8) = lc[q];
            *(u32x4*)(BT + (idx >> 3) * 72 + (idx & 7) * 8) = lbt[q];
        }
        __syncthreads();
        {
            const f32x4 s0 = *(const f32x4*)(scl + xc * 8), s1 = *(const f32x4*)(scl + xc * 8 + 4);
            u32x4 o;
            o.x = pk2(bflo(lx.x) * s0[0], bfhi(lx.x) * s0[1]); o.y = pk2(bflo(lx.y) * s0[2], bfhi(lx.y) * s0[3]);
            o.z = pk2(bflo(lx.z) * s1[0], bfhi(lx.z) * s1[1]); o.w = pk2(bflo(lx.w) * s1[2], bfhi(lx.w) * s1[3]);
            *(u32x4*)(xwT + xp * 72 + xc * 8) = o;
        }
        if (ch + 1 < nch) load_ops(ch + 1);
        f32x4 cb[2], yacc[2];
#pragma unroll
        for (int i = 0; i < 2; ++i) { cb[i] = (f32x4){0.f, 0.f, 0.f, 0.f}; yacc[i] = (f32x4){0.f, 0.f, 0.f, 0.f}; }
        {
            bf16x8 cf[4], bfr[4][2], hf[4][2];
#pragma unroll
            for (int ks = 0; ks < 4; ++ks) {
                cf[ks] = *(const bf16x8*)(Cs + (ttile * 16 + fr) * 136 + ks * 32 + fq * 8);
#pragma unroll
                for (int i = 0; i < 2; ++i) {
                    bfr[ks][i] = *(const bf16x8*)(Bs + ((half * 2 + i) * 16 + fr) * 136 + ks * 32 + fq * 8);
                    hf[ks][i] = *(const bf16x8*)(hb + ((half * 2 + i) * 16 + fr) * 136 + ks * 32 + fq * 8);
                }
            }
#pragma unroll
            for (int ks = 0; ks < 4; ++ks)
#pragma unroll
                for (int i = 0; i < 2; ++i) { cb[i] = mfma16(cf[ks], bfr[ks][i], cb[i]); yacc[i] = mfma16(cf[ks], hf[ks][i], yacc[i]); }
        }
#pragma unroll
        for (int j = 0; j < 4; ++j) {
            const int t = ttile * 16 + fq * 4 + j;
            const float ct = cumv[t];
            const float et = __expf(ct);
#pragma unroll
            for (int i = 0; i < 2; ++i) {
                const int s = (half * 2 + i) * 16 + fr;
                const float mv = (s <= t) ? cb[i][j] * __expf(ct - cumv[s]) * dtv[s] : 0.f;
                Ms[t * 72 + s] = f2bf(mv);
                yacc[i][j] *= et;
            }
        }
        __syncthreads();
        bf16x8 mf[2], xf[2][2], xwf[2], btf[2][4];
#pragma unroll
        for (int ks = 0; ks < 2; ++ks) {
            mf[ks] = *(const bf16x8*)(Ms + (ttile * 16 + fr) * 72 + ks * 32 + fq * 8);
#pragma unroll
            for (int i = 0; i < 2; ++i) xf[ks][i] = *(const bf16x8*)(xT + ((half * 2 + i) * 16 + fr) * 72 + ks * 32 + fq * 8);
            xwf[ks] = *(const bf16x8*)(xwT + (pts * 16 + fr) * 72 + ks * 32 + fq * 8);
#pragma unroll
            for (int i = 0; i < 4; ++i) btf[ks][i] = *(const bf16x8*)(BT + ((nt0 + i) * 16 + fr) * 72 + ks * 32 + fq * 8);
        }
#pragma unroll
        for (int ks = 0; ks < 2; ++ks)
#pragma unroll
            for (int i = 0; i < 2; ++i) yacc[i] = mfma16(mf[ks], xf[ks][i], yacc[i]);
        {
            float ssq[4] = {0.f, 0.f, 0.f, 0.f};
#pragma unroll
            for (int j = 0; j < 4; ++j) {
                const int t = ttile * 16 + fq * 4 + j;
                if (!samp || t < Lv) {
#pragma unroll
                    for (int i = 0; i < 2; ++i) {
                        const int pc = (half * 2 + i) * 16 + fr;
                        const float xv = bf2f(xT[pc * 72 + t]);
                        const float y = yacc[i][j] + Dh * xv;
                        const size_t zi = (size_t)(t0 + t) * 1024 + h * 64 + pc;
                        const float uu = y * siluf_(bf2f(zr[j * 2 + i]));
                        Zb[zi] = f2bf(uu);
                        ssq[j] += uu * uu;
                    }
                }
            }
#pragma unroll
            for (int j = 0; j < 4; ++j) {
                const float s = row16_sum(ssq[j]);
                const int t = ttile * 16 + fq * 4 + j;
                if (fr == 0 && (!samp || t < Lv)) atomicAdd(ROWSS + t0 + t, s);
            }
        }
        const float dec = __expf(cumv[63]);
#pragma unroll
        for (int i = 0; i < 4; ++i) hacc[i] *= dec;
#pragma unroll
        for (int ks = 0; ks < 2; ++ks)
#pragma unroll
            for (int i = 0; i < 4; ++i) hacc[i] = mfma16(xwf[ks], btf[ks][i], hacc[i]);
#pragma unroll
        for (int i = 0; i < 4; ++i)
#pragma unroll
            for (int j = 0; j < 4; ++j) hb[(pts * 16 + fq * 4 + j) * 136 + (nt0 + i) * 16 + fr] = f2bf(hacc[i][j]);
    }
#pragma unroll
    for (int i = 0; i < 4; ++i)
#pragma unroll
        for (int j = 0; j < 4; ++j) stout[(pts * 16 + fq * 4 + j) * 128 + (nt0 + i) * 16 + fr] = hacc[i][j];
}

constexpr int N_OTHER = 512 + 512 + 512 + 64 + 128;
__device__ __forceinline__ void phase_mixers(int l, unsigned char* shm) {
    int* s_item = (int*)(shm + 131072);
    for (int it = blockIdx.x; it < 128; it += gridDim.x) ssd_item(kparams(), l, false, it >> 4, it & 15, shm);
    unsigned nxt_ticket = 0u;
    if (threadIdx.x == 0) nxt_ticket = atomicAdd((unsigned*)(kparams()->ws + W_CNT) + l, 1u);
    for (;;) {
        __syncthreads();
        if (threadIdx.x == 0) *s_item = (int)nxt_ticket;
        __syncthreads();
        int j = *s_item;
        if (j >= N_OTHER) break;
        const KP p = kparams();
        if (threadIdx.x == 0) nxt_ticket = atomicAdd((unsigned*)(p->ws + W_CNT) + l, 1u);
        if (j < 512) { attn_prompt_item(p, l, j, shm); continue; } j -= 512;
        if (j < 512) { gmlp_item(p, l, false, j >> 6, (j >> 2) & 15, j & 3, shm); continue; } j -= 512;
        if (j < 512) { ssd_item(p, l, true, j >> 4, j & 15, shm); continue; } j -= 512;
        if (j < 64) { attn_sample_item(p, l, j, shm); continue; } j -= 64;
        gmlp_item(p, l, true, j >> 2, 0, j & 3, shm);
    }
}

#define XB_TMO      128
#define XB_XCNT(j)  (256  + 64 * (j))
#define XB_XSUB(j)  (1280 + 64 * (j))
#define XB_XGEN(j)  (2304 + 64 * (j))
#define XB_TOP      3328
#define XB_TOPGEN   3392
#define XCD_BAR_WORDS 3456
#define XB_SPIN_CAP (1u << 18)
__device__ __forceinline__ unsigned xb_ld(unsigned* p)              { return __hip_atomic_load(p, __ATOMIC_RELAXED, __HIP_MEMORY_SCOPE_AGENT); }
__device__ __forceinline__ unsigned xb_add(unsigned* p, unsigned v) { return __hip_atomic_fetch_add(p, v, __ATOMIC_RELAXED, __HIP_MEMORY_SCOPE_AGENT); }
__device__ __forceinline__ unsigned xb_xcc_id() { return (unsigned)__builtin_amdgcn_s_getreg((3 << 11) | 20) & 0xFu; }
#define XB_SPIN(cond, bar) do { unsigned _sp = 0; while (cond) { __builtin_amdgcn_s_sleep(1); \
    if ((++_sp & 255u) == 0u) { if (xb_ld(&(bar)[XB_TMO])) break; if (_sp > XB_SPIN_CAP) { atomicAdd(&(bar)[XB_TMO], 1u); break; } } } } while (0)
struct XcdBarrier { unsigned* bar; unsigned x; volatile LAS unsigned* st; };
__device__ __forceinline__ XcdBarrier xcd_barrier_post(unsigned* bar, volatile LAS unsigned* st) {
    XcdBarrier b; b.bar = bar; b.x = xb_xcc_id(); b.st = st;
    if (threadIdx.x == 0) (void)xb_add(&bar[XB_XCNT(b.x)], 1u);
    return b;
}
__device__ __forceinline__ void xcd_barrier_complete(unsigned* bar, unsigned x, unsigned& nloc, unsigned& nx) {
    const unsigned G = gridDim.x * gridDim.y * gridDim.z;
    unsigned sum, cnt, mine, sp = 0u;
    for (;;) {
        sum = 0u; cnt = 0u; mine = 0u;
#pragma unroll
        for (unsigned j = 0; j < 16; ++j) { const unsigned c = xb_ld(&bar[XB_XCNT(j)]); sum += c; cnt += (c > 0u) ? 1u : 0u; mine = (j == x) ? c : mine; }
        if (sum == G) break;
        __builtin_amdgcn_s_sleep(1);
        if ((++sp & 255u) == 0u) { if (xb_ld(&bar[XB_TMO])) break; if (sp > XB_SPIN_CAP) { atomicAdd(&bar[XB_TMO], 1u); break; } }
    }
    nloc = mine > 0u ? mine : 1u; nx = cnt > 0u ? cnt : 1u;
}
__device__ __forceinline__ void xcd_barrier(const XcdBarrier& b) {
    asm volatile("s_waitcnt vmcnt(0)" ::: "memory");
    __syncthreads();
    if (threadIdx.x == 0) {
        unsigned* bar = b.bar;
        __builtin_amdgcn_s_waitcnt(0);
        unsigned nloc = b.st[0], nx = b.st[1];
        if (nloc == 0u) { xcd_barrier_complete(bar, b.x, nloc, nx); b.st[0] = nloc; b.st[1] = nx; }
        const unsigned old = xb_add(&bar[XB_XSUB(b.x)], 1u);
        const unsigned gen = old / nloc;
        if (old + 1u == (gen + 1u) * nloc) {
            __builtin_amdgcn_fence(__ATOMIC_RELEASE, "agent");
            asm volatile("s_waitcnt vmcnt(0)" ::: "memory");
            const unsigned og = xb_add(&bar[XB_TOP], 1u);
            const unsigned tg = og / nx;
            if (og + 1u == (tg + 1u) * nx) xb_add(&bar[XB_TOPGEN], 1u);
            else XB_SPIN(xb_ld(&bar[XB_TOPGEN]) == tg, bar);
            __builtin_amdgcn_fence(__ATOMIC_ACQUIRE, "agent");
            xb_add(&bar[XB_XGEN(b.x)], 1u);
            asm volatile("s_waitcnt vmcnt(0)" ::: "memory");
        } else {
            XB_SPIN(xb_ld(&bar[XB_XGEN(b.x)]) == gen, bar);
            __builtin_amdgcn_fence(__ATOMIC_ACQUIRE, "agent");
            asm volatile("s_waitcnt vmcnt(0)" ::: "memory");
        }
    }
    __syncthreads();
}
__device__ __forceinline__ void grid_seam(unsigned char* shm) {
    XcdBarrier b; b.bar = (unsigned*)(kparams()->ws + W_BAR); b.x = xb_xcc_id(); b.st = (volatile LAS unsigned*)(LAS unsigned char*)(shm + 131072 + 16);
    xcd_barrier(b);
}

__global__ void __launch_bounds__(512, 2) fwd_kernel(Params p_unused) {
    extern __shared__ __attribute__((aligned(16))) unsigned char shm[];
    cg::grid_group grid = cg::this_grid();
    LAS unsigned char* lds = (LAS unsigned char*)shm;
    const int tid = tid_();
#if PROBE_MASK
    unsigned long long probe_acc = 0;
#endif

    {
        if (tid == 0) { volatile LAS unsigned* st = (volatile LAS unsigned*)(LAS unsigned char*)(shm + 131072 + 16); st[0] = 0u; st[1] = 0u; }
        __syncthreads();
        const KP p = kparams();
        (void)xcd_barrier_post((unsigned*)(p->ws + W_BAR), (volatile LAS unsigned*)(LAS unsigned char*)(shm + 131072 + 16));
        if (p->ws == nullptr) grid.sync();
    }
    PH_BEGIN(0);
    phase_mod(kparams(), (float*)shm);
    {
        const KP p = kparams();
        unsigned char* ws = p->ws;
        f32x2* rope = (f32x2*)(ws + W_ROPE);
        for (int idx = blockIdx.x * 512 + tid_(); idx < 2064 * 8; idx += gridDim.x * 512) {
            const int pi = idx >> 3, j = idx & 7;
            const float pos = (float)(pi < 2048 ? pi : 4096 + (pi - 2048));
            const float invf = exp2f(-(float)j * 0.125f * 18.931568569324174f);
            const float ang = pos * invf;
            const double a = (double)ang;
            const double kk = rint(a * 0.15915494309189535);
            const float r = (float)(a - kk * 6.283185307179586);
            rope[idx] = (f32x2){__cosf(r), __sinf(r)};
        }
        float* ROWSS = (float*)(ws + W_ROWSS);
        for (int idx = blockIdx.x * 512 + tid_(); idx < T; idx += gridDim.x * 512) ROWSS[idx] = 0.f;
        if (blockIdx.x == 0 && tid < 64) ((unsigned*)(ws + W_CNT))[tid] = 0u;
    }
    convert_weights(kparams(), 0, (float*)shm);
    grid_seam(shm);
    PH_END(0);

#pragma unroll 1
    for (int l = 0; l < 2; ++l) {
        PH_BEGIN(1);
        {
            const KP p = kparams();
            float* X = p->out + O_Y;
            phase_norm(p, l, l == 0 ? p->x_prompt : X, l == 0 ? p->x_sample : X + (size_t)TP * 1024, p->g_mix + l * 1024, 0);
        }
        if (l == 1) {
            convert_weights(kparams(), 1, (float*)shm);
            float* ROWSS = (float*)(kparams()->ws + W_ROWSS);
            for (int idx = blockIdx.x * 512 + tid_(); idx < T; idx += gridDim.x * 512) ROWSS[idx] = 0.f;
        }
        grid_seam(shm);
        PH_END(1);
        PH_BEGIN(2);
        {
            const KP p = kparams();
            const bf16_t* H = (const bf16_t*)(p->ws + W_H); const bf16_t* WT = (const bf16_t*)(p->ws + W_WT);
            pg8::StaticOrder S; S.init(T, NINP, (int)gridDim.x, (int)blockIdx.x);
            EpiIn E; E.l = l; E.pp = p;
            pg8::gemm_phase(lds, pg8::Gemm{H, WT + WT_IN, T, NINP, 1024}, S, E);
        }
        grid_seam(shm);
        PH_END(2);
        PH_BEGIN(3);
        conv_prepass(kparams(), l, shm);
        grid_seam(shm);
        phase_mixers(l, shm);
        grid_seam(shm);
        PH_END(3);
        PH_BEGIN(4);
#pragma unroll 1
        for (int b = 0; b < 3; ++b) {
            const KP p = kparams();
            unsigned char* ws = p->ws;
            const bf16_t* WT = (const bf16_t*)(ws + W_WT);
            const bf16_t* A = (const bf16_t*)(ws + (b == 0 ? W_Q : (b == 1 ? W_Z : W_GU)));
            const bf16_t* Bt = WT + (b == 0 ? WT_AO : (b == 1 ? WT_SO : WT_GO));
            const int K = b == 1 ? 1024 : 512;
            EpiRC<FMerge, 4> E; E.f.b = b; E.f.G8 = ws + W_G8; E.f.rowss = (const float*)(ws + W_ROWSS); E.f.MG = (bf16_t*)(ws + W_H);
            pg8::StaticOrder S; S.init(TP, 1024, (int)gridDim.x, (int)blockIdx.x);
            pg8::gemm_phase(lds, pg8::Gemm{A, Bt, TP, 1024, K}, S, E);
            if (K == 512) skinny_gemm<64>(shm, A + (size_t)TP * K, Bt, 1024, E.f); else skinny_gemm<128>(shm, A + (size_t)TP * K, Bt, 1024, E.f);
        }
        grid_seam(shm);
        PH_END(4);
#pragma unroll 1
        for (int s2 = 0; s2 < 2; ++s2) {
            PH_BEGIN(5);
            {
                const KP p = kparams();
                unsigned char* ws = p->ws;
                float* X = p->out + O_Y;
                const bf16_t* WT = (const bf16_t*)(ws + W_WT);
                const bf16_t* A = (const bf16_t*)(ws + (s2 == 0 ? W_H : W_FH));
                const bf16_t* Bt = WT + (s2 == 0 ? WT_OUT : WT_F2);
                const int K = s2 == 0 ? 1024 : 4096;
                const bool first = (l == 0 && s2 == 0);
                FResid fs; fs.srcP = first ? p->x_prompt : X; fs.srcS = first ? p->x_sample : X + (size_t)TP * 1024; fs.X = X;
                fs.modg = (const float*)(ws + W_MOD) + (size_t)l * 40 * 6144 + (s2 == 0 ? 2 : 5) * 1024;
                EpiResidP E; E.src = fs.srcP; E.X = X; E.modg = fs.modg;
                pg8::StaticOrder S; S.init(TP, 1024, (int)gridDim.x, (int)blockIdx.x);
                pg8::gemm_phase(lds, pg8::Gemm{A, Bt, TP, 1024, K}, S, E);
                if (s2 == 0) skinny_gemm<128>(shm, A + (size_t)TP * K, Bt, 1024, fs); else skinny_gemm<512>(shm, A + (size_t)TP * K, Bt, 1024, fs);
            }
            grid_seam(shm);
            PH_END(5);
            if (s2 == 0) {
                PH_BEGIN(6);
                {
                    const KP p = kparams();
                    float* X = p->out + O_Y;
                    phase_norm(p, l, X, X + (size_t)TP * 1024, p->g_ff + l * 1024, 3);
                }
                grid_seam(shm);
                PH_END(6);
                PH_BEGIN(7);
                {
                    const KP p = kparams();
                    unsigned char* ws = p->ws;
                    const bf16_t* H = (const bf16_t*)(ws + W_H); const bf16_t* WT = (const bf16_t*)(ws + W_WT);
                    EpiRC<FRelu2> E; E.f.FH = (bf16_t*)(ws + W_FH);
                    pg8::StaticOrder S; S.init(TP, 4096, (int)gridDim.x, (int)blockIdx.x);
                    pg8::gemm_phase(lds, pg8::Gemm{H, WT + WT_F1, TP, 4096, 1024}, S, E);
                    skinny_gemm<128>(shm, H + (size_t)TP * 1024, WT + WT_F1, 4096, E.f);
                }
                grid_seam(shm);
                PH_END(7);
            }
        }
    }
    {
        const KP p = kparams();
        float* X = p->out + O_Y;
        const float* gf = p->g_final;
        const int tidf = tid_(), lane = tidf & 63, gw = blockIdx.x * 8 + (tidf >> 6), ngw = gridDim.x * 8;
        for (int row = gw; row < T; row += ngw) {
            f32x4* xr = (f32x4*)(X + (size_t)row * 1024);
            f32x4 v[4]; float ss = 0.f;
#pragma unroll
            for (int j = 0; j < 4; ++j) { v[j] = xr[lane + 64 * j]; ss += v[j][0] * v[j][0] + v[j][1] * v[j][1] + v[j][2] * v[j][2] + v[j][3] * v[j][3]; }
            ss = wave_sum(ss);
            const float rstd = rsqrtf(ss * (1.f / 1024.f) + EPSF);
#pragma unroll
            for (int j = 0; j < 4; ++j) { const f32x4 g = ((const f32x4*)gf)[lane + 64 * j]; xr[lane + 64 * j] = v[j] * rstd * g; }
        }
    }
#if PROBE_MASK
    { const unsigned long long t0 = wall_clock64(); while (wall_clock64() - t0 < probe_acc) __builtin_amdgcn_s_sleep(8); }
#endif
}

extern "C" void kernel_launch(void* const* d_in, const int* in_sizes, int n_in, void* d_out, int out_size, void* d_ws, size_t ws_size, hipStream_t stream) {
    static int grid_blocks = 0;
    if (!grid_blocks) {
        int dev = 0, cus = 0, per_cu = 0;
        hipGetDevice(&dev);
        hipDeviceGetAttribute(&cus, hipDeviceAttributeMultiprocessorCount, dev);
        hipFuncSetAttribute((const void*)fwd_kernel, hipFuncAttributeMaxDynamicSharedMemorySize, LDS_BYTES);
        hipOccupancyMaxActiveBlocksPerMultiprocessor(&per_cu, (const void*)fwd_kernel, 512, LDS_BYTES);
        if (per_cu < 1) per_cu = 1;
        grid_blocks = cus * per_cu;
        if (ws_size < W_END) fprintf(stderr, "kernel_launch: workspace too small: need %zu, got %zu\n", (size_t)W_END, ws_size);
    }
    Params p{};
    const float** fp = (const float**)&p;
    for (int i = 0; i < 31; ++i) fp[i] = (const float*)d_in[i];
    p.out = (float*)d_out; p.ws = (unsigned char*)d_ws;
    (void)hipMemsetAsync((unsigned char*)d_ws + W_BAR, 0, XCD_BAR_WORDS * 4, stream);
    void* args[] = {&p};
    hipError_t e = hipLaunchCooperativeKernel((const void*)fwd_kernel, dim3(grid_blocks), dim3(512), args, LDS_BYTES, stream);
    if (e != hipSuccess) fprintf(stderr, "cooperative launch failed: %s (grid %d)\n", hipGetErrorString(e), grid_blocks);
}
```

```cpp
#include <hip/hip_runtime.h>
#include <hip/hip_cooperative_groups.h>
#include <cstdio>
namespace cg = cooperative_groups;

#define LAS __attribute__((address_space(3)))
typedef unsigned short bf16_t;
typedef short bf16x8 __attribute__((ext_vector_type(8)));
typedef float f32x4 __attribute__((ext_vector_type(4)));
typedef float f32x2 __attribute__((ext_vector_type(2)));
typedef unsigned u32x2 __attribute__((ext_vector_type(2)));
typedef unsigned u32x4 __attribute__((ext_vector_type(4)));

constexpr int DM = 1024, TP = 16384, TS = 512, T = TP + TS;
constexpr int NINP = 7680;
constexpr float EPSF = 1e-6f;

constexpr size_t O_Y = 0;
constexpr size_t O_KP = (size_t)T * DM;
constexpr size_t O_VP = O_KP + 2 * 8 * 128 * 128;
constexpr size_t O_SP = O_VP + 2 * 8 * 128 * 128;
constexpr size_t O_CP = O_SP + (size_t)2 * 8 * 16 * 64 * 128;
constexpr size_t O_KS = O_CP + 2 * 8 * 3 * 1536;
constexpr size_t O_VS = O_KS + 2 * 32 * 16 * 128;
constexpr size_t O_SS = O_VS + 2 * 32 * 16 * 128;
constexpr size_t O_CS = O_SS + (size_t)2 * 32 * 16 * 64 * 128;
constexpr size_t O_GS = O_CS + 2 * 32 * 3 * 1536;

constexpr size_t WT_IN = 0;
constexpr size_t WT_AO = WT_IN + (size_t)NINP * 1024;
constexpr size_t WT_SO = WT_AO + 1024 * 512;
constexpr size_t WT_GO = WT_SO + 1024 * 1024;
constexpr size_t WT_OUT = WT_GO + 1024 * 512;
constexpr size_t WT_F1 = WT_OUT + 1024 * 1024;
constexpr size_t WT_F2 = WT_F1 + (size_t)4096 * 1024;
constexpr size_t WT_END = WT_F2 + (size_t)1024 * 4096;

constexpr size_t al256(size_t x) { return (x + 255) & ~(size_t)255; }
constexpr size_t W_WT = 0;
constexpr size_t W_MOD = al256(W_WT + WT_END * 2);
constexpr size_t W_ROPE = al256(W_MOD + (size_t)2 * 40 * 6144 * 4);
constexpr size_t W_ROWSS = al256(W_ROPE + (size_t)2064 * 8 * 8);
constexpr size_t W_CNT = al256(W_ROWSS + (size_t)T * 32 * 4);
constexpr size_t W_BAR = al256(W_CNT + 256);
constexpr size_t W_DT = al256(W_BAR + 3456 * 4);
constexpr size_t W_H = al256(W_DT + (size_t)T * 16 * 4);
constexpr size_t W_Q = al256(W_H + (size_t)T * 1024 * 2);
constexpr size_t W_K = W_Q + (size_t)T * 512 * 2;
constexpr size_t W_V = W_K + (size_t)T * 128 * 2;
constexpr size_t W_Z = W_V + (size_t)T * 128 * 2;
constexpr size_t W_XBC = W_Z + (size_t)T * 1024 * 2;
constexpr size_t W_GU = W_XBC + (size_t)T * 1536 * 2;
constexpr size_t W_GV = W_GU + (size_t)T * 512 * 2;
constexpr size_t W_PAEND = W_GV + (size_t)T * 512 * 2;
constexpr size_t W_FH = W_Q;
constexpr size_t W_G8 = al256(W_PAEND);
constexpr size_t W_BCN = al256(W_G8 + (size_t)T * 3072);
constexpr size_t W_BT = al256(W_BCN + (size_t)T * 512 * 2);
constexpr size_t W_END = W_BT + ((size_t)256 * 256 * 64 + (size_t)32 * 256 * 16) * 2;
static_assert((size_t)T * 4096 * 2 <= W_PAEND - W_Q, "FH alias");

constexpr int LDS_BYTES = 131072 + 2048;
#ifndef PROBE_MASK
#define PROBE_MASK 0
#endif
#if PROBE_MASK
#define PH_BEGIN(id) const unsigned long long _t_##id = wall_clock64()
#define PH_END(id) do { if ((PROBE_MASK >> (id)) & 1) probe_acc += wall_clock64() - _t_##id; } while (0)
#else
#define PH_BEGIN(id) do {} while (0)
#define PH_END(id) do {} while (0)
#endif

struct Params {
    const float *x_prompt, *x_sample, *c_prompt, *c_sample, *cache_k, *cache_v, *state_ssm, *state_conv;
    const float *w_ada, *b_ada, *g_mix, *w_in, *sinks, *conv_w, *conv_b, *dt_bias, *a_log, *d_skip, *ssm_norm_w;
    const float *gm_ln_g, *gm_ln_b, *gm_w_s, *gm_b_s, *w_attn_o, *w_ssm_o, *w_gm_o, *w_out, *g_ff, *w_ff1, *w_ff2, *g_final;
    float* out;
    unsigned char* ws;
};

typedef const Params __attribute__((address_space(4)))* KP;
__device__ __forceinline__ KP kparams() { KP q = (KP)__builtin_amdgcn_kernarg_segment_ptr(); asm volatile("" : "+s"(q)); return q; }

__device__ __forceinline__ int tid_() { int t = threadIdx.x; asm volatile("" : "+v"(t)); return t; }
__device__ __forceinline__ unsigned pk2(float lo, float hi) { unsigned r; asm("v_cvt_pk_bf16_f32 %0, %1, %2" : "=v"(r) : "v"(lo), "v"(hi)); return r; }
__device__ __forceinline__ bf16_t f2bf(float f) { return (bf16_t)(pk2(f, 0.f) & 0xffffu); }
__device__ __forceinline__ float bf2f(bf16_t b) { return __uint_as_float(((unsigned)b) << 16); }
__device__ __forceinline__ float bflo(unsigned u) { return __uint_as_float(u << 16); }
__device__ __forceinline__ float bfhi(unsigned u) { return __uint_as_float(u & 0xffff0000u); }
__device__ __forceinline__ float sigm(float x) { return __builtin_amdgcn_rcpf(1.f + __expf(-x)); }
__device__ __forceinline__ float siluf_(float x) { return x * sigm(x); }
__device__ __forceinline__ float geluf_(float x) { return x * sigm(1.5957691216057308f * (x + 0.044715f * x * x * x)); }
__device__ __forceinline__ float wave_sum(float v) {
#pragma unroll
    for (int o = 1; o < 64; o <<= 1) v += __shfl_xor(v, o);
    return v;
}
__device__ __forceinline__ u32x4 zero4() { unsigned z; asm volatile("v_mov_b32 %0, 0" : "=v"(z)); return (u32x4){z, z, z, z}; }
template <int CTRL, int RM = 0xf, int BK = 0xf>
__device__ __forceinline__ float dpp_add(float v) { return v + __int_as_float(__builtin_amdgcn_update_dpp(0, __float_as_int(v), CTRL, RM, BK, false)); }
__device__ __forceinline__ float row16_sum(float v) { v = dpp_add<0xB1>(v); v = dpp_add<0x4E>(v); v = dpp_add<0x141>(v); return dpp_add<0x140>(v); }
__device__ __forceinline__ float wave_scan(float c) { c = dpp_add<0x111>(c); c = dpp_add<0x112>(c); c = dpp_add<0x114>(c); c = dpp_add<0x118>(c); c = dpp_add<0x142, 0xa>(c); return dpp_add<0x143, 0xc>(c); }
__device__ __forceinline__ f32x4 mfma16(bf16x8 a, bf16x8 b, f32x4 c) { return __builtin_amdgcn_mfma_f32_16x16x32_bf16(a, b, c, 0, 0, 0); }
__device__ __forceinline__ int mod_row(int row) { return row < TP ? (row >> 11) : 8 + ((row - TP) >> 4); }

namespace pg8 {
constexpr int BM = 256, BK = 64, HALF = 128, HTB = HALF * BK * 2, STAGE_BYTES = 8 * HTB, NXCD = 8, WGM = 8;
__device__ __forceinline__ int lds_byte(int r, int c) { const int st = (r >> 4) * 2 + (c >> 5), rr = r & 15, cc = c & 31, ob = rr * 64 + cc * 2; return st * 1024 + (ob ^ (((ob >> 9) & 1) << 5)); }
__device__ __forceinline__ void stage_rc(int b, int& R, int& C) { const int st = b / 1024, sb = b % 1024, swz = sb ^ (((sb >> 9) & 1) << 5); R = (st >> 1) * 16 + swz / 64; C = (st & 1) * 32 + (swz % 64) / 2; }
struct Unit { int pm, pn; };
struct Gemm { const bf16_t* A; const bf16_t* Bt; int M, N, K; };
struct StaticOrder {
    int nM, nN, nwg, G, c;
    __device__ __forceinline__ void init(int M, int N, int G_, int c_) { nM = M / BM; nN = N / BM; nwg = nM * nN; G = G_; c = c_; }
    __device__ __forceinline__ bool next(int i, Unit& u) const {
        const long L = (long)i * G + c; if (L >= nwg) return false;
        int wgid = (int)L; { const int q = nwg / NXCD, r = nwg % NXCD, xcd = wgid % NXCD, off = wgid / NXCD; wgid = (xcd < r ? xcd * (q + 1) : r * (q + 1) + (xcd - r) * q) + off; }
        const int nig = WGM * nN, gid = wgid / nig, fm = gid * WGM, gsz = (nM - fm) < WGM ? (nM - fm) : WGM;
        u.pm = fm + ((wgid % nig) % gsz); u.pn = (wgid % nig) / gsz; return true;
    }
};
template <class Epi>
__device__ __forceinline__ void gemm_phase(LAS unsigned char* lds, const Gemm g, const StaticOrder& S, const Epi& E) {
    const int tid = tid_(), wid = __builtin_amdgcn_readfirstlane(tid >> 6), lane = tid & 63, wr = wid >> 2, wc = wid & 3, fr = lane & 15, fq = lane >> 4;
    const int K = g.K, nt = K / BK;
    unsigned voffA[2], voffB[2];
#pragma unroll
    for (int i = 0; i < 2; ++i) { int R, C; stage_rc(tid * 16 + i * 8192, R, C); voffA[i] = (unsigned)(R * K + C) * 2u; voffB[i] = voffA[i]; }
    const size_t kstep = (size_t)(BK * 2);
    const size_t hstep = (size_t)HALF * K * 2;
    const size_t tstep = 2 * hstep;
    const unsigned ldsw = (unsigned)wid * 1024u;
    const int aoff = lds_byte(wr * 64 + fr, fq * 8), boff = lds_byte(wc * 32 + fr, fq * 8);
#define PG8_SA(b, h) (((b) * 2 + (h)) * HTB)
#define PG8_SB(b, h) ((4 + (b) * 2 + (h)) * HTB)
#define PG8_STAGE(bufoff, gbase, voff) do { _Pragma("unroll") for (int _i = 0; _i < 2; ++_i) \
        __builtin_amdgcn_global_load_lds((const unsigned*)((const char*)(gbase) + (voff)[_i]), (LAS unsigned*)(lds + (bufoff) + ldsw + _i * 8192), 16, 0, 0); } while (0)
#define PG8_LDA(dst, b, h) do { _Pragma("unroll") for (int m = 0; m < 4; ++m) _Pragma("unroll") for (int k = 0; k < 2; ++k) dst[m][k] = *(const LAS bf16x8*)(lds + PG8_SA(b, h) + aoff + m * 2048 + k * 1024); } while (0)
#define PG8_LDB(dst, b, h) do { _Pragma("unroll") for (int n = 0; n < 2; ++n) _Pragma("unroll") for (int k = 0; k < 2; ++k) dst[n][k] = *(const LAS bf16x8*)(lds + PG8_SB(b, h) + boff + n * 2048 + k * 1024); } while (0)
#define PG8_MMA(ai, bj, At, Bt) do { __builtin_amdgcn_s_setprio(1); _Pragma("unroll") for (int m = 0; m < 4; ++m) _Pragma("unroll") for (int n = 0; n < 2; ++n) _Pragma("unroll") for (int k = 0; k < 2; ++k) \
        acc[ai][bj][m][n] = __builtin_amdgcn_mfma_f32_16x16x32_bf16(Bt[n][k], At[m][k], acc[ai][bj][m][n], 0, 0, 0); __builtin_amdgcn_s_setprio(0); } while (0)
#define PG8_WAIT_V(n) asm volatile("s_waitcnt vmcnt(" #n ")" ::: "memory")
#define PG8_WAIT_L(n) asm volatile("s_waitcnt lgkmcnt(" #n ")" ::: "memory")
#define PG8_BAR __builtin_amdgcn_s_barrier()
#define PG8_SCHED __builtin_amdgcn_sched_barrier(0)
    Unit cur, nxt; int ui = 0;
    if (!S.next(0, cur)) return;
    f32x4 acc[2][2][4][2];
#pragma unroll
    for (int a = 0; a < 2; ++a)
#pragma unroll
        for (int b = 0; b < 2; ++b)
#pragma unroll
            for (int m = 0; m < 4; ++m)
#pragma unroll
                for (int n = 0; n < 2; ++n) acc[a][b][m][n] = (f32x4){0.f, 0.f, 0.f, 0.f};
    bf16x8 At[4][2], B0[2][2], B1[2][2];
    const char* cA = (const char*)g.A + (size_t)cur.pm * tstep; const char* cB = (const char*)g.Bt + (size_t)cur.pn * tstep;
    PG8_STAGE(PG8_SB(0, 0), cB, voffB); PG8_STAGE(PG8_SA(0, 0), cA, voffA); PG8_STAGE(PG8_SB(0, 1), cB + hstep, voffB); PG8_STAGE(PG8_SA(0, 1), cA + hstep, voffA);
    if (wr == 1) PG8_BAR;
    PG8_WAIT_V(4); PG8_BAR;
    PG8_STAGE(PG8_SB(1, 0), cB + kstep, voffB); PG8_STAGE(PG8_SA(1, 0), cA + kstep, voffA); PG8_STAGE(PG8_SB(1, 1), cB + hstep + kstep, voffB);
    PG8_WAIT_V(6); PG8_BAR;
    for (;;) {
        const bool has_next = S.next(ui + 1, nxt);
        const char* nA = has_next ? (const char*)g.A + (size_t)nxt.pm * tstep : cA; const char* nB = has_next ? (const char*)g.Bt + (size_t)nxt.pn * tstep : cB;
        for (int t = 0; t < nt; t += 2) {
            const bool last = (t == nt - 2);
            const char* a1 = cA + (size_t)(t + 1) * kstep;
            const char* a2 = last ? nA : cA + (size_t)(t + 2) * kstep; const char* b2 = last ? nB : cB + (size_t)(t + 2) * kstep;
            const char* a3 = a2 + kstep; const char* b3 = b2 + kstep;
            PG8_LDB(B0, 0, 0); PG8_SCHED; PG8_LDA(At, 0, 0); PG8_STAGE(PG8_SA(1, 1), a1 + hstep, voffA);
            PG8_WAIT_L(8); PG8_BAR; PG8_WAIT_L(0); PG8_MMA(0, 0, At, B0); PG8_BAR; PG8_SCHED;
            PG8_LDB(B1, 0, 1); PG8_STAGE(PG8_SB(0, 0), b2, voffB);
            PG8_BAR; PG8_WAIT_L(0); PG8_MMA(0, 1, At, B1); PG8_BAR;
            PG8_LDA(At, 0, 1); PG8_STAGE(PG8_SA(0, 0), a2, voffA);
            PG8_BAR; PG8_WAIT_L(0); PG8_MMA(1, 0, At, B0); PG8_BAR; PG8_SCHED;
            PG8_STAGE(PG8_SB(0, 1), b2 + hstep, voffB);
            PG8_WAIT_V(6); PG8_BAR; PG8_MMA(1, 1, At, B1); PG8_BAR;
            PG8_LDB(B0, 1, 0); PG8_SCHED; PG8_LDA(At, 1, 0); PG8_STAGE(PG8_SA(0, 1), a2 + hstep, voffA);
            PG8_WAIT_L(8); PG8_BAR; PG8_WAIT_L(0); PG8_MMA(0, 0, At, B0); PG8_BAR; PG8_SCHED;
            PG8_LDB(B1, 1, 1); PG8_STAGE(PG8_SB(1, 0), b3, voffB);
            PG8_BAR; PG8_WAIT_L(0); PG8_MMA(0, 1, At, B1); PG8_BAR;
            PG8_LDA(At, 1, 1); PG8_STAGE(PG8_SA(1, 0), a3, voffA);
            PG8_BAR; PG8_WAIT_L(0); PG8_MMA(1, 0, At, B0); PG8_BAR; PG8_SCHED;
            PG8_STAGE(PG8_SB(1, 1), b3 + hstep, voffB);
            PG8_WAIT_V(6); PG8_BAR; PG8_MMA(1, 1, At, B1); PG8_BAR;
        }
        E(acc, cur, wr, wc, fr, fq);
        if (!has_next) break;
#pragma unroll
        for (int a = 0; a < 2; ++a)
#pragma unroll
            for (int b = 0; b < 2; ++b)
#pragma unroll
                for (int m = 0; m < 4; ++m)
#pragma unroll
                    for (int n = 0; n < 2; ++n) acc[a][b][m][n] = (f32x4){0.f, 0.f, 0.f, 0.f};
        cur = nxt; cA = nA; cB = nB; ++ui;
    }
    PG8_WAIT_V(0);
    if (wr == 0) PG8_BAR;
    PG8_BAR;
#undef PG8_SA
#undef PG8_SB
#undef PG8_STAGE
#undef PG8_LDA
#undef PG8_LDB
#undef PG8_MMA
#undef PG8_WAIT_V
#undef PG8_WAIT_L
#undef PG8_BAR
#undef PG8_SCHED
}
}

template <class F, int MG = 2> struct EpiRC {
    F f;
    __device__ __forceinline__ void operator()(const f32x4 (&acc)[2][2][4][2], const pg8::Unit& u, int wr, int wc, int fr, int fq) const {
        const int row0 = u.pm * 256 + wr * 64 + fr, col0 = u.pn * 256 + wc * 32 + 4 * fq;
#pragma unroll
        for (int ai = 0; ai < 2; ++ai)
#pragma unroll
            for (int mh = 0; mh < 4 / MG; ++mh) {
                typename F::Ld ld[MG][2][2];
#pragma unroll
                for (int mm = 0; mm < MG; ++mm)
#pragma unroll
                    for (int bj = 0; bj < 2; ++bj)
#pragma unroll
                        for (int n = 0; n < 2; ++n) f.load(row0 + ai * 128 + (mh * MG + mm) * 16, col0 + bj * 128 + n * 16, ld[mm][bj][n]);
#pragma unroll
                for (int mm = 0; mm < MG; ++mm)
#pragma unroll
                    for (int bj = 0; bj < 2; ++bj)
#pragma unroll
                        for (int n = 0; n < 2; ++n) f.apply(row0 + ai * 128 + (mh * MG + mm) * 16, col0 + bj * 128 + n * 16, acc[ai][bj][mh * MG + mm][n], ld[mm][bj][n]);
            }
    }
};
struct EpiResidP {
    const float* src; float* X; const float* modg;
    __device__ __forceinline__ void operator()(const f32x4 (&acc)[2][2][4][2], const pg8::Unit& u, int wr, int wc, int fr, int fq) const {
        const int row0 = u.pm * 256 + wr * 64 + fr, col0 = u.pn * 256 + wc * 32 + 4 * fq;
        const float* gp = modg + (size_t)((u.pm * 256) >> 11) * 6144 + col0;
        f32x4 g[2][2];
#pragma unroll
        for (int bj = 0; bj < 2; ++bj)
#pragma unroll
            for (int n = 0; n < 2; ++n) g[bj][n] = *(const f32x4*)(gp + bj * 128 + n * 16);
#pragma unroll
        for (int ai = 0; ai < 2; ++ai) {
            f32x4 x[4][2][2];
#pragma unroll
            for (int m = 0; m < 4; ++m)
#pragma unroll
                for (int bj = 0; bj < 2; ++bj)
#pragma unroll
                    for (int n = 0; n < 2; ++n) x[m][bj][n] = *(const f32x4*)(src + (size_t)(row0 + ai * 128 + m * 16) * 1024 + col0 + bj * 128 + n * 16);
#pragma unroll
            for (int m = 0; m < 4; ++m)
#pragma unroll
                for (int bj = 0; bj < 2; ++bj)
#pragma unroll
                    for (int n = 0; n < 2; ++n) *(f32x4*)(X + (size_t)(row0 + ai * 128 + m * 16) * 1024 + col0 + bj * 128 + n * 16) = x[m][bj][n] + g[bj][n] * acc[ai][bj][m][n];
        }
    }
};

template <int KW, class F>
__device__ __forceinline__ void skinny_gemm(unsigned char* shm, const bf16_t* A, const bf16_t* Bt, int N, const F& f) {
    constexpr int K = KW * 8, NS = KW / 32 < 4 ? KW / 32 : 4, NSTEP = KW / 32;
    const int tid = tid_(), w = tid >> 6, lane = tid & 63, fr = lane & 15, fq = lane >> 4;
    f32x4* red = (f32x4*)shm;
    const int nun = 16 * (N / 64);
    for (int u = blockIdx.x; u < nun; u += gridDim.x) {
        const int m0 = (u & 15) * 32, n0 = (u >> 4) * 64;
        typename F::Ld eld; const int er = TP + m0 + (w >> 2) * 16 + fr, ec = n0 + (w & 3) * 16 + fq * 4; f.load(er, ec, eld);
        f32x4 acc[2][4];
#pragma unroll
        for (int i = 0; i < 2; ++i)
#pragma unroll
            for (int j = 0; j < 4; ++j) acc[i][j] = (f32x4){0.f, 0.f, 0.f, 0.f};
        const bf16_t* ap = A + (size_t)(m0 + fr) * K + w * KW + fq * 8;
        const bf16_t* bp = Bt + (size_t)(n0 + fr) * K + w * KW + fq * 8;
        bf16x8 ra[NS][2], rb[NS][4];
#pragma unroll
        for (int s = 0; s < NS; ++s) {
#pragma unroll
            for (int i = 0; i < 2; ++i) ra[s][i] = *(const bf16x8*)(ap + (size_t)i * 16 * K + s * 32);
#pragma unroll
            for (int j = 0; j < 4; ++j) rb[s][j] = *(const bf16x8*)(bp + (size_t)j * 16 * K + s * 32);
        }
#pragma unroll
        for (int st = 0; st < NSTEP; ++st) {
            const int s = st % NS;
#pragma unroll
            for (int i = 0; i < 2; ++i)
#pragma unroll
                for (int j = 0; j < 4; ++j) acc[i][j] = mfma16(rb[s][j], ra[s][i], acc[i][j]);
            if (st + NS < NSTEP) {
#pragma unroll
                for (int i = 0; i < 2; ++i) ra[s][i] = *(const bf16x8*)(ap + (size_t)i * 16 * K + (st + NS) * 32);
#pragma unroll
                for (int j = 0; j < 4; ++j) rb[s][j] = *(const bf16x8*)(bp + (size_t)j * 16 * K + (st + NS) * 32);
            }
        }
        __syncthreads();
#pragma unroll
        for (int i = 0; i < 2; ++i)
#pragma unroll
            for (int j = 0; j < 4; ++j) red[(w * 8 + i * 4 + j) * 64 + lane] = acc[i][j];
        __syncthreads();
        f32x4 s = red[w * 64 + lane];
#pragma unroll
        for (int q = 1; q < 8; ++q) s += red[(q * 8 + w) * 64 + lane];
        f.apply(er, ec, s, eld);
    }
    __syncthreads();
}

struct EpiIn {
    int l; KP pp;
    __device__ __forceinline__ void operator()(const f32x4 (&acc)[2][2][4][2], const pg8::Unit& u, int wr, int wc, int fr, int fq) const {
        const KP p = pp;
        unsigned char* ws = p->ws;
        const int pn = u.pn;
        const int row0 = u.pm * 256 + wr * 64 + fr;
        const int ct0 = wc * 32 + 4 * fq;
        if (pn < 3) {
            bf16_t* Qb = (bf16_t*)(ws + W_Q); bf16_t* Kb = (bf16_t*)(ws + W_K); bf16_t* Vb = (bf16_t*)(ws + W_V);
            const f32x2* rope = (const f32x2*)(ws + W_ROPE);
#pragma unroll
            for (int ai = 0; ai < 2; ++ai)
#pragma unroll
                for (int m = 0; m < 4; ++m) {
                    const int row = row0 + ai * 128 + m * 16;
                    const bool samp = row >= TP;
                    const int b = samp ? (row - TP) >> 4 : row >> 11, t = samp ? (row - TP) & 15 : row & 2047;
                    const int pi = samp ? 2048 + t : t;
#pragma unroll
                    for (int bj = 0; bj < 2; ++bj)
#pragma unroll
                        for (int n = 0; n < 2; ++n) {
                            f32x4 v = acc[ai][bj][m][n];
                            const int ct = bj * 128 + ct0 + n * 16;
                            const bool isv = (pn == 2) && (bj == 1);
                            if (!isv && n == 0 && (wc & 1) == 0) {
                                f32x4 o;
                                o[0] = __shfl_xor(v[0], 32); o[1] = __shfl_xor(v[1], 32); o[2] = __shfl_xor(v[2], 32); o[3] = __shfl_xor(v[3], 32);
                                const f32x4* cs = (const f32x4*)(rope + pi * 8 + 4 * (fq & 1));
                                const f32x4 c01 = cs[0], c23 = cs[1];
                                const float sgn = (fq < 2) ? -1.f : 1.f;
                                v[0] = v[0] * c01[0] + sgn * o[0] * c01[1];
                                v[1] = v[1] * c01[2] + sgn * o[1] * c01[3];
                                v[2] = v[2] * c23[0] + sgn * o[2] * c23[1];
                                v[3] = v[3] * c23[2] + sgn * o[3] * c23[3];
                            }
                            u32x2 pk; pk.x = pk2(v[0], v[1]); pk.y = pk2(v[2], v[3]);
                            if (pn < 2) { *(u32x2*)(Qb + (size_t)row * 512 + pn * 256 + ct) = pk; }
                            else {
                                const int c = ct & 127;
                                bf16_t* dst = isv ? Vb : Kb;
                                *(u32x2*)(dst + (size_t)row * 128 + c) = pk;
                                if (samp) {
                                    float* o = p->out + (isv ? O_VS : O_KS) + ((size_t)(l * 32 + b) * 16 + t) * 128 + c;
                                    *(f32x4*)o = v;
                                } else if (t >= 1920) {
                                    float* o = p->out + (isv ? O_VP : O_KP) + ((size_t)(l * 8 + b) * 128 + (t - 1920)) * 128 + c;
                                    *(f32x4*)o = v;
                                }
                            }
                        }
                }
        } else if (pn < 7) {
            bf16_t* Zb = (bf16_t*)(ws + W_Z);
#pragma unroll
            for (int ai = 0; ai < 2; ++ai)
#pragma unroll
                for (int m = 0; m < 4; ++m) {
                    const int row = row0 + ai * 128 + m * 16;
#pragma unroll
                    for (int bj = 0; bj < 2; ++bj)
#pragma unroll
                        for (int n = 0; n < 2; ++n) {
                            const f32x4 v = acc[ai][bj][m][n];
                            u32x2 pk; pk.x = pk2(v[0], v[1]); pk.y = pk2(v[2], v[3]);
                            *(u32x2*)(Zb + (size_t)row * 1024 + (pn - 3) * 256 + bj * 128 + ct0 + n * 16) = pk;
                        }
                }
        } else if (pn < 13) {
            bf16_t* Xb = (bf16_t*)(ws + W_XBC);
#pragma unroll
            for (int ai = 0; ai < 2; ++ai)
#pragma unroll
                for (int m = 0; m < 4; ++m) {
                    const int row = row0 + ai * 128 + m * 16;
                    const bool samp = row >= TP;
                    const int b = samp ? (row - TP) >> 4 : row >> 11, t = samp ? (row - TP) & 15 : row & 2047;
#pragma unroll
                    for (int bj = 0; bj < 2; ++bj)
#pragma unroll
                        for (int n = 0; n < 2; ++n) {
                            const f32x4 v = acc[ai][bj][m][n];
                            const int cc = (pn - 7) * 256 + bj * 128 + ct0 + n * 16;
                            u32x2 pk; pk.x = pk2(v[0], v[1]); pk.y = pk2(v[2], v[3]);
                            *(u32x2*)(Xb + (size_t)row * 1536 + cc) = pk;
                            if (samp) { if (t >= 13) *(f32x4*)(p->out + O_CS + ((size_t)(l * 32 + b) * 3 + (t - 13)) * 1536 + cc) = v; }
                            else if (t >= 2045) *(f32x4*)(p->out + O_CP + ((size_t)(l * 8 + b) * 3 + (t - 2045)) * 1536 + cc) = v;
                        }
                }
        } else if (pn < 17) {
            bf16_t* dst = (bf16_t*)(ws + (pn < 15 ? W_GU : W_GV));
            const int cb = ((pn - 13) & 1) * 256;
#pragma unroll
            for (int ai = 0; ai < 2; ++ai)
#pragma unroll
                for (int m = 0; m < 4; ++m) {
                    const int row = row0 + ai * 128 + m * 16;
#pragma unroll
                    for (int bj = 0; bj < 2; ++bj)
#pragma unroll
                        for (int n = 0; n < 2; ++n) {
                            const f32x4 v = acc[ai][bj][m][n];
                            u32x2 pk; pk.x = pk2(geluf_(v[0]), geluf_(v[1])); pk.y = pk2(geluf_(v[2]), geluf_(v[3]));
                            *(u32x2*)(dst + (size_t)row * 512 + cb + bj * 128 + ct0 + n * 16) = pk;
                        }
                }
        } else if (pn < 29) {
            unsigned char* G8 = ws + W_G8;
#pragma unroll
            for (int ai = 0; ai < 2; ++ai)
#pragma unroll
                for (int m = 0; m < 4; ++m) {
                    const int row = row0 + ai * 128 + m * 16;
#pragma unroll
                    for (int bj = 0; bj < 2; ++bj)
#pragma unroll
                        for (int n = 0; n < 2; ++n) {
                            const f32x4 v = acc[ai][bj][m][n];
                            const unsigned q0 = (unsigned)(sigm(v[0]) * 255.f + 0.5f), q1 = (unsigned)(sigm(v[1]) * 255.f + 0.5f);
                            const unsigned q2 = (unsigned)(sigm(v[2]) * 255.f + 0.5f), q3 = (unsigned)(sigm(v[3]) * 255.f + 0.5f);
                            *(unsigned*)(G8 + (size_t)row * 3072 + (pn - 17) * 256 + bj * 128 + ct0 + n * 16) = q0 | (q1 << 8) | (q2 << 16) | (q3 << 24);
                        }
                }
        } else {
            if (wc == 0) {
                float* DT = (float*)(ws + W_DT);
                const f32x4 bias = *(const f32x4*)(p->dt_bias + l * 16 + 4 * fq);
#pragma unroll
                for (int ai = 0; ai < 2; ++ai)
#pragma unroll
                    for (int m = 0; m < 4; ++m) {
                        const int row = row0 + ai * 128 + m * 16;
                        f32x4 v = acc[ai][0][m][0] + bias;
#pragma unroll
                        for (int e = 0; e < 4; ++e) { const float x = v[e]; v[e] = fmaxf(x, 0.f) + log1pf(__expf(-fabsf(x))); }
                        *(f32x4*)(DT + (size_t)row * 16 + 4 * fq) = v;
                    }
            }
        }
    }
};

template <bool BIG> struct FMergeT {
    int b; const unsigned char* G8; const float* rowss; bf16_t* MG;
    const float* tile_rstd; int tile_row0;
    struct Ld { unsigned g; float ss; u32x2 o; };
    __device__ __forceinline__ void load(int row, int col, Ld& d) const {
        d.g = *(const unsigned*)(G8 + (size_t)row * 3072 + b * 1024 + col);
        d.ss = 1.f;
        if (b == 1) {
            if (BIG) d.ss = tile_rstd[row - tile_row0];
            else {
                const f32x4* pp = (const f32x4*)(rowss + (size_t)row * 32);
                const f32x4 t = ((pp[0] + pp[1]) + (pp[2] + pp[3])) + ((pp[4] + pp[5]) + (pp[6] + pp[7]));
                d.ss = rsqrtf(((t[0] + t[1]) + (t[2] + t[3])) * (1.f / 1024.f) + EPSF);
            }
        }
        d.o = (b > 0) ? *(const u32x2*)(MG + (size_t)row * 1024 + col) : (u32x2){0u, 0u};
    }
    __device__ __forceinline__ void apply(int row, int col, f32x4 v, const Ld& d) const {
        const float sc = d.ss * (1.f / 255.f);
        const unsigned g = d.g;
        f32x4 r;
        r[0] = (float)(g & 255u) * sc * v[0]; r[1] = (float)((g >> 8) & 255u) * sc * v[1];
        r[2] = (float)((g >> 16) & 255u) * sc * v[2]; r[3] = (float)(g >> 24) * sc * v[3];
        if (b > 0) { r[0] += bflo(d.o.x); r[1] += bfhi(d.o.x); r[2] += bflo(d.o.y); r[3] += bfhi(d.o.y); }
        u32x2 pk; pk.x = pk2(r[0], r[1]); pk.y = pk2(r[2], r[3]);
        *(u32x2*)(MG + (size_t)row * 1024 + col) = pk;
    }
};
struct FResid {
    const float* srcP; const float* srcS; float* X; const float* modg;
    struct Ld { f32x4 x, g; };
    __device__ __forceinline__ void load(int row, int col, Ld& d) const {
        const float* s = row < TP ? srcP + (size_t)row * 1024 + col : srcS + (size_t)(row - TP) * 1024 + col;
        d.x = *(const f32x4*)s;
        d.g = *(const f32x4*)(modg + (size_t)mod_row(row) * 6144 + col);
    }
    __device__ __forceinline__ void apply(int row, int col, f32x4 v, const Ld& d) const {
        *(f32x4*)(X + (size_t)row * 1024 + col) = d.x + d.g * v;
    }
};
struct FRelu2 {
    bf16_t* FH;
    struct Ld { };
    __device__ __forceinline__ void load(int, int, Ld&) const {}
    __device__ __forceinline__ void apply(int row, int col, f32x4 v, const Ld&) const {
        f32x4 r; r[0] = fmaxf(v[0], 0.f); r[1] = fmaxf(v[1], 0.f); r[2] = fmaxf(v[2], 0.f); r[3] = fmaxf(v[3], 0.f);
        u32x2 pk; pk.x = pk2(r[0] * r[0], r[1] * r[1]); pk.y = pk2(r[2] * r[2], r[3] * r[3]);
        *(u32x2*)(FH + (size_t)row * 4096 + col) = pk;
    }
};

__device__ __forceinline__ void phase_mod(KP p, float* lds) {
    float* sc = lds;
    float* red = lds + 20480;
    float* MOD = (float*)(p->ws + W_MOD);
    const int tid = tid_();
    const int rh = blockIdx.x & 1;
    __syncthreads();
    for (int idx = tid; idx < 20480; idx += 512) {
        const int r = idx >> 10, k = idx & 1023, gr = rh * 20 + r;
        const float c = gr < 8 ? p->c_prompt[gr * 1024 + k] : p->c_sample[(gr - 8) * 1024 + k];
        sc[k * 20 + r] = siluf_(c);
    }
    __syncthreads();
    for (int pi = blockIdx.x >> 1; pi < 384; pi += gridDim.x >> 1) {
        const int l = pi / 192, cgp = pi % 192;
        const int cn = tid & 31, ks = tid >> 5, n = cgp * 32 + cn;
        float acc[20];
#pragma unroll
        for (int r = 0; r < 20; ++r) acc[r] = 0.f;
        const float* w = p->w_ada + (size_t)l * 1024 * 6144 + n + (size_t)ks * 64 * 6144;
#pragma unroll 1
        for (int kb = 0; kb < 64; kb += 16) {
            float wv[16];
#pragma unroll
            for (int i = 0; i < 16; ++i) wv[i] = w[(size_t)(kb + i) * 6144];
#pragma unroll
            for (int i = 0; i < 16; ++i) {
                const f32x4* s4 = (const f32x4*)(sc + (ks * 64 + kb + i) * 20);
#pragma unroll
                for (int q = 0; q < 5; ++q) { const f32x4 s = s4[q]; acc[4 * q] += s[0] * wv[i]; acc[4 * q + 1] += s[1] * wv[i]; acc[4 * q + 2] += s[2] * wv[i]; acc[4 * q + 3] += s[3] * wv[i]; }
            }
        }
#pragma unroll
        for (int r = 0; r < 20; ++r) red[(ks * 20 + r) * 32 + cn] = acc[r];
        __syncthreads();
        for (int idx = tid; idx < 640; idx += 512) {
            const int r = idx >> 5, c2 = idx & 31, n2 = cgp * 32 + c2;
            float s = 0.f;
#pragma unroll
            for (int k16 = 0; k16 < 16; ++k16) s += red[(k16 * 20 + r) * 32 + c2];
            MOD[((size_t)l * 40 + rh * 20 + r) * 6144 + n2] = s + p->b_ada[l * 6144 + n2];
        }
        __syncthreads();
    }
}

struct CvtTile { const float* src; bf16_t* dst; int K, Ns, mode, n0, k0; };
__device__ __forceinline__ CvtTile cvt_tile(KP p, int l, int it) {
    bf16_t* WT = (bf16_t*)(p->ws + W_WT);
    CvtTile c; int nT; int r = it; c.mode = 0;
    if (r < 1920) { c.src = p->w_in + (size_t)l * 1024 * 7440; c.K = 1024; c.Ns = 7440; nT = 120; c.dst = WT + WT_IN; c.mode = 1; }
    else if ((r -= 1920) < 128) { c.src = p->w_attn_o + (size_t)l * 512 * 1024; c.K = 512; c.Ns = 1024; nT = 16; c.dst = WT + WT_AO; }
    else if ((r -= 128) < 256) { c.src = p->w_ssm_o + (size_t)l * 1024 * 1024; c.K = 1024; c.Ns = 1024; nT = 16; c.dst = WT + WT_SO; c.mode = 2; }
    else if ((r -= 256) < 128) { c.src = p->w_gm_o + (size_t)l * 512 * 1024; c.K = 512; c.Ns = 1024; nT = 16; c.dst = WT + WT_GO; }
    else if ((r -= 128) < 256) { c.src = p->w_out + (size_t)l * 1024 * 1024; c.K = 1024; c.Ns = 1024; nT = 16; c.dst = WT + WT_OUT; }
    else if ((r -= 256) < 1024) { c.src = p->w_ff1 + (size_t)l * 1024 * 4096; c.K = 1024; c.Ns = 4096; nT = 64; c.dst = WT + WT_F1; }
    else { r -= 1024; c.src = p->w_ff2 + (size_t)l * 4096 * 1024; c.K = 4096; c.Ns = 1024; nT = 16; c.dst = WT + WT_F2; }
    c.n0 = (r % nT) * 64; c.k0 = (r / nT) * 64;
    return c;
}
__device__ __forceinline__ void convert_weights(KP p, int l, float* tiles) {
    const int tid = tid_();
    for (int it = blockIdx.x * 2; it < 4736; it += gridDim.x * 2) {
        CvtTile c[2] = {cvt_tile(p, l, it), cvt_tile(p, l, it + 1 < 4736 ? it + 1 : it)};
        __syncthreads();
        float v[2][8];
#pragma unroll
        for (int h = 0; h < 2; ++h) {
            const int nn = tid & 63, ns = c[h].n0 + nn; int sc_ = ns; bool zero = false;
            if (c[h].mode == 1) { if (ns < 3328) sc_ = ns; else if (ns < 7424) sc_ = ns + 16; else if (ns < 7440) sc_ = ns - 7424 + 3328; else { zero = true; sc_ = 0; } }
#pragma unroll
            for (int i = 0; i < 8; ++i) {
                const int kk = (tid >> 6) + 8 * i;
                v[h][i] = zero ? 0.f : c[h].src[(size_t)(c[h].k0 + kk) * c[h].Ns + sc_];
            }
        }
#pragma unroll
        for (int h = 0; h < 2; ++h)
#pragma unroll
            for (int i = 0; i < 8; ++i) {
                const int kk = (tid >> 6) + 8 * i;
                float x = v[h][i];
                if (c[h].mode == 2) x *= p->ssm_norm_w[l * 1024 + c[h].k0 + kk];
                tiles[h * 4224 + kk * 65 + (tid & 63)] = x;
            }
        __syncthreads();
#pragma unroll
        for (int h = 0; h < 2; ++h) {
            if (h == 1 && it + 1 >= 4736) break;
            const float* tile = tiles + h * 4224;
            const int nr = tid >> 3, kc = (tid & 7) * 8;
            u32x4 o;
            o.x = pk2(tile[(kc + 0) * 65 + nr], tile[(kc + 1) * 65 + nr]);
            o.y = pk2(tile[(kc + 2) * 65 + nr], tile[(kc + 3) * 65 + nr]);
            o.z = pk2(tile[(kc + 4) * 65 + nr], tile[(kc + 5) * 65 + nr]);
            o.w = pk2(tile[(kc + 6) * 65 + nr], tile[(kc + 7) * 65 + nr]);
            *(u32x4*)(c[h].dst + (size_t)(c[h].n0 + nr) * c[h].K + c[h].k0 + kc) = o;
        }
    }
    __syncthreads();
}

__device__ __forceinline__ void phase_norm(KP p, int l, const float* srcP, const float* srcS, const float* gvec, int shift_idx) {
    const int tid = tid_(), lane = tid & 63, gw = blockIdx.x * 8 + (tid >> 6), ngw = gridDim.x * 8;
    const float* MOD = (const float*)(p->ws + W_MOD);
    bf16_t* H = (bf16_t*)(p->ws + W_H);
    f32x4 g[4];
#pragma unroll
    for (int j = 0; j < 4; ++j) g[j] = ((const f32x4*)gvec)[lane + 64 * j];
    f32x4 nx[4];
    {
        const int row = gw < T ? gw : T - 1;
        const float* xr = row < TP ? srcP + (size_t)row * 1024 : srcS + (size_t)(row - TP) * 1024;
#pragma unroll
        for (int j = 0; j < 4; ++j) nx[j] = ((const f32x4*)xr)[lane + 64 * j];
    }
    for (int row = gw; row < T; row += ngw) {
        f32x4 v[4];
#pragma unroll
        for (int j = 0; j < 4; ++j) v[j] = nx[j];
        {
            const int rn = row + ngw < T ? row + ngw : row;
            const float* xr = rn < TP ? srcP + (size_t)rn * 1024 : srcS + (size_t)(rn - TP) * 1024;
#pragma unroll
            for (int j = 0; j < 4; ++j) nx[j] = ((const f32x4*)xr)[lane + 64 * j];
        }
        const float* md = MOD + ((size_t)l * 40 + mod_row(row)) * 6144 + shift_idx * 1024;
        f32x4 sh[4], sc[4];
#pragma unroll
        for (int j = 0; j < 4; ++j) { sh[j] = ((const f32x4*)md)[lane + 64 * j]; sc[j] = ((const f32x4*)(md + 1024))[lane + 64 * j]; }
        float ss = 0.f;
#pragma unroll
        for (int j = 0; j < 4; ++j) ss += v[j][0] * v[j][0] + v[j][1] * v[j][1] + v[j][2] * v[j][2] + v[j][3] * v[j][3];
        ss = wave_sum(ss);
        const float rstd = rsqrtf(ss * (1.f / 1024.f) + EPSF);
#pragma unroll
        for (int j = 0; j < 4; ++j) {
            f32x4 h;
#pragma unroll
            for (int e = 0; e < 4; ++e) h[e] = (v[j][e] * rstd * g[j][e]) * (1.f + sc[j][e]) + sh[j][e];
            u32x2 pk; pk.x = pk2(h[0], h[1]); pk.y = pk2(h[2], h[3]);
            *(u32x2*)(H + (size_t)row * 1024 + (lane + 64 * j) * 4) = pk;
        }
    }
}

template <int NMT>
__device__ __forceinline__ void attn_load_q(const bf16_t* qo, int lane, bf16x8 (&qf)[NMT][2]) {
    const int fr = lane & 15, fq = lane >> 4;
#pragma unroll
    for (int mt = 0; mt < NMT; ++mt)
#pragma unroll
        for (int ks = 0; ks < 2; ++ks) qf[mt][ks] = *(const bf16x8*)(qo + (size_t)(mt * 16 + fr) * 512 + ks * 32 + fq * 8);
}
template <int NMT>
__device__ __forceinline__ void attn_compute(const bf16_t* Ks, const bf16_t* VT, bf16_t* qo, const bf16x8 (&qf)[NMT][2], int kt0, int kt1, int nkeys, float sink, int lane) {
    const int fr = lane & 15, fq = lane >> 4;
    f32x4 s[12][NMT];
#pragma unroll
    for (int kp = 0; kp < 6; ++kp) {
#pragma unroll
        for (int h2 = 0; h2 < 2; ++h2)
#pragma unroll
            for (int mt = 0; mt < NMT; ++mt) s[2 * kp + h2][mt] = (f32x4){0.f, 0.f, 0.f, 0.f};
        if (2 * kp >= kt0 && 2 * kp < kt1) {
            bf16x8 kf[2][2];
#pragma unroll
            for (int h2 = 0; h2 < 2; ++h2)
#pragma unroll
                for (int ks = 0; ks < 2; ++ks) kf[h2][ks] = *(const bf16x8*)(Ks + ((2 * kp + h2) * 16 + fr) * 72 + ks * 32 + fq * 8);
#pragma unroll
            for (int h2 = 0; h2 < 2; ++h2)
#pragma unroll
                for (int ks = 0; ks < 2; ++ks)
#pragma unroll
                    for (int mt = 0; mt < NMT; ++mt) s[2 * kp + h2][mt] = mfma16(kf[h2][ks], qf[mt][ks], s[2 * kp + h2][mt]);
        }
    }
    float inv[NMT];
#pragma unroll
    for (int mt = 0; mt < NMT; ++mt) {
        float mx = -INFINITY;
#pragma unroll
        for (int kt = 0; kt < 12; ++kt)
            if (kt >= kt0 && kt < kt1) {
#pragma unroll
                for (int j = 0; j < 4; ++j) { const int key = kt * 16 + fq * 4 + j; const float v = key < nkeys ? s[kt][mt][j] * 0.125f : -INFINITY; s[kt][mt][j] = v; mx = fmaxf(mx, v); }
            }
        mx = fmaxf(mx, __shfl_xor(mx, 16)); mx = fmaxf(mx, __shfl_xor(mx, 32)); mx = fmaxf(mx, sink);
        float sum = 0.f;
#pragma unroll
        for (int kt = 0; kt < 12; ++kt)
            if (kt >= kt0 && kt < kt1) {
#pragma unroll
                for (int j = 0; j < 4; ++j) { const float e = __expf(s[kt][mt][j] - mx); s[kt][mt][j] = e; sum += e; }
            }
        sum += __shfl_xor(sum, 16); sum += __shfl_xor(sum, 32);
        inv[mt] = 1.f / (sum + __expf(sink - mx));
    }
    f32x4 o[4][NMT];
#pragma unroll
    for (int dt = 0; dt < 4; ++dt)
#pragma unroll
        for (int mt = 0; mt < NMT; ++mt) o[dt][mt] = (f32x4){0.f, 0.f, 0.f, 0.f};
#pragma unroll
    for (int kb = 0; kb < 6; ++kb) {
        if (2 * kb >= kt0 && 2 * kb < kt1) {
            bf16x8 pf[NMT];
#pragma unroll
            for (int mt = 0; mt < NMT; ++mt) {
                const f32x4 a = s[2 * kb][mt], b = s[2 * kb + 1][mt];
                u32x4 t; t.x = pk2(a[0], a[1]); t.y = pk2(a[2], a[3]); t.z = pk2(b[0], b[1]); t.w = pk2(b[2], b[3]);
                pf[mt] = __builtin_bit_cast(bf16x8, t);
            }
            bf16x8 vf[4];
#pragma unroll
            for (int dt = 0; dt < 4; ++dt) {
                const u32x2 lo = *(const u32x2*)(VT + (dt * 16 + fr) * 200 + kb * 32 + fq * 4);
                const u32x2 hi = *(const u32x2*)(VT + (dt * 16 + fr) * 200 + kb * 32 + 16 + fq * 4);
                u32x4 t; t.x = lo.x; t.y = lo.y; t.z = hi.x; t.w = hi.y;
                vf[dt] = __builtin_bit_cast(bf16x8, t);
            }
#pragma unroll
            for (int dt = 0; dt < 4; ++dt)
#pragma unroll
                for (int mt = 0; mt < NMT; ++mt) o[dt][mt] = mfma16(vf[dt], pf[mt], o[dt][mt]);
        }
    }
#pragma unroll
    for (int mt = 0; mt < NMT; ++mt)
#pragma unroll
        for (int dt = 0; dt < 4; ++dt) {
            const f32x4 v = o[dt][mt] * inv[mt];
            u32x2 pk; pk.x = pk2(v[0], v[1]); pk.y = pk2(v[2], v[3]);
            *(u32x2*)(qo + (size_t)(mt * 16 + fr) * 512 + dt * 16 + fq * 4) = pk;
        }
}

__device__ __forceinline__ void scatter_vt(bf16_t* VT, int ch, int kk, u32x4 vv) {
    bf16_t* d = VT + (ch * 8) * 200 + kk;
    d[0 * 200] = (bf16_t)(vv.x & 0xffffu); d[1 * 200] = (bf16_t)(vv.x >> 16);
    d[2 * 200] = (bf16_t)(vv.y & 0xffffu); d[3 * 200] = (bf16_t)(vv.y >> 16);
    d[4 * 200] = (bf16_t)(vv.z & 0xffffu); d[5 * 200] = (bf16_t)(vv.z >> 16);
    d[6 * 200] = (bf16_t)(vv.w & 0xffffu); d[7 * 200] = (bf16_t)(vv.w >> 16);
}

__device__ __forceinline__ void attn_prompt_item(KP p, int l, int it, unsigned char* shm) {
    const int tid = tid_(), w = tid >> 6, lane = tid & 63;
    const int b = it >> 6, c = (it >> 1) & 31, kvh = it & 1;
    bf16_t* Ks = (bf16_t*)shm; bf16_t* VT = Ks + 192 * 72;
    bf16_t* Qb = (bf16_t*)(p->ws + W_Q); const bf16_t* Kb = (const bf16_t*)(p->ws + W_K); const bf16_t* Vb = (const bf16_t*)(p->ws + W_V);
    const int kt0 = c >= 2 ? 0 : (2 - c) * 4;
    const int g = w >> 1, q0 = (w & 1) * 32, hq = kvh * 4 + g;
    bf16_t* qo = Qb + ((size_t)b * 2048 + c * 64 + q0) * 512 + hq * 64;
    const float sink = p->sinks[l * 8 + hq];
    __syncthreads();
    {
        u32x4 kv[3], vv[3];
        bf16x8 qf[2][2];
#pragma unroll
        for (int it3 = 0; it3 < 3; ++it3) {
            const int idx = tid + it3 * 512, ch = idx / 192, kk = idx - ch * 192;
            const int kkc = kk >= kt0 * 16 ? kk : kt0 * 16;
            const size_t row = (size_t)b * 2048 + (c - 2) * 64 + kkc;
            kv[it3] = *(const u32x4*)(Kb + row * 128 + kvh * 64 + ch * 8);
            vv[it3] = *(const u32x4*)(Vb + row * 128 + kvh * 64 + ch * 8);
        }
        attn_load_q<2>(qo, lane, qf);
#pragma unroll
        for (int it3 = 0; it3 < 3; ++it3) {
            const int idx = tid + it3 * 512, ch = idx / 192, kk = idx - ch * 192;
            if (kk >= kt0 * 16) { *(u32x4*)(Ks + kk * 72 + ch * 8) = kv[it3]; scatter_vt(VT, ch, kk, vv[it3]); }
        }
        __syncthreads();
        attn_compute<2>(Ks, VT, qo, qf, kt0, 12, 192, sink, lane);
    }
}

__device__ __forceinline__ void attn_sample_item(KP p, int l, int it, unsigned char* shm) {
    const int tid = tid_(), w = tid >> 6, lane = tid & 63;
    const int sb = it >> 1, kvh = it & 1;
    bf16_t* Ks = (bf16_t*)shm; bf16_t* VT = Ks + 192 * 72;
    bf16_t* Qb = (bf16_t*)(p->ws + W_Q); const bf16_t* Kb = (const bf16_t*)(p->ws + W_K); const bf16_t* Vb = (const bf16_t*)(p->ws + W_V);
    __syncthreads();
    for (int idx = tid; idx < 160 * 8; idx += 512) {
        const int ch = idx / 160, kk = idx - ch * 160;
        u32x4 kv, vv;
        if (kk < 128) {
            const size_t o = ((((size_t)l * 32 + sb) * 128 + kk) * 2 + kvh) * 64 + ch * 8;
            const f32x4 k0 = *(const f32x4*)(p->cache_k + o), k1 = *(const f32x4*)(p->cache_k + o + 4);
            const f32x4 v0 = *(const f32x4*)(p->cache_v + o), v1 = *(const f32x4*)(p->cache_v + o + 4);
            kv.x = pk2(k0[0], k0[1]); kv.y = pk2(k0[2], k0[3]); kv.z = pk2(k1[0], k1[1]); kv.w = pk2(k1[2], k1[3]);
            vv.x = pk2(v0[0], v0[1]); vv.y = pk2(v0[2], v0[3]); vv.z = pk2(v1[0], v1[1]); vv.w = pk2(v1[2], v1[3]);
        } else if (kk < 144) {
            const size_t row = (size_t)TP + sb * 16 + (kk - 128);
            kv = *(const u32x4*)(Kb + row * 128 + kvh * 64 + ch * 8);
            vv = *(const u32x4*)(Vb + row * 128 + kvh * 64 + ch * 8);
        } else { kv = zero4(); vv = kv; }
        *(u32x4*)(Ks + kk * 72 + ch * 8) = kv;
        scatter_vt(VT, ch, kk, vv);
    }
    __syncthreads();
    if (w < 4) {
        const int hq = kvh * 4 + w;
        bf16_t* qo = Qb + ((size_t)TP + sb * 16) * 512 + hq * 64;
        bf16x8 qf[1][2];
        attn_load_q<1>(qo, lane, qf);
        attn_compute<1>(Ks, VT, qo, qf, 0, 10, 144, p->sinks[l * 8 + hq], lane);
    }
}

__device__ __forceinline__ void gmlp_item(KP p, int l, bool samp, int bi, int cidx, int g, unsigned char* shm) {
    const int tid = tid_(), w = tid >> 6, lane = tid & 63, fr = lane & 15, fq = lane >> 4;
    bf16_t* Wm = (bf16_t*)shm; bf16_t* VT = Wm + 128 * 136;
    const int L = samp ? 16 : 128;
    const int row0 = samp ? TP + bi * 16 : bi * 2048 + cidx * 128;
    bf16_t* GUb = (bf16_t*)(p->ws + W_GU); const bf16_t* GVb = (const bf16_t*)(p->ws + W_GV);
    __syncthreads();
    if (samp) {
        { const int idx = tid * 8, d = idx >> 5, s = idx & 31; *(u32x4*)(VT + d * 136 + s) = zero4(); }
        if (tid < 128) {
            const int t = tid >> 3, s4 = (tid & 7) * 4;
            f32x4 wv = (f32x4){0.f, 0.f, 0.f, 0.f};
            if (s4 < 16) wv = *(const f32x4*)(p->gm_w_s + ((size_t)(l * 4 + g) * 128 + t) * 128 + s4);
#pragma unroll
            for (int e = 0; e < 4; ++e) if (s4 + e > t) wv[e] = 0.f;
            u32x2 pk; pk.x = pk2(wv[0], wv[1]); pk.y = pk2(wv[2], wv[3]);
            *(u32x2*)(Wm + t * 136 + s4) = pk;
        }
        __syncthreads();
    }
    if (!samp) {
        const int r = tid >> 2, q = tid & 3;
        const bf16_t* src = GVb + (size_t)(row0 + r) * 512 + q * 128;
        u32x4 rv[16];
#pragma unroll
        for (int k = 0; k < 16; ++k) rv[k] = *(const u32x4*)(src + k * 8);
        float s = 0.f, s2 = 0.f;
#pragma unroll
        for (int k = 0; k < 16; ++k) {
            const float a0 = bflo(rv[k].x), a1 = bfhi(rv[k].x), a2 = bflo(rv[k].y), a3 = bfhi(rv[k].y), a4 = bflo(rv[k].z), a5 = bfhi(rv[k].z), a6 = bflo(rv[k].w), a7 = bfhi(rv[k].w);
            s += ((a0 + a1) + (a2 + a3)) + ((a4 + a5) + (a6 + a7));
            s2 += ((a0 * a0 + a1 * a1) + (a2 * a2 + a3 * a3)) + ((a4 * a4 + a5 * a5) + (a6 * a6 + a7 * a7));
        }
        s += __shfl_xor(s, 1); s += __shfl_xor(s, 2); s2 += __shfl_xor(s2, 1); s2 += __shfl_xor(s2, 2);
        float* lgs = (float*)(VT + 128 * 136);
        if (q == 0) {
            const float mean = s * (1.f / 512.f);
            lgs[256 + 2 * r] = mean; lgs[257 + 2 * r] = rsqrtf(fmaxf(s2 * (1.f / 512.f) - mean * mean, 0.f) + EPSF);
        }
        if (tid < 128) lgs[tid] = p->gm_ln_g[l * 512 + g * 128 + tid]; else if (tid < 256) lgs[tid] = p->gm_ln_b[l * 512 + g * 128 + tid - 128];
        const int r2 = tid & 127, dq = tid >> 7;
        u32x4 xv[4];
#pragma unroll
        for (int k = 0; k < 4; ++k) xv[k] = *(const u32x4*)(GVb + (size_t)(row0 + r2) * 512 + g * 128 + dq * 32 + k * 8);
        __syncthreads();
        {
            const float mean = lgs[256 + 2 * r2], rstd = lgs[257 + 2 * r2];
#pragma unroll
            for (int k = 0; k < 4; ++k) {
                const unsigned uu[4] = {xv[k].x, xv[k].y, xv[k].z, xv[k].w};
                const f32x4 g0 = *(const f32x4*)(lgs + dq * 32 + k * 8), g1 = *(const f32x4*)(lgs + dq * 32 + k * 8 + 4);
                const f32x4 b0 = *(const f32x4*)(lgs + 128 + dq * 32 + k * 8), b1 = *(const f32x4*)(lgs + 128 + dq * 32 + k * 8 + 4);
#pragma unroll
                for (int e = 0; e < 8; ++e) {
                    const float v = (e & 1) ? bfhi(uu[e >> 1]) : bflo(uu[e >> 1]);
                    const float gg = e < 4 ? g0[e & 3] : g1[e & 3], bb = e < 4 ? b0[e & 3] : b1[e & 3];
                    VT[(dq * 32 + k * 8 + e) * 136 + r2] = f2bf((v - mean) * rstd * gg + bb);
                }
            }
        }
        {
            f32x4 wv[8];
#pragma unroll
            for (int q = 0; q < 8; ++q) { const int idx = tid + q * 512; wv[q] = *(const f32x4*)(p->gm_w_s + ((size_t)(l * 4 + g) * 128 + (idx >> 5)) * 128 + (idx & 31) * 4); }
#pragma unroll
            for (int q = 0; q < 8; ++q) {
                const int idx = tid + q * 512, t = idx >> 5, s4 = (idx & 31) * 4;
#pragma unroll
                for (int e = 0; e < 4; ++e) if (s4 + e > t) wv[q][e] = 0.f;
                u32x2 pk; pk.x = pk2(wv[q][0], wv[q][1]); pk.y = pk2(wv[q][2], wv[q][3]);
                *(u32x2*)(Wm + t * 136 + s4) = pk;
            }
        }
    } else if (w == 0) {
        u32x4 rawv[16];
#pragma unroll
        for (int r = 0; r < 16; ++r) rawv[r] = *(const u32x4*)(GVb + (size_t)(row0 + r) * 512 + lane * 8);
#pragma unroll
        for (int r = 0; r < 16; ++r) {
            const u32x4 raw = rawv[r];
            float v[8];
            v[0] = bflo(raw.x); v[1] = bfhi(raw.x); v[2] = bflo(raw.y); v[3] = bfhi(raw.y); v[4] = bflo(raw.z); v[5] = bfhi(raw.z); v[6] = bflo(raw.w); v[7] = bfhi(raw.w);
            float s = 0.f;
#pragma unroll
            for (int e = 0; e < 8; ++e) s += v[e];
            const float mean = wave_sum(s) * (1.f / 512.f);
            float s2 = 0.f;
#pragma unroll
            for (int e = 0; e < 8; ++e) { v[e] -= mean; s2 += v[e] * v[e]; }
            const float rstd = rsqrtf(wave_sum(s2) * (1.f / 512.f) + EPSF);
            if (fq == g) {
#pragma unroll
                for (int e = 0; e < 8; ++e) {
                    const int d = fr * 8 + e, col = g * 128 + d;
                    const float vn = v[e] * rstd * p->gm_ln_g[l * 512 + col] + p->gm_ln_b[l * 512 + col];
                    VT[d * 136 + r] = f2bf(vn);
                    p->out[O_GS + ((size_t)(l * 32 + bi) * 16 + r) * 512 + col] = vn;
                }
            }
        }
    }
    bf16_t uv[4][8];
    if (w * 16 < L) {
#pragma unroll
        for (int j = 0; j < 4; ++j)
#pragma unroll
            for (int dt = 0; dt < 8; ++dt) uv[j][dt] = GUb[(size_t)(row0 + w * 16 + fq * 4 + j) * 512 + g * 128 + dt * 16 + fr];
    }
    __syncthreads();
    if (w * 16 < L) {
        f32x4 acc[8];
#pragma unroll
        for (int dt = 0; dt < 8; ++dt) acc[dt] = (f32x4){0.f, 0.f, 0.f, 0.f};
        const int nks = samp ? 1 : ((w * 16 + 15) >> 5) + 1;
#pragma unroll
        for (int ks = 0; ks < 4; ++ks) {
            if (ks < nks) {
                const bf16x8 wf = *(const bf16x8*)(Wm + (w * 16 + fr) * 136 + ks * 32 + fq * 8);
                bf16x8 vf[8];
#pragma unroll
                for (int dt = 0; dt < 8; ++dt) vf[dt] = *(const bf16x8*)(VT + (dt * 16 + fr) * 136 + ks * 32 + fq * 8);
#pragma unroll
                for (int dt = 0; dt < 8; ++dt) acc[dt] = mfma16(wf, vf[dt], acc[dt]);
            }
        }
#pragma unroll
        for (int j = 0; j < 4; ++j) {
            const int t = w * 16 + fq * 4 + j;
            const float bias = p->gm_b_s[(l * 4 + g) * 128 + t];
#pragma unroll
            for (int dt = 0; dt < 8; ++dt) {
                const size_t idx = (size_t)(row0 + t) * 512 + g * 128 + dt * 16 + fr;
                GUb[idx] = f2bf(bf2f(uv[j][dt]) * (acc[dt][j] + bias));
            }
        }
    }
}

constexpr size_t XT_SAMP = (size_t)256 * 1024 * 64, BT_SAMP = (size_t)256 * 256 * 64;
__device__ __forceinline__ void conv_prepass(KP p, int l, unsigned char* shm) {
    const int tid = tid_();
    bf16_t* R = (bf16_t*)shm;
    bf16_t* An = R + 67 * 264;
    bf16_t* At = An + 64 * 264;
    unsigned char* ws = p->ws;
    const bf16_t* Xb = (const bf16_t*)(ws + W_XBC);
    bf16_t* XT = (bf16_t*)(ws + W_H); bf16_t* BCN = (bf16_t*)(ws + W_BCN); bf16_t* BTg = (bf16_t*)(ws + W_BT);
    for (int it = blockIdx.x; it < 288 * 6; it += gridDim.x) {
        const int cidx = it / 6, slab = it - cidx * 6;
        const bool samp = cidx >= 256; const int sb = cidx - 256;
        const int row0 = samp ? TP + sb * 16 : cidx * 64, Lv = samp ? 16 : 64, c0 = slab * 256;
        __syncthreads();
        {
            u32x4 v[5];
#pragma unroll
            for (int q = 0; q < 5; ++q) {
                const int idx = tid + q * 512, r = idx >> 5, ck = idx & 31, rr = r - 3;
                v[q] = zero4();
                if (idx < (Lv + 3) * 32) {
                    if (rr >= 0 || (!samp && (cidx & 31) > 0)) v[q] = *(const u32x4*)(Xb + (size_t)(row0 + rr) * 1536 + c0 + ck * 8);
                    else if (samp) {
                        const float* sp = p->state_conv + (((size_t)l * 32 + sb) * 3 + (3 + rr)) * 1536 + c0 + ck * 8;
                        const f32x4 a = *(const f32x4*)sp, b = *(const f32x4*)(sp + 4);
                        v[q].x = pk2(a[0], a[1]); v[q].y = pk2(a[2], a[3]); v[q].z = pk2(b[0], b[1]); v[q].w = pk2(b[2], b[3]);
                    }
                }
            }
#pragma unroll
            for (int q = 0; q < 5; ++q) {
                const int idx = tid + q * 512;
                if (idx < (Lv + 3) * 32) *(u32x4*)(R + (idx >> 5) * 264 + (idx & 31) * 8) = v[q];
            }
        }
        __syncthreads();
        {
            const int j = tid & 255, tq = tid >> 8;
            if (tq * 32 < Lv) {
                const float w0 = p->conv_w[(l * 4 + 0) * 1536 + c0 + j], w1 = p->conv_w[(l * 4 + 1) * 1536 + c0 + j];
                const float w2 = p->conv_w[(l * 4 + 2) * 1536 + c0 + j], w3 = p->conv_w[(l * 4 + 3) * 1536 + c0 + j], cb = p->conv_b[l * 1536 + c0 + j];
                float x0 = bf2f(R[(tq * 32 + 0) * 264 + j]), x1 = bf2f(R[(tq * 32 + 1) * 264 + j]), x2 = bf2f(R[(tq * 32 + 2) * 264 + j]);
#pragma unroll
                for (int e = 0; e < 32; e += 2) {
                    const int t = tq * 32 + e;
                    if (t < Lv) {
                        const float x3 = bf2f(R[(t + 3) * 264 + j]), x4 = bf2f(R[(t + 4) * 264 + j]);
                        const float o0 = siluf_(cb + w0 * x0 + w1 * x1 + w2 * x2 + w3 * x3);
                        const float o1 = siluf_(cb + w0 * x1 + w1 * x2 + w2 * x3 + w3 * x4);
                        x0 = x2; x1 = x3; x2 = x4;
                        const unsigned pk = pk2(o0, o1);
                        An[t * 264 + j] = (bf16_t)(pk & 0xffffu); An[(t + 1) * 264 + j] = (bf16_t)(pk >> 16);
                        *(unsigned*)(At + j * 66 + t) = pk;
                    }
                }
            }
        }
        __syncthreads();
        if (slab >= 4) {
            for (int idx = tid; idx < Lv * 32; idx += 512) {
                const int t = idx >> 5, ck = idx & 31;
                *(u32x4*)(BCN + (size_t)(row0 + t) * 512 + (slab - 4) * 256 + ck * 8) = *(const u32x4*)(An + t * 264 + ck * 8);
            }
        }
        if (slab < 5) {
            const int sh = samp ? 1 : 3;
            bf16_t* dst;
            if (slab < 4) dst = samp ? XT + XT_SAMP + ((size_t)sb * 1024 + slab * 256) * 16 : XT + ((size_t)cidx * 1024 + slab * 256) * 64;
            else dst = samp ? BTg + BT_SAMP + (size_t)sb * 256 * 16 : BTg + (size_t)cidx * 256 * 64;
            for (int idx = tid; idx < (256 << sh); idx += 512) {
                const int j = idx >> sh, tc = idx & ((1 << sh) - 1);
                const unsigned* src = (const unsigned*)(At + j * 66 + tc * 8);
                u32x4 v; v.x = src[0]; v.y = src[1]; v.z = src[2]; v.w = src[3];
                *(u32x4*)(dst + (size_t)j * Lv + tc * 8) = v;
            }
        }
    }
    __syncthreads();
}

__device__ __forceinline__ void ssd_item(KP p, int l, bool samp, int bi, int h, unsigned char* shm) {
    const int tid = tid_(), w = tid >> 6, lane = tid & 63, fr = lane & 15, fq = lane >> 4;
    bf16_t* xT = (bf16_t*)shm;
    bf16_t* xwT = xT + 64 * 72;
    bf16_t* Bs = xwT + 64 * 72;
    bf16_t* BT = Bs + 64 * 136;
    bf16_t* Cs = BT + 128 * 72;
    bf16_t* Ms = Cs + 64 * 136;
    bf16_t* hb = Ms + 64 * 72;
    float* cumv = (float*)(hb + 64 * 136);
    float* dtv = cumv + 64;
    float* scl = dtv + 64;
    const int gr = h >> 3, nch = samp ? 1 : 32, Lv = samp ? 16 : 64;
    const int rowbase = samp ? TP + bi * 16 : bi * 2048;
    const float a_h = -__expf(p->a_log[l * 16 + h]), Dh = p->d_skip[l * 16 + h];
    unsigned char* ws = p->ws;
    const float* DT = (const float*)(ws + W_DT);
    const bf16_t* XTg = (const bf16_t*)(ws + W_H); const bf16_t* BCN = (const bf16_t*)(ws + W_BCN); const bf16_t* BTg = (const bf16_t*)(ws + W_BT);
    bf16_t* Zb = (bf16_t*)(ws + W_Z);
    float* ROWSS = (float*)(ws + W_ROWSS);
    const int pts = w >> 1, nt0 = (w & 1) * 4;
    f32x4 hacc[4];
    float* stout = samp ? p->out + O_SS + (((size_t)l * 32 + bi) * 16 + h) * 8192 : p->out + O_SP + (((size_t)l * 8 + bi) * 16 + h) * 8192;
    __syncthreads();
#pragma unroll
    for (int i = 0; i < 4; ++i) {
#pragma unroll
        for (int j = 0; j < 4; ++j) {
            const int pr = pts * 16 + fq * 4 + j, n = (nt0 + i) * 16 + fr;
            float v = 0.f;
            if (samp) v = p->state_ssm[((((size_t)l * 32 + bi) * 16 + h) * 64 + pr) * 128 + n];
            hacc[i][j] = v;
            hb[pr * 136 + n] = f2bf(v);
        }
    }
    const int ttile = w >> 1, half = w & 1;
    const int xp = tid >> 3, xc = tid & 7;

    u32x4 lx, lb[2], lc[2], lbt[2];
    float dcur = 0.f;
    auto load_ops = [&](int chx) {
        const int t0x = rowbase + chx * 64;
        lx = zero4();
        if (!samp) {
            const size_t cidx = (size_t)bi * 32 + chx;
            lx = *(const u32x4*)(XTg + (cidx * 1024 + h * 64 + xp) * 64 + xc * 8);
#pragma unroll
            for (int q = 0; q < 2; ++q) {
                const int idx = tid + q * 512;
                const bf16_t* rowp = BCN + (size_t)(t0x + (idx >> 4)) * 512 + gr * 128 + (idx & 15) * 8;
                lb[q] = *(const u32x4*)rowp; lc[q] = *(const u32x4*)(rowp + 256);
                lbt[q] = *(const u32x4*)(BTg + (cidx * 256 + gr * 128 + (idx >> 3)) * 64 + (idx & 7) * 8);
            }
        } else {
            if (xc < 2) lx = *(const u32x4*)(XTg + XT_SAMP + ((size_t)bi * 1024 + h * 64 + xp) * 16 + xc * 8);
#pragma unroll
            for (int q = 0; q < 2; ++q) {
                const int idx = tid + q * 512;
                lb[q] = zero4(); lc[q] = lb[q]; lbt[q] = lb[q];
                if ((idx >> 4) < 16) {
                    const bf16_t* rowp = BCN + (size_t)(t0x + (idx >> 4)) * 512 + gr * 128 + (idx & 15) * 8;
                    lb[q] = *(const u32x4*)rowp; lc[q] = *(const u32x4*)(rowp + 256);
                }
                if ((idx & 7) < 2) lbt[q] = *(const u32x4*)(BTg + BT_SAMP + ((size_t)bi * 256 + gr * 128 + (idx >> 3)) * 16 + (idx & 7) * 8);
            }
        }
        dcur = 0.f;
        if (w == 0 && lane < Lv) dcur = DT[(size_t)(t0x + lane) * 16 + h];
    };
    load_ops(0);

    for (int ch = 0; ch < nch; ++ch) {
        const int t0 = rowbase + ch * 64;
        bf16_t zr[8];
#pragma unroll
        for (int j = 0; j < 4; ++j)
#pragma unroll
            for (int i = 0; i < 2; ++i) {
                int t = ttile * 16 + fq * 4 + j; t = t < Lv ? t : Lv - 1;
                zr[j * 2 + i] = Zb[(size_t)(t0 + t) * 1024 + h * 64 + (half * 2 + i) * 16 + fr];
            }
        __syncthreads();
        if (w == 0) {
            const float c = wave_scan(dcur * a_h);
            const float c63 = __int_as_float(__builtin_amdgcn_readlane(__float_as_int(c), 63));
            cumv[lane] = c; dtv[lane] = dcur; scl[lane] = dcur * __expf(c63 - c);
        }
        *(u32x4*)(xT + xp * 72 + xc * 8) = lx;
#pragma unroll
        for (int q = 0; q < 2; ++q) {
            const int idx = tid + q * 512;
            *(u32x4*)(Bs + (idx >> 4) * 136 + (idx & 15) * 8) = lb[q];
            *(u32x4*)(Cs + (idx >> 4) * 136 + (idx & 15) * 8) = lc[q];
            *(u32x4*)(BT + (idx >> 3) * 72 + (idx & 7) * 8) = lbt[q];
        }
        __syncthreads();
        {
            const f32x4 s0 = *(const f32x4*)(scl + xc * 8), s1 = *(const f32x4*)(scl + xc * 8 + 4);
            u32x4 o;
            o.x = pk2(bflo(lx.x) * s0[0], bfhi(lx.x) * s0[1]); o.y = pk2(bflo(lx.y) * s0[2], bfhi(lx.y) * s0[3]);
            o.z = pk2(bflo(lx.z) * s1[0], bfhi(lx.z) * s1[1]); o.w = pk2(bflo(lx.w) * s1[2], bfhi(lx.w) * s1[3]);
            *(u32x4*)(xwT + xp * 72 + xc * 8) = o;
        }
        if (ch + 1 < nch) load_ops(ch + 1);
        f32x4 cb[2], yacc[2];
#pragma unroll
        for (int i = 0; i < 2; ++i) { cb[i] = (f32x4){0.f, 0.f, 0.f, 0.f}; yacc[i] = (f32x4){0.f, 0.f, 0.f, 0.f}; }
        {
            bf16x8 cf[4], bfr[4][2], hf[4][2];
#pragma unroll
            for (int ks = 0; ks < 4; ++ks) {
                cf[ks] = *(const bf16x8*)(Cs + (ttile * 16 + fr) * 136 + ks * 32 + fq * 8);
#pragma unroll
                for (int i = 0; i < 2; ++i) {
                    bfr[ks][i] = *(const bf16x8*)(Bs + ((half * 2 + i) * 16 + fr) * 136 + ks * 32 + fq * 8);
                    hf[ks][i] = *(const bf16x8*)(hb + ((half * 2 + i) * 16 + fr) * 136 + ks * 32 + fq * 8);
                }
            }
#pragma unroll
            for (int ks = 0; ks < 4; ++ks)
#pragma unroll
                for (int i = 0; i < 2; ++i) { cb[i] = mfma16(cf[ks], bfr[ks][i], cb[i]); yacc[i] = mfma16(cf[ks], hf[ks][i], yacc[i]); }
        }
#pragma unroll
        for (int j = 0; j < 4; ++j) {
            const int t = ttile * 16 + fq * 4 + j;
            const float ct = cumv[t];
            const float et = __expf(ct);
#pragma unroll
            for (int i = 0; i < 2; ++i) {
                const int s = (half * 2 + i) * 16 + fr;
                const float mv = (s <= t) ? cb[i][j] * __expf(ct - cumv[s]) * dtv[s] : 0.f;
                Ms[t * 72 + s] = f2bf(mv);
                yacc[i][j] *= et;
            }
        }
        __syncthreads();
        bf16x8 mf[2], xf[2][2], xwf[2], btf[2][4];
#pragma unroll
        for (int ks = 0; ks < 2; ++ks) {
            mf[ks] = *(const bf16x8*)(Ms + (ttile * 16 + fr) * 72 + ks * 32 + fq * 8);
#pragma unroll
            for (int i = 0; i < 2; ++i) xf[ks][i] = *(const bf16x8*)(xT + ((half * 2 + i) * 16 + fr) * 72 + ks * 32 + fq * 8);
            xwf[ks] = *(const bf16x8*)(xwT + (pts * 16 + fr) * 72 + ks * 32 + fq * 8);
#pragma unroll
            for (int i = 0; i < 4; ++i) btf[ks][i] = *(const bf16x8*)(BT + ((nt0 + i) * 16 + fr) * 72 + ks * 32 + fq * 8);
        }
#pragma unroll
        for (int ks = 0; ks < 2; ++ks)
#pragma unroll
            for (int i = 0; i < 2; ++i) yacc[i] = mfma16(mf[ks], xf[ks][i], yacc[i]);
        {
            float ssq[4] = {0.f, 0.f, 0.f, 0.f};
#pragma unroll
            for (int j = 0; j < 4; ++j) {
                const int t = ttile * 16 + fq * 4 + j;
                if (!samp || t < Lv) {
#pragma unroll
                    for (int i = 0; i < 2; ++i) {
                        const int pc = (half * 2 + i) * 16 + fr;
                        const float xv = bf2f(xT[pc * 72 + t]);
                        const float y = yacc[i][j] + Dh * xv;
                        const size_t zi = (size_t)(t0 + t) * 1024 + h * 64 + pc;
                        const float uu = y * siluf_(bf2f(zr[j * 2 + i]));
                        Zb[zi] = f2bf(uu);
                        ssq[j] += uu * uu;
                    }
                }
            }
#pragma unroll
            for (int j = 0; j < 4; ++j) {
                const float s = row16_sum(ssq[j]);
                const int t = ttile * 16 + fq * 4 + j;
                if (fr == 0 && (!samp || t < Lv)) ROWSS[(size_t)(t0 + t) * 32 + h * 2 + half] = s;
            }
        }
        const float dec = __expf(cumv[63]);
#pragma unroll
        for (int i = 0; i < 4; ++i) hacc[i] *= dec;
#pragma unroll
        for (int ks = 0; ks < 2; ++ks)
#pragma unroll
            for (int i = 0; i < 4; ++i) hacc[i] = mfma16(xwf[ks], btf[ks][i], hacc[i]);
#pragma unroll
        for (int i = 0; i < 4; ++i)
#pragma unroll
            for (int j = 0; j < 4; ++j) hb[(pts * 16 + fq * 4 + j) * 136 + (nt0 + i) * 16 + fr] = f2bf(hacc[i][j]);
    }
#pragma unroll
    for (int i = 0; i < 4; ++i)
#pragma unroll
        for (int j = 0; j < 4; ++j) stout[(pts * 16 + fq * 4 + j) * 128 + (nt0 + i) * 16 + fr] = hacc[i][j];
}

constexpr int N_OTHER = 512 + 512 + 512 + 64 + 128;
__device__ __forceinline__ void phase_mixers(int l, unsigned char* shm) {
    int* s_item = (int*)(shm + 131072);
    for (int it = blockIdx.x; it < 128; it += gridDim.x) ssd_item(kparams(), l, false, it >> 4, it & 15, shm);
    unsigned nxt_ticket = 0u;
    if (threadIdx.x == 0) nxt_ticket = atomicAdd((unsigned*)(kparams()->ws + W_CNT) + l, 1u);
    for (;;) {
        __syncthreads();
        if (threadIdx.x == 0) *s_item = (int)nxt_ticket;
        __syncthreads();
        int j = *s_item;
        if (j >= N_OTHER) break;
        const KP p = kparams();
        if (threadIdx.x == 0) nxt_ticket = atomicAdd((unsigned*)(p->ws + W_CNT) + l, 1u);
        if (j < 512) { attn_prompt_item(p, l, j, shm); continue; } j -= 512;
        if (j < 512) { gmlp_item(p, l, false, j >> 6, (j >> 2) & 15, j & 3, shm); continue; } j -= 512;
        if (j < 512) { ssd_item(p, l, true, j >> 4, j & 15, shm); continue; } j -= 512;
        if (j < 64) { attn_sample_item(p, l, j, shm); continue; } j -= 64;
        gmlp_item(p, l, true, j >> 2, 0, j & 3, shm);
    }
}

#define XB_TMO      128
#define XB_XCNT(j)  (256  + 64 * (j))
#define XB_XSUB(j)  (1280 + 64 * (j))
#define XB_XGEN(j)  (2304 + 64 * (j))
#define XB_TOP      3328
#define XB_TOPGEN   3392
#define XCD_BAR_WORDS 3456
#define XB_SPIN_CAP (1u << 18)
__device__ __forceinline__ unsigned xb_ld(unsigned* p)              { return __hip_atomic_load(p, __ATOMIC_RELAXED, __HIP_MEMORY_SCOPE_AGENT); }
__device__ __forceinline__ unsigned xb_add(unsigned* p, unsigned v) { return __hip_atomic_fetch_add(p, v, __ATOMIC_RELAXED, __HIP_MEMORY_SCOPE_AGENT); }
__device__ __forceinline__ unsigned xb_xcc_id() { return (unsigned)__builtin_amdgcn_s_getreg((3 << 11) | 20) & 0xFu; }
#define XB_SPIN(cond, bar) do { unsigned _sp = 0; while (cond) { __builtin_amdgcn_s_sleep(1); \
    if ((++_sp & 255u) == 0u) { if (xb_ld(&(bar)[XB_TMO])) break; if (_sp > XB_SPIN_CAP) { atomicAdd(&(bar)[XB_TMO], 1u); break; } } } } while (0)
struct XcdBarrier { unsigned* bar; unsigned x; volatile LAS unsigned* st; };
__device__ __forceinline__ XcdBarrier xcd_barrier_post(unsigned* bar, volatile LAS unsigned* st) {
    XcdBarrier b; b.bar = bar; b.x = xb_xcc_id(); b.st = st;
    if (threadIdx.x == 0) (void)xb_add(&bar[XB_XCNT(b.x)], 1u);
    return b;
}
__device__ __forceinline__ void xcd_barrier_complete(unsigned* bar, unsigned x, unsigned& nloc, unsigned& nx) {
    const unsigned G = gridDim.x * gridDim.y * gridDim.z;
    unsigned sum, cnt, mine, sp = 0u;
    for (;;) {
        sum = 0u; cnt = 0u; mine = 0u;
#pragma unroll
        for (unsigned j = 0; j < 16; ++j) { const unsigned c = xb_ld(&bar[XB_XCNT(j)]); sum += c; cnt += (c > 0u) ? 1u : 0u; mine = (j == x) ? c : mine; }
        if (sum == G) break;
        __builtin_amdgcn_s_sleep(1);
        if ((++sp & 255u) == 0u) { if (xb_ld(&bar[XB_TMO])) break; if (sp > XB_SPIN_CAP) { atomicAdd(&bar[XB_TMO], 1u); break; } }
    }
    nloc = mine > 0u ? mine : 1u; nx = cnt > 0u ? cnt : 1u;
}
__device__ __forceinline__ void xcd_barrier(const XcdBarrier& b) {
    asm volatile("s_waitcnt vmcnt(0)" ::: "memory");
    __syncthreads();
    if (threadIdx.x == 0) {
        unsigned* bar = b.bar;
        __builtin_amdgcn_s_waitcnt(0);
        unsigned nloc = b.st[0], nx = b.st[1];
        if (nloc == 0u) { xcd_barrier_complete(bar, b.x, nloc, nx); b.st[0] = nloc; b.st[1] = nx; }
        const unsigned old = xb_add(&bar[XB_XSUB(b.x)], 1u);
        const unsigned gen = old / nloc;
        if (old + 1u == (gen + 1u) * nloc) {
            __builtin_amdgcn_fence(__ATOMIC_RELEASE, "agent");
            asm volatile("s_waitcnt vmcnt(0)" ::: "memory");
            const unsigned og = xb_add(&bar[XB_TOP], 1u);
            const unsigned tg = og / nx;
            if (og + 1u == (tg + 1u) * nx) xb_add(&bar[XB_TOPGEN], 1u);
            else XB_SPIN(xb_ld(&bar[XB_TOPGEN]) == tg, bar);
            __builtin_amdgcn_fence(__ATOMIC_ACQUIRE, "agent");
            xb_add(&bar[XB_XGEN(b.x)], 1u);
            asm volatile("s_waitcnt vmcnt(0)" ::: "memory");
        } else {
            XB_SPIN(xb_ld(&bar[XB_XGEN(b.x)]) == gen, bar);
            __builtin_amdgcn_fence(__ATOMIC_ACQUIRE, "agent");
            asm volatile("s_waitcnt vmcnt(0)" ::: "memory");
        }
    }
    __syncthreads();
}
__device__ __forceinline__ void grid_seam(unsigned char* shm) {
    XcdBarrier b; b.bar = (unsigned*)(kparams()->ws + W_BAR); b.x = xb_xcc_id(); b.st = (volatile LAS unsigned*)(LAS unsigned char*)(shm + 131072 + 16);
    xcd_barrier(b);
}

__global__ void __launch_bounds__(512, 2) fwd_kernel(Params p_unused) {
    extern __shared__ __attribute__((aligned(16))) unsigned char shm[];
    cg::grid_group grid = cg::this_grid();
    LAS unsigned char* lds = (LAS unsigned char*)shm;
    const int tid = tid_();
#if PROBE_MASK
    unsigned long long probe_acc = 0;
#endif

    {
        if (tid == 0) { volatile LAS unsigned* st = (volatile LAS unsigned*)(LAS unsigned char*)(shm + 131072 + 16); st[0] = 0u; st[1] = 0u; }
        __syncthreads();
        const KP p = kparams();
        (void)xcd_barrier_post((unsigned*)(p->ws + W_BAR), (volatile LAS unsigned*)(LAS unsigned char*)(shm + 131072 + 16));
        if (p->ws == nullptr) grid.sync();
    }
    PH_BEGIN(0);
    phase_mod(kparams(), (float*)shm);
    {
        const KP p = kparams();
        unsigned char* ws = p->ws;
        f32x2* rope = (f32x2*)(ws + W_ROPE);
        for (int idx = blockIdx.x * 512 + tid_(); idx < 2064 * 8; idx += gridDim.x * 512) {
            const int pi = idx >> 3, j = idx & 7;
            const float pos = (float)(pi < 2048 ? pi : 4096 + (pi - 2048));
            const float invf = exp2f(-(float)j * 0.125f * 18.931568569324174f);
            const float ang = pos * invf;
            const double a = (double)ang;
            const double kk = rint(a * 0.15915494309189535);
            const float r = (float)(a - kk * 6.283185307179586);
            rope[idx] = (f32x2){__cosf(r), __sinf(r)};
        }
        if (blockIdx.x == 0 && tid < 64) ((unsigned*)(ws + W_CNT))[tid] = 0u;
    }
    convert_weights(kparams(), 0, (float*)shm);
    grid_seam(shm);
    PH_END(0);

#pragma unroll 1
    for (int l = 0; l < 2; ++l) {
        PH_BEGIN(1);
        {
            const KP p = kparams();
            float* X = p->out + O_Y;
            phase_norm(p, l, l == 0 ? p->x_prompt : X, l == 0 ? p->x_sample : X + (size_t)TP * 1024, p->g_mix + l * 1024, 0);
        }
        if (l == 1) {
            convert_weights(kparams(), 1, (float*)shm);
        }
        grid_seam(shm);
        PH_END(1);
        PH_BEGIN(2);
        {
            const KP p = kparams();
            const bf16_t* H = (const bf16_t*)(p->ws + W_H); const bf16_t* WT = (const bf16_t*)(p->ws + W_WT);
            pg8::StaticOrder S; S.init(T, NINP, (int)gridDim.x, (int)blockIdx.x);
            EpiIn E; E.l = l; E.pp = p;
            pg8::gemm_phase(lds, pg8::Gemm{H, WT + WT_IN, T, NINP, 1024}, S, E);
        }
        grid_seam(shm);
        PH_END(2);
        PH_BEGIN(3);
        conv_prepass(kparams(), l, shm);
        grid_seam(shm);
        phase_mixers(l, shm);
        grid_seam(shm);
        PH_END(3);
        PH_BEGIN(4);
#pragma unroll 1
        for (int b = 0; b < 3; ++b) {
            const KP p = kparams();
            unsigned char* ws = p->ws;
            const bf16_t* WT = (const bf16_t*)(ws + W_WT);
            const bf16_t* A = (const bf16_t*)(ws + (b == 0 ? W_Q : (b == 1 ? W_Z : W_GU)));
            const bf16_t* Bt = WT + (b == 0 ? WT_AO : (b == 1 ? WT_SO : WT_GO));
            const int K = b == 1 ? 1024 : 512;
            EpiRC<FMergeT<true>, 4> E; E.f.b = b; E.f.G8 = ws + W_G8; E.f.rowss = (const float*)(ws + W_ROWSS); E.f.MG = (bf16_t*)(ws + W_H);
            pg8::StaticOrder S; S.init(TP, 1024, (int)gridDim.x, (int)blockIdx.x);
            E.f.tile_rstd = (const float*)(shm + 131072 + 512); E.f.tile_row0 = 0;
            if (b == 1) {
                pg8::Unit u0;
                if (S.next(0, u0)) {
                    E.f.tile_row0 = u0.pm * 256;
                    const int t2 = tid_();
                    if (t2 < 256) {
                        const f32x4* pp = (const f32x4*)((const float*)(ws + W_ROWSS) + (size_t)(u0.pm * 256 + t2) * 32);
                        const f32x4 t = ((pp[0] + pp[1]) + (pp[2] + pp[3])) + ((pp[4] + pp[5]) + (pp[6] + pp[7]));
                        ((float*)(shm + 131072 + 512))[t2] = rsqrtf(((t[0] + t[1]) + (t[2] + t[3])) * (1.f / 1024.f) + EPSF);
                    }
                }
                __syncthreads();
            }
            pg8::gemm_phase(lds, pg8::Gemm{A, Bt, TP, 1024, K}, S, E);
            FMergeT<false> fs2; fs2.b = b; fs2.G8 = E.f.G8; fs2.rowss = E.f.rowss; fs2.MG = E.f.MG; fs2.tile_rstd = nullptr; fs2.tile_row0 = 0;
            if (K == 512) skinny_gemm<64>(shm, A + (size_t)TP * K, Bt, 1024, fs2); else skinny_gemm<128>(shm, A + (size_t)TP * K, Bt, 1024, fs2);
        }
        grid_seam(shm);
        PH_END(4);
#pragma unroll 1
        for (int s2 = 0; s2 < 2; ++s2) {
            PH_BEGIN(5);
            {
                const KP p = kparams();
                unsigned char* ws = p->ws;
                float* X = p->out + O_Y;
                const bf16_t* WT = (const bf16_t*)(ws + W_WT);
                const bf16_t* A = (const bf16_t*)(ws + (s2 == 0 ? W_H : W_FH));
                const bf16_t* Bt = WT + (s2 == 0 ? WT_OUT : WT_F2);
                const int K = s2 == 0 ? 1024 : 4096;
                const bool first = (l == 0 && s2 == 0);
                FResid fs; fs.srcP = first ? p->x_prompt : X; fs.srcS = first ? p->x_sample : X + (size_t)TP * 1024; fs.X = X;
                fs.modg = (const float*)(ws + W_MOD) + (size_t)l * 40 * 6144 + (s2 == 0 ? 2 : 5) * 1024;
                EpiResidP E; E.src = fs.srcP; E.X = X; E.modg = fs.modg;
                pg8::StaticOrder S; S.init(TP, 1024, (int)gridDim.x, (int)blockIdx.x);
                pg8::gemm_phase(lds, pg8::Gemm{A, Bt, TP, 1024, K}, S, E);
                if (s2 == 0) skinny_gemm<128>(shm, A + (size_t)TP * K, Bt, 1024, fs); else skinny_gemm<512>(shm, A + (size_t)TP * K, Bt, 1024, fs);
            }
            grid_seam(shm);
            PH_END(5);
            if (s2 == 0) {
                PH_BEGIN(6);
                {
                    const KP p = kparams();
                    float* X = p->out + O_Y;
                    phase_norm(p, l, X, X + (size_t)TP * 1024, p->g_ff + l * 1024, 3);
                }
                grid_seam(shm);
                PH_END(6);
                PH_BEGIN(7);
                {
                    const KP p = kparams();
                    unsigned char* ws = p->ws;
                    const bf16_t* H = (const bf16_t*)(ws + W_H); const bf16_t* WT = (const bf16_t*)(ws + W_WT);
                    EpiRC<FRelu2> E; E.f.FH = (bf16_t*)(ws + W_FH);
                    pg8::StaticOrder S; S.init(TP, 4096, (int)gridDim.x, (int)blockIdx.x);
                    pg8::gemm_phase(lds, pg8::Gemm{H, WT + WT_F1, TP, 4096, 1024}, S, E);
                    skinny_gemm<128>(shm, H + (size_t)TP * 1024, WT + WT_F1, 4096, E.f);
                }
                grid_seam(shm);
                PH_END(7);
            }
        }
    }
    {
        const KP p = kparams();
        float* X = p->out + O_Y;
        const float* gf = p->g_final;
        const int tidf = tid_(), lane = tidf & 63, gw = blockIdx.x * 8 + (tidf >> 6), ngw = gridDim.x * 8;
        for (int row = gw; row < T; row += ngw) {
            f32x4* xr = (f32x4*)(X + (size_t)row * 1024);
            f32x4 v[4]; float ss = 0.f;
#pragma unroll
            for (int j = 0; j < 4; ++j) { v[j] = xr[lane + 64 * j]; ss += v[j][0] * v[j][0] + v[j][1] * v[j][1] + v[j][2] * v[j][2] + v[j][3] * v[j][3]; }
            ss = wave_sum(ss);
            const float rstd = rsqrtf(ss * (1.f / 1024.f) + EPSF);
#pragma unroll
            for (int j = 0; j < 4; ++j) { const f32x4 g = ((const f32x4*)gf)[lane + 64 * j]; xr[lane + 64 * j] = v[j] * rstd * g; }
        }
    }
#if PROBE_MASK
    { const unsigned long long t0 = wall_clock64(); while (wall_clock64() - t0 < probe_acc) __builtin_amdgcn_s_sleep(8); }
#endif
}

extern "C" void kernel_launch(void* const* d_in, const int* in_sizes, int n_in, void* d_out, int out_size, void* d_ws, size_t ws_size, hipStream_t stream) {
    static int grid_blocks = 0;
    if (!grid_blocks) {
        int dev = 0, cus = 0, per_cu = 0;
        hipGetDevice(&dev);
        hipDeviceGetAttribute(&cus, hipDeviceAttributeMultiprocessorCount, dev);
        hipFuncSetAttribute((const void*)fwd_kernel, hipFuncAttributeMaxDynamicSharedMemorySize, LDS_BYTES);
        hipOccupancyMaxActiveBlocksPerMultiprocessor(&per_cu, (const void*)fwd_kernel, 512, LDS_BYTES);
        if (per_cu < 1) per_cu = 1;
        grid_blocks = cus * per_cu;
        if (ws_size < W_END) fprintf(stderr, "kernel_launch: workspace too small: need %zu, got %zu\n", (size_t)W_END, ws_size);
    }
    Params p{};
    const float** fp = (const float**)&p;
    for (int i = 0; i < 31; ++i) fp[i] = (const float*)d_in[i];
    p.out = (float*)d_out; p.ws = (unsigned char*)d_ws;
    (void)hipMemsetAsync((unsigned char*)d_ws + W_BAR, 0, XCD_BAR_WORDS * 4, stream);
    void* args[] = {&p};
    hipError_t e = hipLaunchCooperativeKernel((const void*)fwd_kernel, dim3(grid_blocks), dim3(512), args, LDS_BYTES, stream);
    if (e != hipSuccess) fprintf(stderr, "cooperative launch failed: %s (grid %d)\n", hipGetErrorString(e), grid_blocks);
}
```

```cpp
#include <hip/hip_runtime.h>
#include <hip/hip_cooperative_groups.h>
#include <cstdio>
namespace cg = cooperative_groups;

#define LAS __attribute__((address_space(3)))
typedef unsigned short bf16_t;
typedef short bf16x8 __attribute__((ext_vector_type(8)));
typedef float f32x4 __attribute__((ext_vector_type(4)));
typedef float f32x2 __attribute__((ext_vector_type(2)));
typedef unsigned u32x2 __attribute__((ext_vector_type(2)));
typedef unsigned u32x4 __attribute__((ext_vector_type(4)));

constexpr int DM = 1024, TP = 16384, TS = 512, T = TP + TS;
constexpr int NINP = 7680;
constexpr float EPSF = 1e-6f;

constexpr size_t O_Y = 0;
constexpr size_t O_KP = (size_t)T * DM;
constexpr size_t O_VP = O_KP + 2 * 8 * 128 * 128;
constexpr size_t O_SP = O_VP + 2 * 8 * 128 * 128;
constexpr size_t O_CP = O_SP + (size_t)2 * 8 * 16 * 64 * 128;
constexpr size_t O_KS = O_CP + 2 * 8 * 3 * 1536;
constexpr size_t O_VS = O_KS + 2 * 32 * 16 * 128;
constexpr size_t O_SS = O_VS + 2 * 32 * 16 * 128;
constexpr size_t O_CS = O_SS + (size_t)2 * 32 * 16 * 64 * 128;
constexpr size_t O_GS = O_CS + 2 * 32 * 3 * 1536;

constexpr size_t WT_IN = 0;
constexpr size_t WT_AO = WT_IN + (size_t)NINP * 1024;
constexpr size_t WT_SO = WT_AO + 1024 * 512;
constexpr size_t WT_GO = WT_SO + 1024 * 1024;
constexpr size_t WT_OUT = WT_GO + 1024 * 512;
constexpr size_t WT_F1 = WT_OUT + 1024 * 1024;
constexpr size_t WT_F2 = WT_F1 + (size_t)4096 * 1024;
constexpr size_t WT_END = WT_F2 + (size_t)1024 * 4096;

constexpr size_t al256(size_t x) { return (x + 255) & ~(size_t)255; }
constexpr size_t W_WT = 0;
constexpr size_t W_MOD = al256(W_WT + WT_END * 2);
constexpr size_t W_ROPE = al256(W_MOD + (size_t)2 * 40 * 6144 * 4);
constexpr size_t W_ROWSS = al256(W_ROPE + (size_t)2064 * 8 * 8);
constexpr size_t W_CNT = al256(W_ROWSS + (size_t)T * 32 * 4);
constexpr size_t W_BAR = al256(W_CNT + 256);
constexpr size_t W_DT = al256(W_BAR + 3456 * 4);
constexpr size_t W_H = al256(W_DT + (size_t)T * 16 * 4);
constexpr size_t W_Q = al256(W_H + (size_t)T * 1024 * 2);
constexpr size_t W_K = W_Q + (size_t)T * 512 * 2;
constexpr size_t W_V = W_K + (size_t)T * 128 * 2;
constexpr size_t W_Z = W_V + (size_t)T * 128 * 2;
constexpr size_t W_XBC = W_Z + (size_t)T * 1024 * 2;
constexpr size_t W_GU = W_XBC + (size_t)T * 1536 * 2;
constexpr size_t W_GV = W_GU + (size_t)T * 512 * 2;
constexpr size_t W_PAEND = W_GV + (size_t)T * 512 * 2;
constexpr size_t W_FH = W_Q;
constexpr size_t W_G8 = al256(W_PAEND);
constexpr size_t W_BCN = al256(W_G8 + (size_t)T * 3072);
constexpr size_t W_BT = al256(W_BCN + (size_t)T * 512 * 2);
constexpr size_t W_END = W_BT + ((size_t)256 * 256 * 64 + (size_t)32 * 256 * 16) * 2;
static_assert((size_t)T * 4096 * 2 <= W_PAEND - W_Q, "FH alias");

constexpr int LDS_BYTES = 131072 + 2048;
#ifndef PROBE_MASK
#define PROBE_MASK 0
#endif
#if PROBE_MASK
#define PH_BEGIN(id) const unsigned long long _t_##id = wall_clock64()
#define PH_END(id) do { if ((PROBE_MASK >> (id)) & 1) probe_acc += wall_clock64() - _t_##id; } while (0)
#else
#define PH_BEGIN(id) do {} while (0)
#define PH_END(id) do {} while (0)
#endif

struct Params {
    const float *x_prompt, *x_sample, *c_prompt, *c_sample, *cache_k, *cache_v, *state_ssm, *state_conv;
    const float *w_ada, *b_ada, *g_mix, *w_in, *sinks, *conv_w, *conv_b, *dt_bias, *a_log, *d_skip, *ssm_norm_w;
    const float *gm_ln_g, *gm_ln_b, *gm_w_s, *gm_b_s, *w_attn_o, *w_ssm_o, *w_gm_o, *w_out, *g_ff, *w_ff1, *w_ff2, *g_final;
    float* out;
    unsigned char* ws;
};

typedef const Params __attribute__((address_space(4)))* KP;
__device__ __forceinline__ KP kparams() { KP q = (KP)__builtin_amdgcn_kernarg_segment_ptr(); asm volatile("" : "+s"(q)); return q; }

__device__ __forceinline__ int tid_() { int t = threadIdx.x; asm volatile("" : "+v"(t)); return t; }
__device__ __forceinline__ unsigned pk2(float lo, float hi) { unsigned r; asm("v_cvt_pk_bf16_f32 %0, %1, %2" : "=v"(r) : "v"(lo), "v"(hi)); return r; }
__device__ __forceinline__ bf16_t f2bf(float f) { return (bf16_t)(pk2(f, 0.f) & 0xffffu); }
__device__ __forceinline__ float bf2f(bf16_t b) { return __uint_as_float(((unsigned)b) << 16); }
__device__ __forceinline__ float bflo(unsigned u) { return __uint_as_float(u << 16); }
__device__ __forceinline__ float bfhi(unsigned u) { return __uint_as_float(u & 0xffff0000u); }
__device__ __forceinline__ float sigm(float x) { return __builtin_amdgcn_rcpf(1.f + __expf(-x)); }
__device__ __forceinline__ float siluf_(float x) { return x * sigm(x); }
__device__ __forceinline__ float geluf_(float x) { return x * sigm(1.5957691216057308f * (x + 0.044715f * x * x * x)); }
__device__ __forceinline__ float wave_sum(float v) {
#pragma unroll
    for (int o = 1; o < 64; o <<= 1) v += __shfl_xor(v, o);
    return v;
}
__device__ __forceinline__ u32x4 zero4() { unsigned z; asm volatile("v_mov_b32 %0, 0" : "=v"(z)); return (u32x4){z, z, z, z}; }
template <int CTRL, int RM = 0xf, int BK = 0xf>
__device__ __forceinline__ float dpp_add(float v) { return v + __int_as_float(__builtin_amdgcn_update_dpp(0, __float_as_int(v), CTRL, RM, BK, false)); }
__device__ __forceinline__ float row16_sum(float v) { v = dpp_add<0xB1>(v); v = dpp_add<0x4E>(v); v = dpp_add<0x141>(v); return dpp_add<0x140>(v); }
__device__ __forceinline__ float wave_scan(float c) { c = dpp_add<0x111>(c); c = dpp_add<0x112>(c); c = dpp_add<0x114>(c); c = dpp_add<0x118>(c); c = dpp_add<0x142, 0xa>(c); return dpp_add<0x143, 0xc>(c); }
__device__ __forceinline__ f32x4 mfma16(bf16x8 a, bf16x8 b, f32x4 c) { return __builtin_amdgcn_mfma_f32_16x16x32_bf16(a, b, c, 0, 0, 0); }
__device__ __forceinline__ int mod_row(int row) { return row < TP ? (row >> 11) : 8 + ((row - TP) >> 4); }

namespace pg8 {
constexpr int BM = 256, BK = 64, HALF = 128, HTB = HALF * BK * 2, STAGE_BYTES = 8 * HTB, NXCD = 8, WGM = 8;
__device__ __forceinline__ int lds_byte(int r, int c) { const int st = (r >> 4) * 2 + (c >> 5), rr = r & 15, cc = c & 31, ob = rr * 64 + cc * 2; return st * 1024 + (ob ^ (((ob >> 9) & 1) << 5)); }
__device__ __forceinline__ void stage_rc(int b, int& R, int& C) { const int st = b / 1024, sb = b % 1024, swz = sb ^ (((sb >> 9) & 1) << 5); R = (st >> 1) * 16 + swz / 64; C = (st & 1) * 32 + (swz % 64) / 2; }
struct Unit { int pm, pn; };
struct Gemm { const bf16_t* A; const bf16_t* Bt; int M, N, K; };
struct StaticOrder {
    int nM, nN, nwg, G, c;
    __device__ __forceinline__ void init(int M, int N, int G_, int c_) { nM = M / BM; nN = N / BM; nwg = nM * nN; G = G_; c = c_; }
    __device__ __forceinline__ bool next(int i, Unit& u) const {
        const long L = (long)i * G + c; if (L >= nwg) return false;
        int wgid = (int)L; { const int q = nwg / NXCD, r = nwg % NXCD, xcd = wgid % NXCD, off = wgid / NXCD; wgid = (xcd < r ? xcd * (q + 1) : r * (q + 1) + (xcd - r) * q) + off; }
        const int nig = WGM * nN, gid = wgid / nig, fm = gid * WGM, gsz = (nM - fm) < WGM ? (nM - fm) : WGM;
        u.pm = fm + ((wgid % nig) % gsz); u.pn = (wgid % nig) / gsz; return true;
    }
};
template <class Epi>
__device__ __forceinline__ void gemm_phase(LAS unsigned char* lds, const Gemm g, const StaticOrder& S, const Epi& E) {
    const int tid = tid_(), wid = __builtin_amdgcn_readfirstlane(tid >> 6), lane = tid & 63, wr = wid >> 2, wc = wid & 3, fr = lane & 15, fq = lane >> 4;
    const int K = g.K, nt = K / BK;
    unsigned voffA[2], voffB[2];
#pragma unroll
    for (int i = 0; i < 2; ++i) { int R, C; stage_rc(tid * 16 + i * 8192, R, C); voffA[i] = (unsigned)(R * K + C) * 2u; voffB[i] = voffA[i]; }
    const size_t kstep = (size_t)(BK * 2);
    const size_t hstep = (size_t)HALF * K * 2;
    const size_t tstep = 2 * hstep;
    const unsigned ldsw = (unsigned)wid * 1024u;
    const int aoff = lds_byte(wr * 64 + fr, fq * 8), boff = lds_byte(wc * 32 + fr, fq * 8);
#define PG8_SA(b, h) (((b) * 2 + (h)) * HTB)
#define PG8_SB(b, h) ((4 + (b) * 2 + (h)) * HTB)
#define PG8_STAGE(bufoff, gbase, voff) do { _Pragma("unroll") for (int _i = 0; _i < 2; ++_i) \
        __builtin_amdgcn_global_load_lds((const unsigned*)((const char*)(gbase) + (voff)[_i]), (LAS unsigned*)(lds + (bufoff) + ldsw + _i * 8192), 16, 0, 0); } while (0)
#define PG8_LDA(dst, b, h) do { _Pragma("unroll") for (int m = 0; m < 4; ++m) _Pragma("unroll") for (int k = 0; k < 2; ++k) dst[m][k] = *(const LAS bf16x8*)(lds + PG8_SA(b, h) + aoff + m * 2048 + k * 1024); } while (0)
#define PG8_LDB(dst, b, h) do { _Pragma("unroll") for (int n = 0; n < 2; ++n) _Pragma("unroll") for (int k = 0; k < 2; ++k) dst[n][k] = *(const LAS bf16x8*)(lds + PG8_SB(b, h) + boff + n * 2048 + k * 1024); } while (0)
#define PG8_MMA(ai, bj, At, Bt) do { __builtin_amdgcn_s_setprio(1); _Pragma("unroll") for (int m = 0; m < 4; ++m) _Pragma("unroll") for (int n = 0; n < 2; ++n) _Pragma("unroll") for (int k = 0; k < 2; ++k) \
        acc[ai][bj][m][n] = __builtin_amdgcn_mfma_f32_16x16x32_bf16(Bt[n][k], At[m][k], acc[ai][bj][m][n], 0, 0, 0); __builtin_amdgcn_s_setprio(0); } while (0)
#define PG8_WAIT_V(n) asm volatile("s_waitcnt vmcnt(" #n ")" ::: "memory")
#define PG8_WAIT_L(n) asm volatile("s_waitcnt lgkmcnt(" #n ")" ::: "memory")
#define PG8_BAR __builtin_amdgcn_s_barrier()
#define PG8_SCHED __builtin_amdgcn_sched_barrier(0)
    Unit cur, nxt; int ui = 0;
    if (!S.next(0, cur)) return;
    f32x4 acc[2][2][4][2];
#pragma unroll
    for (int a = 0; a < 2; ++a)
#pragma unroll
        for (int b = 0; b < 2; ++b)
#pragma unroll
            for (int m = 0; m < 4; ++m)
#pragma unroll
                for (int n = 0; n < 2; ++n) acc[a][b][m][n] = (f32x4){0.f, 0.f, 0.f, 0.f};
    bf16x8 At[4][2], B0[2][2], B1[2][2];
    const char* cA = (const char*)g.A + (size_t)cur.pm * tstep; const char* cB = (const char*)g.Bt + (size_t)cur.pn * tstep;
    PG8_STAGE(PG8_SB(0, 0), cB, voffB); PG8_STAGE(PG8_SA(0, 0), cA, voffA); PG8_STAGE(PG8_SB(0, 1), cB + hstep, voffB); PG8_STAGE(PG8_SA(0, 1), cA + hstep, voffA);
    if (wr == 1) PG8_BAR;
    PG8_WAIT_V(4); PG8_BAR;
    PG8_STAGE(PG8_SB(1, 0), cB + kstep, voffB); PG8_STAGE(PG8_SA(1, 0), cA + kstep, voffA); PG8_STAGE(PG8_SB(1, 1), cB + hstep + kstep, voffB);
    PG8_WAIT_V(6); PG8_BAR;
    for (;;) {
        const bool has_next = S.next(ui + 1, nxt);
        const char* nA = has_next ? (const char*)g.A + (size_t)nxt.pm * tstep : cA; const char* nB = has_next ? (const char*)g.Bt + (size_t)nxt.pn * tstep : cB;
        for (int t = 0; t < nt; t += 2) {
            const bool last = (t == nt - 2);
            const char* a1 = cA + (size_t)(t + 1) * kstep;
            const char* a2 = last ? nA : cA + (size_t)(t + 2) * kstep; const char* b2 = last ? nB : cB + (size_t)(t + 2) * kstep;
            const char* a3 = a2 + kstep; const char* b3 = b2 + kstep;
            PG8_LDB(B0, 0, 0); PG8_SCHED; PG8_LDA(At, 0, 0); PG8_STAGE(PG8_SA(1, 1), a1 + hstep, voffA);
            PG8_WAIT_L(8); PG8_BAR; PG8_WAIT_L(0); PG8_MMA(0, 0, At, B0); PG8_BAR; PG8_SCHED;
            PG8_LDB(B1, 0, 1); PG8_STAGE(PG8_SB(0, 0), b2, voffB);
            PG8_BAR; PG8_WAIT_L(0); PG8_MMA(0, 1, At, B1); PG8_BAR;
            PG8_LDA(At, 0, 1); PG8_STAGE(PG8_SA(0, 0), a2, voffA);
            PG8_BAR; PG8_WAIT_L(0); PG8_MMA(1, 0, At, B0); PG8_BAR; PG8_SCHED;
            PG8_STAGE(PG8_SB(0, 1), b2 + hstep, voffB);
            PG8_WAIT_V(6); PG8_BAR; PG8_MMA(1, 1, At, B1); PG8_BAR;
            PG8_LDB(B0, 1, 0); PG8_SCHED; PG8_LDA(At, 1, 0); PG8_STAGE(PG8_SA(0, 1), a2 + hstep, voffA);
            PG8_WAIT_L(8); PG8_BAR; PG8_WAIT_L(0); PG8_MMA(0, 0, At, B0); PG8_BAR; PG8_SCHED;
            PG8_LDB(B1, 1, 1); PG8_STAGE(PG8_SB(1, 0), b3, voffB);
            PG8_BAR; PG8_WAIT_L(0); PG8_MMA(0, 1, At, B1); PG8_BAR;
            PG8_LDA(At, 1, 1); PG8_STAGE(PG8_SA(1, 0), a3, voffA);
            PG8_BAR; PG8_WAIT_L(0); PG8_MMA(1, 0, At, B0); PG8_BAR; PG8_SCHED;
            PG8_STAGE(PG8_SB(1, 1), b3 + hstep, voffB);
            PG8_WAIT_V(6); PG8_BAR; PG8_MMA(1, 1, At, B1); PG8_BAR;
        }
        E(acc, cur, wr, wc, fr, fq);
        if (!has_next) break;
#pragma unroll
        for (int a = 0; a < 2; ++a)
#pragma unroll
            for (int b = 0; b < 2; ++b)
#pragma unroll
                for (int m = 0; m < 4; ++m)
#pragma unroll
                    for (int n = 0; n < 2; ++n) acc[a][b][m][n] = (f32x4){0.f, 0.f, 0.f, 0.f};
        cur = nxt; cA = nA; cB = nB; ++ui;
    }
    PG8_WAIT_V(0);
    if (wr == 0) PG8_BAR;
    PG8_BAR;
#undef PG8_SA
#undef PG8_SB
#undef PG8_STAGE
#undef PG8_LDA
#undef PG8_LDB
#undef PG8_MMA
#undef PG8_WAIT_V
#undef PG8_WAIT_L
#undef PG8_BAR
#undef PG8_SCHED
}
}

template <class F, int MG = 2> struct EpiRC {
    F f;
    __device__ __forceinline__ void operator()(const f32x4 (&acc)[2][2][4][2], const pg8::Unit& u, int wr, int wc, int fr, int fq) const {
        const int row0 = u.pm * 256 + wr * 64 + fr, col0 = u.pn * 256 + wc * 32 + 4 * fq;
#pragma unroll
        for (int ai = 0; ai < 2; ++ai)
#pragma unroll
            for (int mh = 0; mh < 4 / MG; ++mh) {
                typename F::Ld ld[MG][2][2];
#pragma unroll
                for (int mm = 0; mm < MG; ++mm)
#pragma unroll
                    for (int bj = 0; bj < 2; ++bj)
#pragma unroll
                        for (int n = 0; n < 2; ++n) f.load(row0 + ai * 128 + (mh * MG + mm) * 16, col0 + bj * 128 + n * 16, ld[mm][bj][n]);
#pragma unroll
                for (int mm = 0; mm < MG; ++mm)
#pragma unroll
                    for (int bj = 0; bj < 2; ++bj)
#pragma unroll
                        for (int n = 0; n < 2; ++n) f.apply(row0 + ai * 128 + (mh * MG + mm) * 16, col0 + bj * 128 + n * 16, acc[ai][bj][mh * MG + mm][n], ld[mm][bj][n]);
            }
    }
};
struct EpiResidP {
    const float* src; float* X; const float* modg;
    __device__ __forceinline__ void operator()(const f32x4 (&acc)[2][2][4][2], const pg8::Unit& u, int wr, int wc, int fr, int fq) const {
        const int row0 = u.pm * 256 + wr * 64 + fr, col0 = u.pn * 256 + wc * 32 + 4 * fq;
        const float* gp = modg + (size_t)((u.pm * 256) >> 11) * 6144 + col0;
        f32x4 g[2][2];
#pragma unroll
        for (int bj = 0; bj < 2; ++bj)
#pragma unroll
            for (int n = 0; n < 2; ++n) g[bj][n] = *(const f32x4*)(gp + bj * 128 + n * 16);
#pragma unroll
        for (int ai = 0; ai < 2; ++ai) {
            f32x4 x[4][2][2];
#pragma unroll
            for (int m = 0; m < 4; ++m)
#pragma unroll
                for (int bj = 0; bj < 2; ++bj)
#pragma unroll
                    for (int n = 0; n < 2; ++n) x[m][bj][n] = *(const f32x4*)(src + (size_t)(row0 + ai * 128 + m * 16) * 1024 + col0 + bj * 128 + n * 16);
#pragma unroll
            for (int m = 0; m < 4; ++m)
#pragma unroll
                for (int bj = 0; bj < 2; ++bj)
#pragma unroll
                    for (int n = 0; n < 2; ++n) *(f32x4*)(X + (size_t)(row0 + ai * 128 + m * 16) * 1024 + col0 + bj * 128 + n * 16) = x[m][bj][n] + g[bj][n] * acc[ai][bj][m][n];
        }
    }
};

template <int KW, class F>
__device__ __forceinline__ void skinny_gemm(unsigned char* shm, const bf16_t* A, const bf16_t* Bt, int N, const F& f) {
    constexpr int K = KW * 8, NS = KW / 32 < 4 ? KW / 32 : 4, NSTEP = KW / 32;
    const int tid = tid_(), w = tid >> 6, lane = tid & 63, fr = lane & 15, fq = lane >> 4;
    f32x4* red = (f32x4*)shm;
    const int nun = 16 * (N / 64);
    for (int u = blockIdx.x; u < nun; u += gridDim.x) {
        const int m0 = (u & 15) * 32, n0 = (u >> 4) * 64;
        typename F::Ld eld; const int er = TP + m0 + (w >> 2) * 16 + fr, ec = n0 + (w & 3) * 16 + fq * 4; f.load(er, ec, eld);
        f32x4 acc[2][4];
#pragma unroll
        for (int i = 0; i < 2; ++i)
#pragma unroll
            for (int j = 0; j < 4; ++j) acc[i][j] = (f32x4){0.f, 0.f, 0.f, 0.f};
        const bf16_t* ap = A + (size_t)(m0 + fr) * K + w * KW + fq * 8;
        const bf16_t* bp = Bt + (size_t)(n0 + fr) * K + w * KW + fq * 8;
        bf16x8 ra[NS][2], rb[NS][4];
#pragma unroll
        for (int s = 0; s < NS; ++s) {
#pragma unroll
            for (int i = 0; i < 2; ++i) ra[s][i] = *(const bf16x8*)(ap + (size_t)i * 16 * K + s * 32);
#pragma unroll
            for (int j = 0; j < 4; ++j) rb[s][j] = *(const bf16x8*)(bp + (size_t)j * 16 * K + s * 32);
        }
#pragma unroll
        for (int st = 0; st < NSTEP; ++st) {
            const int s = st % NS;
#pragma unroll
            for (int i = 0; i < 2; ++i)
#pragma unroll
                for (int j = 0; j < 4; ++j) acc[i][j] = mfma16(rb[s][j], ra[s][i], acc[i][j]);
            if (st + NS < NSTEP) {
#pragma unroll
                for (int i = 0; i < 2; ++i) ra[s][i] = *(const bf16x8*)(ap + (size_t)i * 16 * K + (st + NS) * 32);
#pragma unroll
                for (int j = 0; j < 4; ++j) rb[s][j] = *(const bf16x8*)(bp + (size_t)j * 16 * K + (st + NS) * 32);
            }
        }
        __syncthreads();
#pragma unroll
        for (int i = 0; i < 2; ++i)
#pragma unroll
            for (int j = 0; j < 4; ++j) red[(w * 8 + i * 4 + j) * 64 + lane] = acc[i][j];
        __syncthreads();
        f32x4 s = red[w * 64 + lane];
#pragma unroll
        for (int q = 1; q < 8; ++q) s += red[(q * 8 + w) * 64 + lane];
        f.apply(er, ec, s, eld);
    }
    __syncthreads();
}

struct EpiIn {
    int l; KP pp;
    __device__ __forceinline__ void operator()(const f32x4 (&acc)[2][2][4][2], const pg8::Unit& u, int wr, int wc, int fr, int fq) const {
        const KP p = pp;
        unsigned char* ws = p->ws;
        const int pn = u.pn;
        const int row0 = u.pm * 256 + wr * 64 + fr;
        const int ct0 = wc * 32 + 4 * fq;
        if (pn < 3) {
            bf16_t* Qb = (bf16_t*)(ws + W_Q); bf16_t* Kb = (bf16_t*)(ws + W_K); bf16_t* Vb = (bf16_t*)(ws + W_V);
            const f32x2* rope = (const f32x2*)(ws + W_ROPE);
#pragma unroll
            for (int ai = 0; ai < 2; ++ai)
#pragma unroll
                for (int m = 0; m < 4; ++m) {
                    const int row = row0 + ai * 128 + m * 16;
                    const bool samp = row >= TP;
                    const int b = samp ? (row - TP) >> 4 : row >> 11, t = samp ? (row - TP) & 15 : row & 2047;
                    const int pi = samp ? 2048 + t : t;
#pragma unroll
                    for (int bj = 0; bj < 2; ++bj)
#pragma unroll
                        for (int n = 0; n < 2; ++n) {
                            f32x4 v = acc[ai][bj][m][n];
                            const int ct = bj * 128 + ct0 + n * 16;
                            const bool isv = (pn == 2) && (bj == 1);
                            if (!isv && n == 0 && (wc & 1) == 0) {
                                f32x4 o;
                                o[0] = __shfl_xor(v[0], 32); o[1] = __shfl_xor(v[1], 32); o[2] = __shfl_xor(v[2], 32); o[3] = __shfl_xor(v[3], 32);
                                const f32x4* cs = (const f32x4*)(rope + pi * 8 + 4 * (fq & 1));
                                const f32x4 c01 = cs[0], c23 = cs[1];
                                const float sgn = (fq < 2) ? -1.f : 1.f;
                                v[0] = v[0] * c01[0] + sgn * o[0] * c01[1];
                                v[1] = v[1] * c01[2] + sgn * o[1] * c01[3];
                                v[2] = v[2] * c23[0] + sgn * o[2] * c23[1];
                                v[3] = v[3] * c23[2] + sgn * o[3] * c23[3];
                            }
                            u32x2 pk; pk.x = pk2(v[0], v[1]); pk.y = pk2(v[2], v[3]);
                            if (pn < 2) { *(u32x2*)(Qb + (size_t)row * 512 + pn * 256 + ct) = pk; }
                            else {
                                const int c = ct & 127;
                                bf16_t* dst = isv ? Vb : Kb;
                                *(u32x2*)(dst + (size_t)row * 128 + c) = pk;
                                if (samp) {
                                    float* o = p->out + (isv ? O_VS : O_KS) + ((size_t)(l * 32 + b) * 16 + t) * 128 + c;
                                    *(f32x4*)o = v;
                                } else if (t >= 1920) {
                                    float* o = p->out + (isv ? O_VP : O_KP) + ((size_t)(l * 8 + b) * 128 + (t - 1920)) * 128 + c;
                                    *(f32x4*)o = v;
                                }
                            }
                        }
                }
        } else if (pn < 7) {
            bf16_t* Zb = (bf16_t*)(ws + W_Z);
#pragma unroll
            for (int ai = 0; ai < 2; ++ai)
#pragma unroll
                for (int m = 0; m < 4; ++m) {
                    const int row = row0 + ai * 128 + m * 16;
#pragma unroll
                    for (int bj = 0; bj < 2; ++bj)
#pragma unroll
                        for (int n = 0; n < 2; ++n) {
                            const f32x4 v = acc[ai][bj][m][n];
                            u32x2 pk; pk.x = pk2(v[0], v[1]); pk.y = pk2(v[2], v[3]);
                            *(u32x2*)(Zb + (size_t)row * 1024 + (pn - 3) * 256 + bj * 128 + ct0 + n * 16) = pk;
                        }
                }
        } else if (pn < 13) {
            bf16_t* Xb = (bf16_t*)(ws + W_XBC);
#pragma unroll
            for (int ai = 0; ai < 2; ++ai)
#pragma unroll
                for (int m = 0; m < 4; ++m) {
                    const int row = row0 + ai * 128 + m * 16;
                    const bool samp = row >= TP;
                    const int b = samp ? (row - TP) >> 4 : row >> 11, t = samp ? (row - TP) & 15 : row & 2047;
#pragma unroll
                    for (int bj = 0; bj < 2; ++bj)
#pragma unroll
                        for (int n = 0; n < 2; ++n) {
                            const f32x4 v = acc[ai][bj][m][n];
                            const int cc = (pn - 7) * 256 + bj * 128 + ct0 + n * 16;
                            u32x2 pk; pk.x = pk2(v[0], v[1]); pk.y = pk2(v[2], v[3]);
                            *(u32x2*)(Xb + (size_t)row * 1536 + cc) = pk;
                            if (samp) { if (t >= 13) *(f32x4*)(p->out + O_CS + ((size_t)(l * 32 + b) * 3 + (t - 13)) * 1536 + cc) = v; }
                            else if (t >= 2045) *(f32x4*)(p->out + O_CP + ((size_t)(l * 8 + b) * 3 + (t - 2045)) * 1536 + cc) = v;
                        }
                }
        } else if (pn < 17) {
            bf16_t* dst = (bf16_t*)(ws + (pn < 15 ? W_GU : W_GV));
            const int cb = ((pn - 13) & 1) * 256;
#pragma unroll
            for (int ai = 0; ai < 2; ++ai)
#pragma unroll
                for (int m = 0; m < 4; ++m) {
                    const int row = row0 + ai * 128 + m * 16;
#pragma unroll
                    for (int bj = 0; bj < 2; ++bj)
#pragma unroll
                        for (int n = 0; n < 2; ++n) {
                            const f32x4 v = acc[ai][bj][m][n];
                            u32x2 pk; pk.x = pk2(geluf_(v[0]), geluf_(v[1])); pk.y = pk2(geluf_(v[2]), geluf_(v[3]));
                            *(u32x2*)(dst + (size_t)row * 512 + cb + bj * 128 + ct0 + n * 16) = pk;
                        }
                }
        } else if (pn < 29) {
            unsigned char* G8 = ws + W_G8;
#pragma unroll
            for (int ai = 0; ai < 2; ++ai)
#pragma unroll
                for (int m = 0; m < 4; ++m) {
                    const int row = row0 + ai * 128 + m * 16;
#pragma unroll
                    for (int bj = 0; bj < 2; ++bj)
#pragma unroll
                        for (int n = 0; n < 2; ++n) {
                            const f32x4 v = acc[ai][bj][m][n];
                            const unsigned q0 = (unsigned)(sigm(v[0]) * 255.f + 0.5f), q1 = (unsigned)(sigm(v[1]) * 255.f + 0.5f);
                            const unsigned q2 = (unsigned)(sigm(v[2]) * 255.f + 0.5f), q3 = (unsigned)(sigm(v[3]) * 255.f + 0.5f);
                            *(unsigned*)(G8 + (size_t)row * 3072 + (pn - 17) * 256 + bj * 128 + ct0 + n * 16) = q0 | (q1 << 8) | (q2 << 16) | (q3 << 24);
                        }
                }
        } else {
            if (wc == 0) {
                float* DT = (float*)(ws + W_DT);
                const f32x4 bias = *(const f32x4*)(p->dt_bias + l * 16 + 4 * fq);
#pragma unroll
                for (int ai = 0; ai < 2; ++ai)
#pragma unroll
                    for (int m = 0; m < 4; ++m) {
                        const int row = row0 + ai * 128 + m * 16;
                        f32x4 v = acc[ai][0][m][0] + bias;
#pragma unroll
                        for (int e = 0; e < 4; ++e) { const float x = v[e]; v[e] = fmaxf(x, 0.f) + log1pf(__expf(-fabsf(x))); }
                        *(f32x4*)(DT + (size_t)row * 16 + 4 * fq) = v;
                    }
            }
        }
    }
};

template <bool BIG> struct FMergeT {
    int b; const unsigned char* G8; const float* rowss; bf16_t* MG;
    const float* tile_rstd; int tile_row0;
    struct Ld { unsigned g; float ss; u32x2 o; };
    __device__ __forceinline__ void load(int row, int col, Ld& d) const {
        d.g = *(const unsigned*)(G8 + (size_t)row * 3072 + b * 1024 + col);
        d.ss = 1.f;
        if (b == 1) {
            if (BIG) d.ss = tile_rstd[row - tile_row0];
            else {
                const f32x4* pp = (const f32x4*)(rowss + (size_t)row * 32);
                const f32x4 t = ((pp[0] + pp[1]) + (pp[2] + pp[3])) + ((pp[4] + pp[5]) + (pp[6] + pp[7]));
                d.ss = rsqrtf(((t[0] + t[1]) + (t[2] + t[3])) * (1.f / 1024.f) + EPSF);
            }
        }
        d.o = (b > 0) ? *(const u32x2*)(MG + (size_t)row * 1024 + col) : (u32x2){0u, 0u};
    }
    __device__ __forceinline__ void apply(int row, int col, f32x4 v, const Ld& d) const {
        const float sc = d.ss * (1.f / 255.f);
        const unsigned g = d.g;
        f32x4 r;
        r[0] = (float)(g & 255u) * sc * v[0]; r[1] = (float)((g >> 8) & 255u) * sc * v[1];
        r[2] = (float)((g >> 16) & 255u) * sc * v[2]; r[3] = (float)(g >> 24) * sc * v[3];
        if (b > 0) { r[0] += bflo(d.o.x); r[1] += bfhi(d.o.x); r[2] += bflo(d.o.y); r[3] += bfhi(d.o.y); }
        u32x2 pk; pk.x = pk2(r[0], r[1]); pk.y = pk2(r[2], r[3]);
        *(u32x2*)(MG + (size_t)row * 1024 + col) = pk;
    }
};
struct FResid {
    const float* srcP; const float* srcS; float* X; const float* modg;
    struct Ld { f32x4 x, g; };
    __device__ __forceinline__ void load(int row, int col, Ld& d) const {
        const float* s = row < TP ? srcP + (size_t)row * 1024 + col : srcS + (size_t)(row - TP) * 1024 + col;
        d.x = *(const f32x4*)s;
        d.g = *(const f32x4*)(modg + (size_t)mod_row(row) * 6144 + col);
    }
    __device__ __forceinline__ void apply(int row, int col, f32x4 v, const Ld& d) const {
        *(f32x4*)(X + (size_t)row * 1024 + col) = d.x + d.g * v;
    }
};
struct FRelu2 {
    bf16_t* FH;
    struct Ld { };
    __device__ __forceinline__ void load(int, int, Ld&) const {}
    __device__ __forceinline__ void apply(int row, int col, f32x4 v, const Ld&) const {
        f32x4 r; r[0] = fmaxf(v[0], 0.f); r[1] = fmaxf(v[1], 0.f); r[2] = fmaxf(v[2], 0.f); r[3] = fmaxf(v[3], 0.f);
        u32x2 pk; pk.x = pk2(r[0] * r[0], r[1] * r[1]); pk.y = pk2(r[2] * r[2], r[3] * r[3]);
        *(u32x2*)(FH + (size_t)row * 4096 + col) = pk;
    }
};

__device__ __forceinline__ void phase_mod(KP p, float* lds) {
    float* sc = lds;
    float* red = lds + 20480;
    float* MOD = (float*)(p->ws + W_MOD);
    const int tid = tid_();
    const int rh = blockIdx.x & 1;
    __syncthreads();
    for (int idx = tid; idx < 20480; idx += 512) {
        const int r = idx >> 10, k = idx & 1023, gr = rh * 20 + r;
        const float c = gr < 8 ? p->c_prompt[gr * 1024 + k] : p->c_sample[(gr - 8) * 1024 + k];
        sc[k * 20 + r] = siluf_(c);
    }
    __syncthreads();
    for (int pi = blockIdx.x >> 1; pi < 384; pi += gridDim.x >> 1) {
        const int l = pi / 192, cgp = pi % 192;
        const int cn = tid & 31, ks = tid >> 5, n = cgp * 32 + cn;
        float acc[20];
#pragma unroll
        for (int r = 0; r < 20; ++r) acc[r] = 0.f;
        const float* w = p->w_ada + (size_t)l * 1024 * 6144 + n + (size_t)ks * 64 * 6144;
#pragma unroll 1
        for (int kb = 0; kb < 64; kb += 32) {
            float wv[32];
#pragma unroll
            for (int i = 0; i < 32; ++i) wv[i] = w[(size_t)(kb + i) * 6144];
#pragma unroll
            for (int i = 0; i < 32; ++i) {
                const f32x4* s4 = (const f32x4*)(sc + (ks * 64 + kb + i) * 20);
#pragma unroll
                for (int q = 0; q < 5; ++q) { const f32x4 s = s4[q]; acc[4 * q] += s[0] * wv[i]; acc[4 * q + 1] += s[1] * wv[i]; acc[4 * q + 2] += s[2] * wv[i]; acc[4 * q + 3] += s[3] * wv[i]; }
            }
        }
#pragma unroll
        for (int r = 0; r < 20; ++r) red[(ks * 20 + r) * 32 + cn] = acc[r];
        __syncthreads();
        for (int idx = tid; idx < 640; idx += 512) {
            const int r = idx >> 5, c2 = idx & 31, n2 = cgp * 32 + c2;
            float s = 0.f;
#pragma unroll
            for (int k16 = 0; k16 < 16; ++k16) s += red[(k16 * 20 + r) * 32 + c2];
            MOD[((size_t)l * 40 + rh * 20 + r) * 6144 + n2] = s + p->b_ada[l * 6144 + n2];
        }
        __syncthreads();
    }
}

struct CvtTile { const float* src; bf16_t* dst; int K, Ns, mode, n0, k0; };
__device__ __forceinline__ CvtTile cvt_tile(KP p, int l, int it) {
    bf16_t* WT = (bf16_t*)(p->ws + W_WT);
    CvtTile c; int nT; int r = it; c.mode = 0;
    if (r < 1920) { c.src = p->w_in + (size_t)l * 1024 * 7440; c.K = 1024; c.Ns = 7440; nT = 120; c.dst = WT + WT_IN; c.mode = 1; }
    else if ((r -= 1920) < 128) { c.src = p->w_attn_o + (size_t)l * 512 * 1024; c.K = 512; c.Ns = 1024; nT = 16; c.dst = WT + WT_AO; }
    else if ((r -= 128) < 256) { c.src = p->w_ssm_o + (size_t)l * 1024 * 1024; c.K = 1024; c.Ns = 1024; nT = 16; c.dst = WT + WT_SO; c.mode = 2; }
    else if ((r -= 256) < 128) { c.src = p->w_gm_o + (size_t)l * 512 * 1024; c.K = 512; c.Ns = 1024; nT = 16; c.dst = WT + WT_GO; }
    else if ((r -= 128) < 256) { c.src = p->w_out + (size_t)l * 1024 * 1024; c.K = 1024; c.Ns = 1024; nT = 16; c.dst = WT + WT_OUT; }
    else if ((r -= 256) < 1024) { c.src = p->w_ff1 + (size_t)l * 1024 * 4096; c.K = 1024; c.Ns = 4096; nT = 64; c.dst = WT + WT_F1; }
    else { r -= 1024; c.src = p->w_ff2 + (size_t)l * 4096 * 1024; c.K = 4096; c.Ns = 1024; nT = 16; c.dst = WT + WT_F2; }
    c.n0 = (r % nT) * 64; c.k0 = (r / nT) * 64;
    return c;
}
__device__ __forceinline__ void convert_weights(KP p, int l, float* tiles) {
    const int tid = tid_();
    for (int it = blockIdx.x * 4; it < 4736; it += gridDim.x * 4) {
        CvtTile c[4] = {cvt_tile(p, l, it), cvt_tile(p, l, it + 1), cvt_tile(p, l, it + 2), cvt_tile(p, l, it + 3)};
        __syncthreads();
        float v[4][8];
#pragma unroll
        for (int h = 0; h < 4; ++h) {
            const int nn = tid & 63, ns = c[h].n0 + nn; int sc_ = ns; bool zero = false;
            if (c[h].mode == 1) { if (ns < 3328) sc_ = ns; else if (ns < 7424) sc_ = ns + 16; else if (ns < 7440) sc_ = ns - 7424 + 3328; else { zero = true; sc_ = 0; } }
#pragma unroll
            for (int i = 0; i < 8; ++i) {
                const int kk = (tid >> 6) + 8 * i;
                v[h][i] = zero ? 0.f : c[h].src[(size_t)(c[h].k0 + kk) * c[h].Ns + sc_];
            }
        }
#pragma unroll
        for (int h = 0; h < 4; ++h)
#pragma unroll
            for (int i = 0; i < 8; ++i) {
                const int kk = (tid >> 6) + 8 * i;
                float x = v[h][i];
                if (c[h].mode == 2) x *= p->ssm_norm_w[l * 1024 + c[h].k0 + kk];
                tiles[h * 4224 + kk * 65 + (tid & 63)] = x;
            }
        __syncthreads();
#pragma unroll
        for (int h = 0; h < 4; ++h) {
            const float* tile = tiles + h * 4224;
            const int nr = tid >> 3, kc = (tid & 7) * 8;
            u32x4 o;
            o.x = pk2(tile[(kc + 0) * 65 + nr], tile[(kc + 1) * 65 + nr]);
            o.y = pk2(tile[(kc + 2) * 65 + nr], tile[(kc + 3) * 65 + nr]);
            o.z = pk2(tile[(kc + 4) * 65 + nr], tile[(kc + 5) * 65 + nr]);
            o.w = pk2(tile[(kc + 6) * 65 + nr], tile[(kc + 7) * 65 + nr]);
            *(u32x4*)(c[h].dst + (size_t)(c[h].n0 + nr) * c[h].K + c[h].k0 + kc) = o;
        }
    }
    __syncthreads();
}

__device__ __forceinline__ void phase_norm(KP p, int l, const float* srcP, const float* srcS, const float* gvec, int shift_idx) {
    const int tid = tid_(), lane = tid & 63, gw = blockIdx.x * 8 + (tid >> 6), ngw = gridDim.x * 8;
    const float* MOD = (const float*)(p->ws + W_MOD);
    bf16_t* H = (bf16_t*)(p->ws + W_H);
    f32x4 g[4];
#pragma unroll
    for (int j = 0; j < 4; ++j) g[j] = ((const f32x4*)gvec)[lane + 64 * j];
    f32x4 nx[4];
    {
        const int row = gw < T ? gw : T - 1;
        const float* xr = row < TP ? srcP + (size_t)row * 1024 : srcS + (size_t)(row - TP) * 1024;
#pragma unroll
        for (int j = 0; j < 4; ++j) nx[j] = ((const f32x4*)xr)[lane + 64 * j];
    }
    for (int row = gw; row < T; row += ngw) {
        f32x4 v[4];
#pragma unroll
        for (int j = 0; j < 4; ++j) v[j] = nx[j];
        {
            const int rn = row + ngw < T ? row + ngw : row;
            const float* xr = rn < TP ? srcP + (size_t)rn * 1024 : srcS + (size_t)(rn - TP) * 1024;
#pragma unroll
            for (int j = 0; j < 4; ++j) nx[j] = ((const f32x4*)xr)[lane + 64 * j];
        }
        const float* md = MOD + ((size_t)l * 40 + mod_row(row)) * 6144 + shift_idx * 1024;
        f32x4 sh[4], sc[4];
#pragma unroll
        for (int j = 0; j < 4; ++j) { sh[j] = ((const f32x4*)md)[lane + 64 * j]; sc[j] = ((const f32x4*)(md + 1024))[lane + 64 * j]; }
        float ss = 0.f;
#pragma unroll
        for (int j = 0; j < 4; ++j) ss += v[j][0] * v[j][0] + v[j][1] * v[j][1] + v[j][2] * v[j][2] + v[j][3] * v[j][3];
        ss = wave_sum(ss);
        const float rstd = rsqrtf(ss * (1.f / 1024.f) + EPSF);
#pragma unroll
        for (int j = 0; j < 4; ++j) {
            f32x4 h;
#pragma unroll
            for (int e = 0; e < 4; ++e) h[e] = (v[j][e] * rstd * g[j][e]) * (1.f + sc[j][e]) + sh[j][e];
            u32x2 pk; pk.x = pk2(h[0], h[1]); pk.y = pk2(h[2], h[3]);
            *(u32x2*)(H + (size_t)row * 1024 + (lane + 64 * j) * 4) = pk;
        }
    }
}

template <int NMT>
__device__ __forceinline__ void attn_load_q(const bf16_t* qo, int lane, bf16x8 (&qf)[NMT][2]) {
    const int fr = lane & 15, fq = lane >> 4;
#pragma unroll
    for (int mt = 0; mt < NMT; ++mt)
#pragma unroll
        for (int ks = 0; ks < 2; ++ks) qf[mt][ks] = *(const bf16x8*)(qo + (size_t)(mt * 16 + fr) * 512 + ks * 32 + fq * 8);
}
template <int NMT>
__device__ __forceinline__ void attn_compute(const bf16_t* Ks, const bf16_t* VT, bf16_t* qo, const bf16x8 (&qf)[NMT][2], int kt0, int kt1, int nkeys, float sink, int lane) {
    const int fr = lane & 15, fq = lane >> 4;
    f32x4 s[12][NMT];
#pragma unroll
    for (int kp = 0; kp < 6; ++kp) {
#pragma unroll
        for (int h2 = 0; h2 < 2; ++h2)
#pragma unroll
            for (int mt = 0; mt < NMT; ++mt) s[2 * kp + h2][mt] = (f32x4){0.f, 0.f, 0.f, 0.f};
        if (2 * kp >= kt0 && 2 * kp < kt1) {
            bf16x8 kf[2][2];
#pragma unroll
            for (int h2 = 0; h2 < 2; ++h2)
#pragma unroll
                for (int ks = 0; ks < 2; ++ks) kf[h2][ks] = *(const bf16x8*)(Ks + ((2 * kp + h2) * 16 + fr) * 72 + ks * 32 + fq * 8);
#pragma unroll
            for (int h2 = 0; h2 < 2; ++h2)
#pragma unroll
                for (int ks = 0; ks < 2; ++ks)
#pragma unroll
                    for (int mt = 0; mt < NMT; ++mt) s[2 * kp + h2][mt] = mfma16(kf[h2][ks], qf[mt][ks], s[2 * kp + h2][mt]);
        }
    }
    float inv[NMT];
#pragma unroll
    for (int mt = 0; mt < NMT; ++mt) {
        float mx = -INFINITY;
#pragma unroll
        for (int kt = 0; kt < 12; ++kt)
            if (kt >= kt0 && kt < kt1) {
#pragma unroll
                for (int j = 0; j < 4; ++j) { const int key = kt * 16 + fq * 4 + j; const float v = key < nkeys ? s[kt][mt][j] * 0.125f : -INFINITY; s[kt][mt][j] = v; mx = fmaxf(mx, v); }
            }
        mx = fmaxf(mx, __shfl_xor(mx, 16)); mx = fmaxf(mx, __shfl_xor(mx, 32)); mx = fmaxf(mx, sink);
        float sum = 0.f;
#pragma unroll
        for (int kt = 0; kt < 12; ++kt)
            if (kt >= kt0 && kt < kt1) {
#pragma unroll
                for (int j = 0; j < 4; ++j) { const float e = __expf(s[kt][mt][j] - mx); s[kt][mt][j] = e; sum += e; }
            }
        sum += __shfl_xor(sum, 16); sum += __shfl_xor(sum, 32);
        inv[mt] = 1.f / (sum + __expf(sink - mx));
    }
    f32x4 o[4][NMT];
#pragma unroll
    for (int dt = 0; dt < 4; ++dt)
#pragma unroll
        for (int mt = 0; mt < NMT; ++mt) o[dt][mt] = (f32x4){0.f, 0.f, 0.f, 0.f};
#pragma unroll
    for (int kb = 0; kb < 6; ++kb) {
        if (2 * kb >= kt0 && 2 * kb < kt1) {
            bf16x8 pf[NMT];
#pragma unroll
            for (int mt = 0; mt < NMT; ++mt) {
                const f32x4 a = s[2 * kb][mt], b = s[2 * kb + 1][mt];
                u32x4 t; t.x = pk2(a[0], a[1]); t.y = pk2(a[2], a[3]); t.z = pk2(b[0], b[1]); t.w = pk2(b[2], b[3]);
                pf[mt] = __builtin_bit_cast(bf16x8, t);
            }
            bf16x8 vf[4];
#pragma unroll
            for (int dt = 0; dt < 4; ++dt) {
                const u32x2 lo = *(const u32x2*)(VT + (dt * 16 + fr) * 200 + kb * 32 + fq * 4);
                const u32x2 hi = *(const u32x2*)(VT + (dt * 16 + fr) * 200 + kb * 32 + 16 + fq * 4);
                u32x4 t; t.x = lo.x; t.y = lo.y; t.z = hi.x; t.w = hi.y;
                vf[dt] = __builtin_bit_cast(bf16x8, t);
            }
#pragma unroll
            for (int dt = 0; dt < 4; ++dt)
#pragma unroll
                for (int mt = 0; mt < NMT; ++mt) o[dt][mt] = mfma16(vf[dt], pf[mt], o[dt][mt]);
        }
    }
#pragma unroll
    for (int mt = 0; mt < NMT; ++mt)
#pragma unroll
        for (int dt = 0; dt < 4; ++dt) {
            const f32x4 v = o[dt][mt] * inv[mt];
            u32x2 pk; pk.x = pk2(v[0], v[1]); pk.y = pk2(v[2], v[3]);
            *(u32x2*)(qo + (size_t)(mt * 16 + fr) * 512 + dt * 16 + fq * 4) = pk;
        }
}

__device__ __forceinline__ void scatter_vt(bf16_t* VT, int ch, int kk, u32x4 vv) {
    bf16_t* d = VT + (ch * 8) * 200 + kk;
    d[0 * 200] = (bf16_t)(vv.x & 0xffffu); d[1 * 200] = (bf16_t)(vv.x >> 16);
    d[2 * 200] = (bf16_t)(vv.y & 0xffffu); d[3 * 200] = (bf16_t)(vv.y >> 16);
    d[4 * 200] = (bf16_t)(vv.z & 0xffffu); d[5 * 200] = (bf16_t)(vv.z >> 16);
    d[6 * 200] = (bf16_t)(vv.w & 0xffffu); d[7 * 200] = (bf16_t)(vv.w >> 16);
}

__device__ __forceinline__ void attn_prompt_item(KP p, int l, int it, unsigned char* shm) {
    const int tid = tid_(), w = tid >> 6, lane = tid & 63;
    const int b = it >> 6, c = (it >> 1) & 31, kvh = it & 1;
    bf16_t* Ks = (bf16_t*)shm; bf16_t* VT = Ks + 192 * 72;
    bf16_t* Qb = (bf16_t*)(p->ws + W_Q); const bf16_t* Kb = (const bf16_t*)(p->ws + W_K); const bf16_t* Vb = (const bf16_t*)(p->ws + W_V);
    const int kt0 = c >= 2 ? 0 : (2 - c) * 4;
    const int g = w >> 1, q0 = (w & 1) * 32, hq = kvh * 4 + g;
    bf16_t* qo = Qb + ((size_t)b * 2048 + c * 64 + q0) * 512 + hq * 64;
    const float sink = p->sinks[l * 8 + hq];
    __syncthreads();
    {
        u32x4 kv[3], vv[3];
        bf16x8 qf[2][2];
#pragma unroll
        for (int it3 = 0; it3 < 3; ++it3) {
            const int idx = tid + it3 * 512, ch = idx / 192, kk = idx - ch * 192;
            const int kkc = kk >= kt0 * 16 ? kk : kt0 * 16;
            const size_t row = (size_t)b * 2048 + (c - 2) * 64 + kkc;
            kv[it3] = *(const u32x4*)(Kb + row * 128 + kvh * 64 + ch * 8);
            vv[it3] = *(const u32x4*)(Vb + row * 128 + kvh * 64 + ch * 8);
        }
        attn_load_q<2>(qo, lane, qf);
#pragma unroll
        for (int it3 = 0; it3 < 3; ++it3) {
            const int idx = tid + it3 * 512, ch = idx / 192, kk = idx - ch * 192;
            if (kk >= kt0 * 16) { *(u32x4*)(Ks + kk * 72 + ch * 8) = kv[it3]; scatter_vt(VT, ch, kk, vv[it3]); }
        }
        __syncthreads();
        attn_compute<2>(Ks, VT, qo, qf, kt0, 12, 192, sink, lane);
    }
}

__device__ __forceinline__ void attn_sample_item(KP p, int l, int it, unsigned char* shm) {
    const int tid = tid_(), w = tid >> 6, lane = tid & 63;
    const int sb = it >> 1, kvh = it & 1;
    bf16_t* Ks = (bf16_t*)shm; bf16_t* VT = Ks + 192 * 72;
    bf16_t* Qb = (bf16_t*)(p->ws + W_Q); const bf16_t* Kb = (const bf16_t*)(p->ws + W_K); const bf16_t* Vb = (const bf16_t*)(p->ws + W_V);
    __syncthreads();
    for (int idx = tid; idx < 160 * 8; idx += 512) {
        const int ch = idx / 160, kk = idx - ch * 160;
        u32x4 kv, vv;
        if (kk < 128) {
            const size_t o = ((((size_t)l * 32 + sb) * 128 + kk) * 2 + kvh) * 64 + ch * 8;
            const f32x4 k0 = *(const f32x4*)(p->cache_k + o), k1 = *(const f32x4*)(p->cache_k + o + 4);
            const f32x4 v0 = *(const f32x4*)(p->cache_v + o), v1 = *(const f32x4*)(p->cache_v + o + 4);
            kv.x = pk2(k0[0], k0[1]); kv.y = pk2(k0[2], k0[3]); kv.z = pk2(k1[0], k1[1]); kv.w = pk2(k1[2], k1[3]);
            vv.x = pk2(v0[0], v0[1]); vv.y = pk2(v0[2], v0[3]); vv.z = pk2(v1[0], v1[1]); vv.w = pk2(v1[2], v1[3]);
        } else if (kk < 144) {
            const size_t row = (size_t)TP + sb * 16 + (kk - 128);
            kv = *(const u32x4*)(Kb + row * 128 + kvh * 64 + ch * 8);
            vv = *(const u32x4*)(Vb + row * 128 + kvh * 64 + ch * 8);
        } else { kv = zero4(); vv = kv; }
        *(u32x4*)(Ks + kk * 72 + ch * 8) = kv;
        scatter_vt(VT, ch, kk, vv);
    }
    __syncthreads();
    if (w < 4) {
        const int hq = kvh * 4 + w;
        bf16_t* qo = Qb + ((size_t)TP + sb * 16) * 512 + hq * 64;
        bf16x8 qf[1][2];
        attn_load_q<1>(qo, lane, qf);
        attn_compute<1>(Ks, VT, qo, qf, 0, 10, 144, p->sinks[l * 8 + hq], lane);
    }
}

__device__ __forceinline__ void gmlp_item(KP p, int l, bool samp, int bi, int cidx, int g, unsigned char* shm) {
    const int tid = tid_(), w = tid >> 6, lane = tid & 63, fr = lane & 15, fq = lane >> 4;
    bf16_t* Wm = (bf16_t*)shm; bf16_t* VT = Wm + 128 * 136;
    const int L = samp ? 16 : 128;
    const int row0 = samp ? TP + bi * 16 : bi * 2048 + cidx * 128;
    bf16_t* GUb = (bf16_t*)(p->ws + W_GU); const bf16_t* GVb = (const bf16_t*)(p->ws + W_GV);
    __syncthreads();
    if (samp) {
        { const int idx = tid * 8, d = idx >> 5, s = idx & 31; *(u32x4*)(VT + d * 136 + s) = zero4(); }
        if (tid < 128) {
            const int t = tid >> 3, s4 = (tid & 7) * 4;
            f32x4 wv = (f32x4){0.f, 0.f, 0.f, 0.f};
            if (s4 < 16) wv = *(const f32x4*)(p->gm_w_s + ((size_t)(l * 4 + g) * 128 + t) * 128 + s4);
#pragma unroll
            for (int e = 0; e < 4; ++e) if (s4 + e > t) wv[e] = 0.f;
            u32x2 pk; pk.x = pk2(wv[0], wv[1]); pk.y = pk2(wv[2], wv[3]);
            *(u32x2*)(Wm + t * 136 + s4) = pk;
        }
        __syncthreads();
    }
    if (!samp) {
        const int r = tid >> 2, q = tid & 3;
        const bf16_t* src = GVb + (size_t)(row0 + r) * 512 + q * 128;
        u32x4 rv[16];
#pragma unroll
        for (int k = 0; k < 16; ++k) rv[k] = *(const u32x4*)(src + k * 8);
        float s = 0.f, s2 = 0.f;
#pragma unroll
        for (int k = 0; k < 16; ++k) {
            const float a0 = bflo(rv[k].x), a1 = bfhi(rv[k].x), a2 = bflo(rv[k].y), a3 = bfhi(rv[k].y), a4 = bflo(rv[k].z), a5 = bfhi(rv[k].z), a6 = bflo(rv[k].w), a7 = bfhi(rv[k].w);
            s += ((a0 + a1) + (a2 + a3)) + ((a4 + a5) + (a6 + a7));
            s2 += ((a0 * a0 + a1 * a1) + (a2 * a2 + a3 * a3)) + ((a4 * a4 + a5 * a5) + (a6 * a6 + a7 * a7));
        }
        s += __shfl_xor(s, 1); s += __shfl_xor(s, 2); s2 += __shfl_xor(s2, 1); s2 += __shfl_xor(s2, 2);
        float* lgs = (float*)(VT + 128 * 136);
        if (q == 0) {
            const float mean = s * (1.f / 512.f);
            lgs[256 + 2 * r] = mean; lgs[257 + 2 * r] = rsqrtf(fmaxf(s2 * (1.f / 512.f) - mean * mean, 0.f) + EPSF);
        }
        if (tid < 128) lgs[tid] = p->gm_ln_g[l * 512 + g * 128 + tid]; else if (tid < 256) lgs[tid] = p->gm_ln_b[l * 512 + g * 128 + tid - 128];
        const int r2 = tid & 127, dq = tid >> 7;
        u32x4 xv[4];
#pragma unroll
        for (int k = 0; k < 4; ++k) xv[k] = *(const u32x4*)(GVb + (size_t)(row0 + r2) * 512 + g * 128 + dq * 32 + k * 8);
        __syncthreads();
        {
            const float mean = lgs[256 + 2 * r2], rstd = lgs[257 + 2 * r2];
#pragma unroll
            for (int k = 0; k < 4; ++k) {
                const unsigned uu[4] = {xv[k].x, xv[k].y, xv[k].z, xv[k].w};
                const f32x4 g0 = *(const f32x4*)(lgs + dq * 32 + k * 8), g1 = *(const f32x4*)(lgs + dq * 32 + k * 8 + 4);
                const f32x4 b0 = *(const f32x4*)(lgs + 128 + dq * 32 + k * 8), b1 = *(const f32x4*)(lgs + 128 + dq * 32 + k * 8 + 4);
#pragma unroll
                for (int e = 0; e < 8; ++e) {
                    const float v = (e & 1) ? bfhi(uu[e >> 1]) : bflo(uu[e >> 1]);
                    const float gg = e < 4 ? g0[e & 3] : g1[e & 3], bb = e < 4 ? b0[e & 3] : b1[e & 3];
                    VT[(dq * 32 + k * 8 + e) * 136 + r2] = f2bf((v - mean) * rstd * gg + bb);
                }
            }
        }
        {
            f32x4 wv[8];
#pragma unroll
            for (int q = 0; q < 8; ++q) { const int idx = tid + q * 512; wv[q] = *(const f32x4*)(p->gm_w_s + ((size_t)(l * 4 + g) * 128 + (idx >> 5)) * 128 + (idx & 31) * 4); }
#pragma unroll
            for (int q = 0; q < 8; ++q) {
                const int idx = tid + q * 512, t = idx >> 5, s4 = (idx & 31) * 4;
#pragma unroll
                for (int e = 0; e < 4; ++e) if (s4 + e > t) wv[q][e] = 0.f;
                u32x2 pk; pk.x = pk2(wv[q][0], wv[q][1]); pk.y = pk2(wv[q][2], wv[q][3]);
                *(u32x2*)(Wm + t * 136 + s4) = pk;
            }
        }
    } else if (w == 0) {
        u32x4 rawv[16];
#pragma unroll
        for (int r = 0; r < 16; ++r) rawv[r] = *(const u32x4*)(GVb + (size_t)(row0 + r) * 512 + lane * 8);
#pragma unroll
        for (int r = 0; r < 16; ++r) {
            const u32x4 raw = rawv[r];
            float v[8];
            v[0] = bflo(raw.x); v[1] = bfhi(raw.x); v[2] = bflo(raw.y); v[3] = bfhi(raw.y); v[4] = bflo(raw.z); v[5] = bfhi(raw.z); v[6] = bflo(raw.w); v[7] = bfhi(raw.w);
            float s = 0.f;
#pragma unroll
            for (int e = 0; e < 8; ++e) s += v[e];
            const float mean = wave_sum(s) * (1.f / 512.f);
            float s2 = 0.f;
#pragma unroll
            for (int e = 0; e < 8; ++e) { v[e] -= mean; s2 += v[e] * v[e]; }
            const float rstd = rsqrtf(wave_sum(s2) * (1.f / 512.f) + EPSF);
            if (fq == g) {
#pragma unroll
                for (int e = 0; e < 8; ++e) {
                    const int d = fr * 8 + e, col = g * 128 + d;
                    const float vn = v[e] * rstd * p->gm_ln_g[l * 512 + col] + p->gm_ln_b[l * 512 + col];
                    VT[d * 136 + r] = f2bf(vn);
                    p->out[O_GS + ((size_t)(l * 32 + bi) * 16 + r) * 512 + col] = vn;
                }
            }
        }
    }
    bf16_t uv[4][8];
    if (w * 16 < L) {
#pragma unroll
        for (int j = 0; j < 4; ++j)
#pragma unroll
            for (int dt = 0; dt < 8; ++dt) uv[j][dt] = GUb[(size_t)(row0 + w * 16 + fq * 4 + j) * 512 + g * 128 + dt * 16 + fr];
    }
    __syncthreads();
    if (w * 16 < L) {
        f32x4 acc[8];
#pragma unroll
        for (int dt = 0; dt < 8; ++dt) acc[dt] = (f32x4){0.f, 0.f, 0.f, 0.f};
        const int nks = samp ? 1 : ((w * 16 + 15) >> 5) + 1;
#pragma unroll
        for (int ks = 0; ks < 4; ++ks) {
            if (ks < nks) {
                const bf16x8 wf = *(const bf16x8*)(Wm + (w * 16 + fr) * 136 + ks * 32 + fq * 8);
                bf16x8 vf[8];
#pragma unroll
                for (int dt = 0; dt < 8; ++dt) vf[dt] = *(const bf16x8*)(VT + (dt * 16 + fr) * 136 + ks * 32 + fq * 8);
#pragma unroll
                for (int dt = 0; dt < 8; ++dt) acc[dt] = mfma16(wf, vf[dt], acc[dt]);
            }
        }
#pragma unroll
        for (int j = 0; j < 4; ++j) {
            const int t = w * 16 + fq * 4 + j;
            const float bias = p->gm_b_s[(l * 4 + g) * 128 + t];
#pragma unroll
            for (int dt = 0; dt < 8; ++dt) {
                const size_t idx = (size_t)(row0 + t) * 512 + g * 128 + dt * 16 + fr;
                GUb[idx] = f2bf(bf2f(uv[j][dt]) * (acc[dt][j] + bias));
            }
        }
    }
}

constexpr size_t XT_SAMP = (size_t)256 * 1024 * 64, BT_SAMP = (size_t)256 * 256 * 64;
__device__ __forceinline__ void conv_prepass(KP p, int l, unsigned char* shm) {
    const int tid = tid_();
    bf16_t* R = (bf16_t*)shm;
    bf16_t* An = R + 67 * 264;
    bf16_t* At = An + 64 * 264;
    unsigned char* ws = p->ws;
    const bf16_t* Xb = (const bf16_t*)(ws + W_XBC);
    bf16_t* XT = (bf16_t*)(ws + W_H); bf16_t* BCN = (bf16_t*)(ws + W_BCN); bf16_t* BTg = (bf16_t*)(ws + W_BT);
    for (int it = blockIdx.x; it < 288 * 6; it += gridDim.x) {
        const int cidx = it / 6, slab = it - cidx * 6;
        const bool samp = cidx >= 256; const int sb = cidx - 256;
        const int row0 = samp ? TP + sb * 16 : cidx * 64, Lv = samp ? 16 : 64, c0 = slab * 256;
        __syncthreads();
        {
            u32x4 v[5];
#pragma unroll
            for (int q = 0; q < 5; ++q) {
                const int idx = tid + q * 512, r = idx >> 5, ck = idx & 31, rr = r - 3;
                v[q] = zero4();
                if (idx < (Lv + 3) * 32) {
                    if (rr >= 0 || (!samp && (cidx & 31) > 0)) v[q] = *(const u32x4*)(Xb + (size_t)(row0 + rr) * 1536 + c0 + ck * 8);
                    else if (samp) {
                        const float* sp = p->state_conv + (((size_t)l * 32 + sb) * 3 + (3 + rr)) * 1536 + c0 + ck * 8;
                        const f32x4 a = *(const f32x4*)sp, b = *(const f32x4*)(sp + 4);
                        v[q].x = pk2(a[0], a[1]); v[q].y = pk2(a[2], a[3]); v[q].z = pk2(b[0], b[1]); v[q].w = pk2(b[2], b[3]);
                    }
                }
            }
#pragma unroll
            for (int q = 0; q < 5; ++q) {
                const int idx = tid + q * 512;
                if (idx < (Lv + 3) * 32) *(u32x4*)(R + (idx >> 5) * 264 + (idx & 31) * 8) = v[q];
            }
        }
        __syncthreads();
        {
            const int j = tid & 255, tq = tid >> 8;
            if (tq * 32 < Lv) {
                const float w0 = p->conv_w[(l * 4 + 0) * 1536 + c0 + j], w1 = p->conv_w[(l * 4 + 1) * 1536 + c0 + j];
                const float w2 = p->conv_w[(l * 4 + 2) * 1536 + c0 + j], w3 = p->conv_w[(l * 4 + 3) * 1536 + c0 + j], cb = p->conv_b[l * 1536 + c0 + j];
                float x0 = bf2f(R[(tq * 32 + 0) * 264 + j]), x1 = bf2f(R[(tq * 32 + 1) * 264 + j]), x2 = bf2f(R[(tq * 32 + 2) * 264 + j]);
#pragma unroll
                for (int e = 0; e < 32; e += 2) {
                    const int t = tq * 32 + e;
                    if (t < Lv) {
                        const float x3 = bf2f(R[(t + 3) * 264 + j]), x4 = bf2f(R[(t + 4) * 264 + j]);
                        const float o0 = siluf_(cb + w0 * x0 + w1 * x1 + w2 * x2 + w3 * x3);
                        const float o1 = siluf_(cb + w0 * x1 + w1 * x2 + w2 * x3 + w3 * x4);
                        x0 = x2; x1 = x3; x2 = x4;
                        const unsigned pk = pk2(o0, o1);
                        An[t * 264 + j] = (bf16_t)(pk & 0xffffu); An[(t + 1) * 264 + j] = (bf16_t)(pk >> 16);
                        *(unsigned*)(At + j * 66 + t) = pk;
                    }
                }
            }
        }
        __syncthreads();
        if (slab >= 4) {
            for (int idx = tid; idx < Lv * 32; idx += 512) {
                const int t = idx >> 5, ck = idx & 31;
                *(u32x4*)(BCN + (size_t)(row0 + t) * 512 + (slab - 4) * 256 + ck * 8) = *(const u32x4*)(An + t * 264 + ck * 8);
            }
        }
        if (slab < 5) {
            const int sh = samp ? 1 : 3;
            bf16_t* dst;
            if (slab < 4) dst = samp ? XT + XT_SAMP + ((size_t)sb * 1024 + slab * 256) * 16 : XT + ((size_t)cidx * 1024 + slab * 256) * 64;
            else dst = samp ? BTg + BT_SAMP + (size_t)sb * 256 * 16 : BTg + (size_t)cidx * 256 * 64;
            for (int idx = tid; idx < (256 << sh); idx += 512) {
                const int j = idx >> sh, tc = idx & ((1 << sh) - 1);
                const unsigned* src = (const unsigned*)(At + j * 66 + tc * 8);
                u32x4 v; v.x = src[0]; v.y = src[1]; v.z = src[2]; v.w = src[3];
                *(u32x4*)(dst + (size_t)j * Lv + tc * 8) = v;
            }
        }
    }
    __syncthreads();
}

__device__ __forceinline__ void ssd_item(KP p, int l, bool samp, int bi, int h, unsigned char* shm) {
    const int tid = tid_(), w = tid >> 6, lane = tid & 63, fr = lane & 15, fq = lane >> 4;
    bf16_t* xT = (bf16_t*)shm;
    bf16_t* xwT = xT + 64 * 72;
    bf16_t* Bs = xwT + 64 * 72;
    bf16_t* BT = Bs + 64 * 136;
    bf16_t* Cs = BT + 128 * 72;
    bf16_t* Ms = Cs + 64 * 136;
    bf16_t* hb = Ms + 64 * 72;
    float* cumv = (float*)(hb + 64 * 136);
    float* dtv = cumv + 64;
    float* scl = dtv + 64;
    const int gr = h >> 3, nch = samp ? 1 : 32, Lv = samp ? 16 : 64;
    const int rowbase = samp ? TP + bi * 16 : bi * 2048;
    const float a_h = -__expf(p->a_log[l * 16 + h]), Dh = p->d_skip[l * 16 + h];
    unsigned char* ws = p->ws;
    const float* DT = (const float*)(ws + W_DT);
    const bf16_t* XTg = (const bf16_t*)(ws + W_H); const bf16_t* BCN = (const bf16_t*)(ws + W_BCN); const bf16_t* BTg = (const bf16_t*)(ws + W_BT);
    bf16_t* Zb = (bf16_t*)(ws + W_Z);
    float* ROWSS = (float*)(ws + W_ROWSS);
    const int pts = w >> 1, nt0 = (w & 1) * 4;
    f32x4 hacc[4];
    float* stout = samp ? p->out + O_SS + (((size_t)l * 32 + bi) * 16 + h) * 8192 : p->out + O_SP + (((size_t)l * 8 + bi) * 16 + h) * 8192;
    __syncthreads();
#pragma unroll
    for (int i = 0; i < 4; ++i) {
#pragma unroll
        for (int j = 0; j < 4; ++j) {
            const int pr = pts * 16 + fq * 4 + j, n = (nt0 + i) * 16 + fr;
            float v = 0.f;
            if (samp) v = p->state_ssm[((((size_t)l * 32 + bi) * 16 + h) * 64 + pr) * 128 + n];
            hacc[i][j] = v;
            hb[pr * 136 + n] = f2bf(v);
        }
    }
    const int ttile = w >> 1, half = w & 1;
    const int xp = tid >> 3, xc = tid & 7;

    u32x4 lx, lb[2], lc[2], lbt[2];
    float dcur = 0.f;
    auto load_ops = [&](int chx) {
        const int t0x = rowbase + chx * 64;
        lx = zero4();
        if (!samp) {
            const size_t cidx = (size_t)bi * 32 + chx;
            lx = *(const u32x4*)(XTg + (cidx * 1024 + h * 64 + xp) * 64 + xc * 8);
#pragma unroll
            for (int q = 0; q < 2; ++q) {
                const int idx = tid + q * 512;
                const bf16_t* rowp = BCN + (size_t)(t0x + (idx >> 4)) * 512 + gr * 128 + (idx & 15) * 8;
                lb[q] = *(const u32x4*)rowp; lc[q] = *(const u32x4*)(rowp + 256);
                lbt[q] = *(const u32x4*)(BTg + (cidx * 256 + gr * 128 + (idx >> 3)) * 64 + (idx & 7) * 8);
            }
        } else {
            if (xc < 2) lx = *(const u32x4*)(XTg + XT_SAMP + ((size_t)bi * 1024 + h * 64 + xp) * 16 + xc * 8);
#pragma unroll
            for (int q = 0; q < 2; ++q) {
                const int idx = tid + q * 512;
                lb[q] = zero4(); lc[q] = lb[q]; lbt[q] = lb[q];
                if ((idx >> 4) < 16) {
                    const bf16_t* rowp = BCN + (size_t)(t0x + (idx >> 4)) * 512 + gr * 128 + (idx & 15) * 8;
                    lb[q] = *(const u32x4*)rowp; lc[q] = *(const u32x4*)(rowp + 256);
                }
                if ((idx & 7) < 2) lbt[q] = *(const u32x4*)(BTg + BT_SAMP + ((size_t)bi * 256 + gr * 128 + (idx >> 3)) * 16 + (idx & 7) * 8);
            }
        }
        dcur = 0.f;
        if (w == 0 && lane < Lv) dcur = DT[(size_t)(t0x + lane) * 16 + h];
    };
    load_ops(0);

    for (int ch = 0; ch < nch; ++ch) {
        const int t0 = rowbase + ch * 64;
        bf16_t zr[8];
#pragma unroll
        for (int j = 0; j < 4; ++j)
#pragma unroll
            for (int i = 0; i < 2; ++i) {
                int t = ttile * 16 + fq * 4 + j; t = t < Lv ? t : Lv - 1;
                zr[j * 2 + i] = Zb[(size_t)(t0 + t) * 1024 + h * 64 + (half * 2 + i) * 16 + fr];
            }
        __syncthreads();
        if (w == 0) {
            const float c = wave_scan(dcur * a_h);
            const float c63 = __int_as_float(__builtin_amdgcn_readlane(__float_as_int(c), 63));
            cumv[lane] = c; dtv[lane] = dcur; scl[lane] = dcur * __expf(c63 - c);
        }
        *(u32x4*)(xT + xp * 72 + xc * 8) = lx;
#pragma unroll
        for (int q = 0; q < 2; ++q) {
            const int idx = tid + q * 512;
            *(u32x4*)(Bs + (idx >> 4) * 136 + (idx & 15) * 8) = lb[q];
            *(u32x4*)(Cs + (idx >> 4) * 136 + (idx & 15) * 8) = lc[q];
            *(u32x4*)(BT + (idx >> 3) * 72 + (idx & 7) * 8) = lbt[q];
        }
        __syncthreads();
        {
            const f32x4 s0 = *(const f32x4*)(scl + xc * 8), s1 = *(const f32x4*)(scl + xc * 8 + 4);
            u32x4 o;
            o.x = pk2(bflo(lx.x) * s0[0], bfhi(lx.x) * s0[1]); o.y = pk2(bflo(lx.y) * s0[2], bfhi(lx.y) * s0[3]);
            o.z = pk2(bflo(lx.z) * s1[0], bfhi(lx.z) * s1[1]); o.w = pk2(bflo(lx.w) * s1[2], bfhi(lx.w) * s1[3]);
            *(u32x4*)(xwT + xp * 72 + xc * 8) = o;
        }
        if (ch + 1 < nch) load_ops(ch + 1);
        f32x4 cb[2], yacc[2];
#pragma unroll
        for (int i = 0; i < 2; ++i) { cb[i] = (f32x4){0.f, 0.f, 0.f, 0.f}; yacc[i] = (f32x4){0.f, 0.f, 0.f, 0.f}; }
        {
            bf16x8 cf[4], bfr[4][2], hf[4][2];
#pragma unroll
            for (int ks = 0; ks < 4; ++ks) {
                cf[ks] = *(const bf16x8*)(Cs + (ttile * 16 + fr) * 136 + ks * 32 + fq * 8);
#pragma unroll
                for (int i = 0; i < 2; ++i) {
                    bfr[ks][i] = *(const bf16x8*)(Bs + ((half * 2 + i) * 16 + fr) * 136 + ks * 32 + fq * 8);
                    hf[ks][i] = *(const bf16x8*)(hb + ((half * 2 + i) * 16 + fr) * 136 + ks * 32 + fq * 8);
                }
            }
#pragma unroll
            for (int ks = 0; ks < 4; ++ks)
#pragma unroll
                for (int i = 0; i < 2; ++i) { cb[i] = mfma16(cf[ks], bfr[ks][i], cb[i]); yacc[i] = mfma16(cf[ks], hf[ks][i], yacc[i]); }
        }
#pragma unroll
        for (int j = 0; j < 4; ++j) {
            const int t = ttile * 16 + fq * 4 + j;
            const float ct = cumv[t];
            const float et = __expf(ct);
#pragma unroll
            for (int i = 0; i < 2; ++i) {
                const int s = (half * 2 + i) * 16 + fr;
                const float mv = (s <= t) ? cb[i][j] * __expf(ct - cumv[s]) * dtv[s] : 0.f;
                Ms[t * 72 + s] = f2bf(mv);
                yacc[i][j] *= et;
            }
        }
        __syncthreads();
        bf16x8 mf[2], xf[2][2], xwf[2], btf[2][4];
#pragma unroll
        for (int ks = 0; ks < 2; ++ks) {
            mf[ks] = *(const bf16x8*)(Ms + (ttile * 16 + fr) * 72 + ks * 32 + fq * 8);
#pragma unroll
            for (int i = 0; i < 2; ++i) xf[ks][i] = *(const bf16x8*)(xT + ((half * 2 + i) * 16 + fr) * 72 + ks * 32 + fq * 8);
            xwf[ks] = *(const bf16x8*)(xwT + (pts * 16 + fr) * 72 + ks * 32 + fq * 8);
#pragma unroll
            for (int i = 0; i < 4; ++i) btf[ks][i] = *(const bf16x8*)(BT + ((nt0 + i) * 16 + fr) * 72 + ks * 32 + fq * 8);
        }
#pragma unroll
        for (int ks = 0; ks < 2; ++ks)
#pragma unroll
            for (int i = 0; i < 2; ++i) yacc[i] = mfma16(mf[ks], xf[ks][i], yacc[i]);
        {
            float ssq[4] = {0.f, 0.f, 0.f, 0.f};
#pragma unroll
            for (int j = 0; j < 4; ++j) {
                const int t = ttile * 16 + fq * 4 + j;
                if (!samp || t < Lv) {
#pragma unroll
                    for (int i = 0; i < 2; ++i) {
                        const int pc = (half * 2 + i) * 16 + fr;
                        const float xv = bf2f(xT[pc * 72 + t]);
                        const float y = yacc[i][j] + Dh * xv;
                        const size_t zi = (size_t)(t0 + t) * 1024 + h * 64 + pc;
                        const float uu = y * siluf_(bf2f(zr[j * 2 + i]));
                        Zb[zi] = f2bf(uu);
                        ssq[j] += uu * uu;
                    }
                }
            }
#pragma unroll
            for (int j = 0; j < 4; ++j) {
                const float s = row16_sum(ssq[j]);
                const int t = ttile * 16 + fq * 4 + j;
                if (fr == 0 && (!samp || t < Lv)) ROWSS[(size_t)(t0 + t) * 32 + h * 2 + half] = s;
            }
        }
        const float dec = __expf(cumv[63]);
#pragma unroll
        for (int i = 0; i < 4; ++i) hacc[i] *= dec;
#pragma unroll
        for (int ks = 0; ks < 2; ++ks)
#pragma unroll
            for (int i = 0; i < 4; ++i) hacc[i] = mfma16(xwf[ks], btf[ks][i], hacc[i]);
#pragma unroll
        for (int i = 0; i < 4; ++i)
#pragma unroll
            for (int j = 0; j < 4; ++j) hb[(pts * 16 + fq * 4 + j) * 136 + (nt0 + i) * 16 + fr] = f2bf(hacc[i][j]);
    }
#pragma unroll
    for (int i = 0; i < 4; ++i)
#pragma unroll
        for (int j = 0; j < 4; ++j) stout[(pts * 16 + fq * 4 + j) * 128 + (nt0 + i) * 16 + fr] = hacc[i][j];
}

constexpr int N_OTHER = 512 + 512 + 512 + 64 + 128;
__device__ __forceinline__ void phase_mixers(int l, unsigned char* shm) {
    int* s_item = (int*)(shm + 131072);
    for (int it = blockIdx.x; it < 128; it += gridDim.x) ssd_item(kparams(), l, false, it >> 4, it & 15, shm);
    unsigned nxt_ticket = 0u;
    if (threadIdx.x == 0) nxt_ticket = atomicAdd((unsigned*)(kparams()->ws + W_CNT) + l, 1u);
    for (;;) {
        __syncthreads();
        if (threadIdx.x == 0) *s_item = (int)nxt_ticket;
        __syncthreads();
        int j = *s_item;
        if (j >= N_OTHER) break;
        const KP p = kparams();
        if (threadIdx.x == 0) nxt_ticket = atomicAdd((unsigned*)(p->ws + W_CNT) + l, 1u);
        if (j < 512) { attn_prompt_item(p, l, j, shm); continue; } j -= 512;
        if (j < 512) { gmlp_item(p, l, false, j >> 6, (j >> 2) & 15, j & 3, shm); continue; } j -= 512;
        if (j < 512) { ssd_item(p, l, true, j >> 4, j & 15, shm); continue; } j -= 512;
        if (j < 64) { attn_sample_item(p, l, j, shm); continue; } j -= 64;
        gmlp_item(p, l, true, j >> 2, 0, j & 3, shm);
    }
}

#define XB_TMO      128
#define XB_XCNT(j)  (256  + 64 * (j))
#define XB_XSUB(j)  (1280 + 64 * (j))
#define XB_XGEN(j)  (2304 + 64 * (j))
#define XB_TOP      3328
#define XB_TOPGEN   3392
#define XCD_BAR_WORDS 3456
#define XB_SPIN_CAP (1u << 18)
__device__ __forceinline__ unsigned xb_ld(unsigned* p)              { return __hip_atomic_load(p, __ATOMIC_RELAXED, __HIP_MEMORY_SCOPE_AGENT); }
__device__ __forceinline__ unsigned xb_add(unsigned* p, unsigned v) { return __hip_atomic_fetch_add(p, v, __ATOMIC_RELAXED, __HIP_MEMORY_SCOPE_AGENT); }
__device__ __forceinline__ unsigned xb_xcc_id() { return (unsigned)__builtin_amdgcn_s_getreg((3 << 11) | 20) & 0xFu; }
#define XB_SPIN(cond, bar) do { unsigned _sp = 0; while (cond) { __builtin_amdgcn_s_sleep(1); \
    if ((++_sp & 255u) == 0u) { if (xb_ld(&(bar)[XB_TMO])) break; if (_sp > XB_SPIN_CAP) { atomicAdd(&(bar)[XB_TMO], 1u); break; } } } } while (0)
struct XcdBarrier { unsigned* bar; unsigned x; volatile LAS unsigned* st; };
__device__ __forceinline__ XcdBarrier xcd_barrier_post(unsigned* bar, volatile LAS unsigned* st) {
    XcdBarrier b; b.bar = bar; b.x = xb_xcc_id(); b.st = st;
    if (threadIdx.x == 0) (void)xb_add(&bar[XB_XCNT(b.x)], 1u);
    return b;
}
__device__ __forceinline__ void xcd_barrier_complete(unsigned* bar, unsigned x, unsigned& nloc, unsigned& nx) {
    const unsigned G = gridDim.x * gridDim.y * gridDim.z;
    unsigned sum, cnt, mine, sp = 0u;
    for (;;) {
        sum = 0u; cnt = 0u; mine = 0u;
#pragma unroll
        for (unsigned j = 0; j < 16; ++j) { const unsigned c = xb_ld(&bar[XB_XCNT(j)]); sum += c; cnt += (c > 0u) ? 1u : 0u; mine = (j == x) ? c : mine; }
        if (sum == G) break;
        __builtin_amdgcn_s_sleep(1);
        if ((++sp & 255u) == 0u) { if (xb_ld(&bar[XB_TMO])) break; if (sp > XB_SPIN_CAP) { atomicAdd(&bar[XB_TMO], 1u); break; } }
    }
    nloc = mine > 0u ? mine : 1u; nx = cnt > 0u ? cnt : 1u;
}
__device__ __forceinline__ void xcd_barrier(const XcdBarrier& b) {
    asm volatile("s_waitcnt vmcnt(0)" ::: "memory");
    __syncthreads();
    if (threadIdx.x == 0) {
        unsigned* bar = b.bar;
        __builtin_amdgcn_s_waitcnt(0);
        unsigned nloc = b.st[0], nx = b.st[1];
        if (nloc == 0u) { xcd_barrier_complete(bar, b.x, nloc, nx); b.st[0] = nloc; b.st[1] = nx; }
        const unsigned old = xb_add(&bar[XB_XSUB(b.x)], 1u);
        const unsigned gen = old / nloc;
        if (old + 1u == (gen + 1u) * nloc) {
            __builtin_amdgcn_fence(__ATOMIC_RELEASE, "agent");
            asm volatile("s_waitcnt vmcnt(0)" ::: "memory");
            const unsigned og = xb_add(&bar[XB_TOP], 1u);
            const unsigned tg = og / nx;
            if (og + 1u == (tg + 1u) * nx) xb_add(&bar[XB_TOPGEN], 1u);
            else XB_SPIN(xb_ld(&bar[XB_TOPGEN]) == tg, bar);
            __builtin_amdgcn_fence(__ATOMIC_ACQUIRE, "agent");
            xb_add(&bar[XB_XGEN(b.x)], 1u);
            asm volatile("s_waitcnt vmcnt(0)" ::: "memory");
        } else {
            XB_SPIN(xb_ld(&bar[XB_XGEN(b.x)]) == gen, bar);
            __builtin_amdgcn_fence(__ATOMIC_ACQUIRE, "agent");
            asm volatile("s_waitcnt vmcnt(0)" ::: "memory");
        }
    }
    __syncthreads();
}
__device__ __forceinline__ void grid_seam(unsigned char* shm) {
    XcdBarrier b; b.bar = (unsigned*)(kparams()->ws + W_BAR); b.x = xb_xcc_id(); b.st = (volatile LAS unsigned*)(LAS unsigned char*)(shm + 131072 + 16);
    xcd_barrier(b);
}

__global__ void __launch_bounds__(512, 2) fwd_kernel(Params p_unused) {
    extern __shared__ __attribute__((aligned(16))) unsigned char shm[];
    cg::grid_group grid = cg::this_grid();
    LAS unsigned char* lds = (LAS unsigned char*)shm;
    const int tid = tid_();
#if PROBE_MASK
    unsigned long long probe_acc = 0;
#endif

    {
        if (tid == 0) { volatile LAS unsigned* st = (volatile LAS unsigned*)(LAS unsigned char*)(shm + 131072 + 16); st[0] = 0u; st[1] = 0u; }
        __syncthreads();
        const KP p = kparams();
        (void)xcd_barrier_post((unsigned*)(p->ws + W_BAR), (volatile LAS unsigned*)(LAS unsigned char*)(shm + 131072 + 16));
        if (p->ws == nullptr) grid.sync();
    }
    PH_BEGIN(0);
    phase_mod(kparams(), (float*)shm);
    {
        const KP p = kparams();
        unsigned char* ws = p->ws;
        f32x2* rope = (f32x2*)(ws + W_ROPE);
        for (int idx = blockIdx.x * 512 + tid_(); idx < 2064 * 8; idx += gridDim.x * 512) {
            const int pi = idx >> 3, j = idx & 7;
            const float pos = (float)(pi < 2048 ? pi : 4096 + (pi - 2048));
            const float invf = exp2f(-(float)j * 0.125f * 18.931568569324174f);
            const float ang = pos * invf;
            const double a = (double)ang;
            const double kk = rint(a * 0.15915494309189535);
            const float r = (float)(a - kk * 6.283185307179586);
            rope[idx] = (f32x2){__cosf(r), __sinf(r)};
        }
        if (blockIdx.x == 0 && tid < 64) ((unsigned*)(ws + W_CNT))[tid] = 0u;
    }
    convert_weights(kparams(), 0, (float*)shm);
    grid_seam(shm);
    PH_END(0);

#pragma unroll 1
    for (int l = 0; l < 2; ++l) {
        PH_BEGIN(1);
        {
            const KP p = kparams();
            float* X = p->out + O_Y;
            phase_norm(p, l, l == 0 ? p->x_prompt : X, l == 0 ? p->x_sample : X + (size_t)TP * 1024, p->g_mix + l * 1024, 0);
        }
        if (l == 1) {
            convert_weights(kparams(), 1, (float*)shm);
        }
        grid_seam(shm);
        PH_END(1);
        PH_BEGIN(2);
        {
            const KP p = kparams();
            const bf16_t* H = (const bf16_t*)(p->ws + W_H); const bf16_t* WT = (const bf16_t*)(p->ws + W_WT);
            pg8::StaticOrder S; S.init(T, NINP, (int)gridDim.x, (int)blockIdx.x);
            EpiIn E; E.l = l; E.pp = p;
            pg8::gemm_phase(lds, pg8::Gemm{H, WT + WT_IN, T, NINP, 1024}, S, E);
        }
        grid_seam(shm);
        PH_END(2);
        PH_BEGIN(3);
        conv_prepass(kparams(), l, shm);
        grid_seam(shm);
        phase_mixers(l, shm);
        grid_seam(shm);
        PH_END(3);
        PH_BEGIN(4);
#pragma unroll 1
        for (int b = 0; b < 3; ++b) {
            const KP p = kparams();
            unsigned char* ws = p->ws;
            const bf16_t* WT = (const bf16_t*)(ws + W_WT);
            const bf16_t* A = (const bf16_t*)(ws + (b == 0 ? W_Q : (b == 1 ? W_Z : W_GU)));
            const bf16_t* Bt = WT + (b == 0 ? WT_AO : (b == 1 ? WT_SO : WT_GO));
            const int K = b == 1 ? 1024 : 512;
            EpiRC<FMergeT<true>, 4> E; E.f.b = b; E.f.G8 = ws + W_G8; E.f.rowss = (const float*)(ws + W_ROWSS); E.f.MG = (bf16_t*)(ws + W_H);
            pg8::StaticOrder S; S.init(TP, 1024, (int)gridDim.x, (int)blockIdx.x);
            E.f.tile_rstd = (const float*)(shm + 131072 + 512); E.f.tile_row0 = 0;
            if (b == 1) {
                pg8::Unit u0;
                if (S.next(0, u0)) {
                    E.f.tile_row0 = u0.pm * 256;
                    const int t2 = tid_();
                    if (t2 < 256) {
                        const f32x4* pp = (const f32x4*)((const float*)(ws + W_ROWSS) + (size_t)(u0.pm * 256 + t2) * 32);
                        const f32x4 t = ((pp[0] + pp[1]) + (pp[2] + pp[3])) + ((pp[4] + pp[5]) + (pp[6] + pp[7]));
                        ((float*)(shm + 131072 + 512))[t2] = rsqrtf(((t[0] + t[1]) + (t[2] + t[3])) * (1.f / 1024.f) + EPSF);
                    }
                }
                __syncthreads();
            }
            pg8::gemm_phase(lds, pg8::Gemm{A, Bt, TP, 1024, K}, S, E);
            FMergeT<false> fs2; fs2.b = b; fs2.G8 = E.f.G8; fs2.rowss = E.f.rowss; fs2.MG = E.f.MG; fs2.tile_rstd = nullptr; fs2.tile_row0 = 0;
            if (K == 512) skinny_gemm<64>(shm, A + (size_t)TP * K, Bt, 1024, fs2); else skinny_gemm<128>(shm, A + (size_t)TP * K, Bt, 1024, fs2);
        }
        grid_seam(shm);
        PH_END(4);
#pragma unroll 1
        for (int s2 = 0; s2 < 2; ++s2) {
            PH_BEGIN(5);
            {
                const KP p = kparams();
                unsigned char* ws = p->ws;
                float* X = p->out + O_Y;
                const bf16_t* WT = (const bf16_t*)(ws + W_WT);
                const bf16_t* A = (const bf16_t*)(ws + (s2 == 0 ? W_H : W_FH));
                const bf16_t* Bt = WT + (s2 == 0 ? WT_OUT : WT_F2);
                const int K = s2 == 0 ? 1024 : 4096;
                const bool first = (l == 0 && s2 == 0);
                FResid fs; fs.srcP = first ? p->x_prompt : X; fs.srcS = first ? p->x_sample : X + (size_t)TP * 1024; fs.X = X;
                fs.modg = (const float*)(ws + W_MOD) + (size_t)l * 40 * 6144 + (s2 == 0 ? 2 : 5) * 1024;
                EpiResidP E; E.src = fs.srcP; E.X = X; E.modg = fs.modg;
                pg8::StaticOrder S; S.init(TP, 1024, (int)gridDim.x, (int)blockIdx.x);
                pg8::gemm_phase(lds, pg8::Gemm{A, Bt, TP, 1024, K}, S, E);
                if (s2 == 0) skinny_gemm<128>(shm, A + (size_t)TP * K, Bt, 1024, fs); else skinny_gemm<512>(shm, A + (size_t)TP * K, Bt, 1024, fs);
            }
            grid_seam(shm);
            PH_END(5);
            if (s2 == 0) {
                PH_BEGIN(6);
                {
                    const KP p = kparams();
                    float* X = p->out + O_Y;
                    phase_norm(p, l, X, X + (size_t)TP * 1024, p->g_ff + l * 1024, 3);
                }
                grid_seam(shm);
                PH_END(6);
                PH_BEGIN(7);
                {
                    const KP p = kparams();
                    unsigned char* ws = p->ws;
                    const bf16_t* H = (const bf16_t*)(ws + W_H); const bf16_t* WT = (const bf16_t*)(ws + W_WT);
                    EpiRC<FRelu2> E; E.f.FH = (bf16_t*)(ws + W_FH);
                    pg8::StaticOrder S; S.init(TP, 4096, (int)gridDim.x, (int)blockIdx.x);
                    pg8::gemm_phase(lds, pg8::Gemm{H, WT + WT_F1, TP, 4096, 1024}, S, E);
                    skinny_gemm<128>(shm, H + (size_t)TP * 1024, WT + WT_F1, 4096, E.f);
                }
                grid_seam(shm);
                PH_END(7);
            }
        }
    }
    {
        const KP p = kparams();
        float* X = p->out + O_Y;
        const float* gf = p->g_final;
        const int tidf = tid_(), lane = tidf & 63, gw = blockIdx.x * 8 + (tidf >> 6), ngw = gridDim.x * 8;
        for (int row = gw; row < T; row += ngw) {
            f32x4* xr = (f32x4*)(X + (size_t)row * 1024);
            f32x4 v[4]; float ss = 0.f;
#pragma unroll
            for (int j = 0; j < 4; ++j) { v[j] = xr[lane + 64 * j]; ss += v[j][0] * v[j][0] + v[j][1] * v[j][1] + v[j][2] * v[j][2] + v[j][3] * v[j][3]; }
            ss = wave_sum(ss);
            const float rstd = rsqrtf(ss * (1.f / 1024.f) + EPSF);
#pragma unroll
            for (int j = 0; j < 4; ++j) { const f32x4 g = ((const f32x4*)gf)[lane + 64 * j]; xr[lane + 64 * j] = v[j] * rstd * g; }
        }
    }
#if PROBE_MASK
    { const unsigned long long t0 = wall_clock64(); while (wall_clock64() - t0 < probe_acc) __builtin_amdgcn_s_sleep(8); }
#endif
}

extern "C" void kernel_launch(void* const* d_in, const int* in_sizes, int n_in, void* d_out, int out_size, void* d_ws, size_t ws_size, hipStream_t stream) {
    static int grid_blocks = 0;
    if (!grid_blocks) {
        int dev = 0, cus = 0, per_cu = 0;
        hipGetDevice(&dev);
        hipDeviceGetAttribute(&cus, hipDeviceAttributeMultiprocessorCount, dev);
        hipFuncSetAttribute((const void*)fwd_kernel, hipFuncAttributeMaxDynamicSharedMemorySize, LDS_BYTES);
        hipOccupancyMaxActiveBlocksPerMultiprocessor(&per_cu, (const void*)fwd_kernel, 512, LDS_BYTES);
        if (per_cu < 1) per_cu = 1;
        grid_blocks = cus * per_cu;
        if (ws_size < W_END) fprintf(stderr, "kernel_launch: workspace too small: need %zu, got %zu\n", (size_t)W_END, ws_size);
    }
    Params p{};
    const float** fp = (const float**)&p;
    for (int i = 0; i < 31; ++i) fp[i] = (const float*)d_in[i];
    p.out = (float*)d_out; p.ws = (unsigned char*)d_ws;
    (void)hipMemsetAsync((unsigned char*)d_ws + W_BAR, 0, XCD_BAR_WORDS * 4, stream);
    void* args[] = {&p};
    hipError_t e = hipLaunchCooperativeKernel((const void*)fwd_kernel, dim3(grid_blocks), dim3(512), args, LDS_BYTES, stream);
    if (e != hipSuccess) fprintf(stderr, "cooperative launch failed: %s (grid %d)\n", hipGetErrorString(e), grid_blocks);
}
```

```cpp
#include <hip/hip_runtime.h>
#include <hip/hip_cooperative_groups.h>
#include <cstdio>
namespace cg = cooperative_groups;

#define LAS __attribute__((address_space(3)))
typedef unsigned short bf16_t;
typedef short bf16x8 __attribute__((ext_vector_type(8)));
typedef float f32x4 __attribute__((ext_vector_type(4)));
typedef float f32x2 __attribute__((ext_vector_type(2)));
typedef unsigned u32x2 __attribute__((ext_vector_type(2)));
typedef unsigned u32x4 __attribute__((ext_vector_type(4)));

constexpr int DM = 1024, TP = 16384, TS = 512, T = TP + TS;
constexpr int NINP = 7680;
constexpr float EPSF = 1e-6f;

constexpr size_t O_Y = 0;
constexpr size_t O_KP = (size_t)T * DM;
constexpr size_t O_VP = O_KP + 2 * 8 * 128 * 128;
constexpr size_t O_SP = O_VP + 2 * 8 * 128 * 128;
constexpr size_t O_CP = O_SP + (size_t)2 * 8 * 16 * 64 * 128;
constexpr size_t O_KS = O_CP + 2 * 8 * 3 * 1536;
constexpr size_t O_VS = O_KS + 2 * 32 * 16 * 128;
constexpr size_t O_SS = O_VS + 2 * 32 * 16 * 128;
constexpr size_t O_CS = O_SS + (size_t)2 * 32 * 16 * 64 * 128;
constexpr size_t O_GS = O_CS + 2 * 32 * 3 * 1536;

constexpr size_t WT_IN = 0;
constexpr size_t WT_AO = WT_IN + (size_t)NINP * 1024;
constexpr size_t WT_SO = WT_AO + 1024 * 512;
constexpr size_t WT_GO = WT_SO + 1024 * 1024;
constexpr size_t WT_OUT = WT_GO + 1024 * 512;
constexpr size_t WT_F1 = WT_OUT + 1024 * 1024;
constexpr size_t WT_F2 = WT_F1 + (size_t)4096 * 1024;
constexpr size_t WT_END = WT_F2 + (size_t)1024 * 4096;

constexpr size_t al256(size_t x) { return (x + 255) & ~(size_t)255; }
constexpr size_t W_WT = 0;
constexpr size_t W_MOD = al256(W_WT + WT_END * 2);
constexpr size_t W_ROPE = al256(W_MOD + (size_t)2 * 40 * 6144 * 4);
constexpr size_t W_ROWSS = al256(W_ROPE + (size_t)2064 * 8 * 8);
constexpr size_t W_CNT = al256(W_ROWSS + (size_t)T * 32 * 4);
constexpr size_t W_BAR = al256(W_CNT + 256);
constexpr size_t W_DT = al256(W_BAR + 3456 * 4);
constexpr size_t W_H = al256(W_DT + (size_t)T * 16 * 4);
constexpr size_t W_Q = al256(W_H + (size_t)T * 1024 * 2);
constexpr size_t W_K = W_Q + (size_t)T * 512 * 2;
constexpr size_t W_V = W_K + (size_t)T * 128 * 2;
constexpr size_t W_Z = W_V + (size_t)T * 128 * 2;
constexpr size_t W_XBC = W_Z + (size_t)T * 1024 * 2;
constexpr size_t W_GU = W_XBC + (size_t)T * 1536 * 2;
constexpr size_t W_GV = W_GU + (size_t)T * 512 * 2;
constexpr size_t W_PAEND = W_GV + (size_t)T * 512 * 2;
constexpr size_t W_FH = W_Q;
constexpr size_t W_G8 = al256(W_PAEND);
constexpr size_t W_BCN = al256(W_G8 + (size_t)T * 3072);
constexpr size_t W_BT = al256(W_BCN + (size_t)T * 512 * 2);
constexpr size_t W_END = W_BT + ((size_t)256 * 256 * 64 + (size_t)32 * 256 * 16) * 2;
static_assert((size_t)T * 4096 * 2 <= W_PAEND - W_Q, "FH alias");

constexpr int LDS_BYTES = 131072 + 2048;
#ifndef PROBE_MASK
#define PROBE_MASK 0
#endif
#if PROBE_MASK
#define PH_BEGIN(id) const unsigned long long _t_##id = wall_clock64()
#define PH_END(id) do { if ((PROBE_MASK >> (id)) & 1) probe_acc += wall_clock64() - _t_##id; } while (0)
#else
#define PH_BEGIN(id) do {} while (0)
#define PH_END(id) do {} while (0)
#endif

struct Params {
    const float *x_prompt, *x_sample, *c_prompt, *c_sample, *cache_k, *cache_v, *state_ssm, *state_conv;
    const float *w_ada, *b_ada, *g_mix, *w_in, *sinks, *conv_w, *conv_b, *dt_bias, *a_log, *d_skip, *ssm_norm_w;
    const float *gm_ln_g, *gm_ln_b, *gm_w_s, *gm_b_s, *w_attn_o, *w_ssm_o, *w_gm_o, *w_out, *g_ff, *w_ff1, *w_ff2, *g_final;
    float* out;
    unsigned char* ws;
};

typedef const Params __attribute__((address_space(4)))* KP;
__device__ __forceinline__ KP kparams() { KP q = (KP)__builtin_amdgcn_kernarg_segment_ptr(); asm volatile("" : "+s"(q)); return q; }

__device__ __forceinline__ int tid_() { int t = threadIdx.x; asm volatile("" : "+v"(t)); return t; }
__device__ __forceinline__ unsigned pk2(float lo, float hi) { unsigned r; asm("v_cvt_pk_bf16_f32 %0, %1, %2" : "=v"(r) : "v"(lo), "v"(hi)); return r; }
__device__ __forceinline__ bf16_t f2bf(float f) { return (bf16_t)(pk2(f, 0.f) & 0xffffu); }
__device__ __forceinline__ float bf2f(bf16_t b) { return __uint_as_float(((unsigned)b) << 16); }
__device__ __forceinline__ float bflo(unsigned u) { return __uint_as_float(u << 16); }
__device__ __forceinline__ float bfhi(unsigned u) { return __uint_as_float(u & 0xffff0000u); }
__device__ __forceinline__ float sigm(float x) { return __builtin_amdgcn_rcpf(1.f + __expf(-x)); }
__device__ __forceinline__ float siluf_(float x) { return x * sigm(x); }
__device__ __forceinline__ float geluf_(float x) { return x * sigm(1.5957691216057308f * (x + 0.044715f * x * x * x)); }
__device__ __forceinline__ float wave_sum(float v) {
#pragma unroll
    for (int o = 1; o < 64; o <<= 1) v += __shfl_xor(v, o);
    return v;
}
__device__ __forceinline__ u32x4 zero4() { unsigned z; asm volatile("v_mov_b32 %0, 0" : "=v"(z)); return (u32x4){z, z, z, z}; }
template <int CTRL, int RM = 0xf, int BK = 0xf>
__device__ __forceinline__ float dpp_add(float v) { return v + __int_as_float(__builtin_amdgcn_update_dpp(0, __float_as_int(v), CTRL, RM, BK, false)); }
__device__ __forceinline__ float row16_sum(float v) { v = dpp_add<0xB1>(v); v = dpp_add<0x4E>(v); v = dpp_add<0x141>(v); return dpp_add<0x140>(v); }
__device__ __forceinline__ float wave_scan(float c) { c = dpp_add<0x111>(c); c = dpp_add<0x112>(c); c = dpp_add<0x114>(c); c = dpp_add<0x118>(c); c = dpp_add<0x142, 0xa>(c); return dpp_add<0x143, 0xc>(c); }
__device__ __forceinline__ f32x4 mfma16(bf16x8 a, bf16x8 b, f32x4 c) { return __builtin_amdgcn_mfma_f32_16x16x32_bf16(a, b, c, 0, 0, 0); }
__device__ __forceinline__ int mod_row(int row) { return row < TP ? (row >> 11) : 8 + ((row - TP) >> 4); }

namespace pg8 {
constexpr int BM = 256, BK = 64, HALF = 128, HTB = HALF * BK * 2, STAGE_BYTES = 8 * HTB, NXCD = 8, WGM = 8;
__device__ __forceinline__ int lds_byte(int r, int c) { const int st = (r >> 4) * 2 + (c >> 5), rr = r & 15, cc = c & 31, ob = rr * 64 + cc * 2; return st * 1024 + (ob ^ (((ob >> 9) & 1) << 5)); }
__device__ __forceinline__ void stage_rc(int b, int& R, int& C) { const int st = b / 1024, sb = b % 1024, swz = sb ^ (((sb >> 9) & 1) << 5); R = (st >> 1) * 16 + swz / 64; C = (st & 1) * 32 + (swz % 64) / 2; }
struct Unit { int pm, pn; };
struct Gemm { const bf16_t* A; const bf16_t* Bt; int M, N, K; };
struct StaticOrder {
    int nM, nN, nwg, G, c;
    __device__ __forceinline__ void init(int M, int N, int G_, int c_) { nM = M / BM; nN = N / BM; nwg = nM * nN; G = G_; c = c_; }
    __device__ __forceinline__ bool next(int i, Unit& u) const {
        const long L = (long)i * G + c; if (L >= nwg) return false;
        int wgid = (int)L; { const int q = nwg / NXCD, r = nwg % NXCD, xcd = wgid % NXCD, off = wgid / NXCD; wgid = (xcd < r ? xcd * (q + 1) : r * (q + 1) + (xcd - r) * q) + off; }
        const int nig = WGM * nN, gid = wgid / nig, fm = gid * WGM, gsz = (nM - fm) < WGM ? (nM - fm) : WGM;
        u.pm = fm + ((wgid % nig) % gsz); u.pn = (wgid % nig) / gsz; return true;
    }
};
template <class Epi>
__device__ __forceinline__ void gemm_phase(LAS unsigned char* lds, const Gemm g, const StaticOrder& S, const Epi& E) {
    const int tid = tid_(), wid = __builtin_amdgcn_readfirstlane(tid >> 6), lane = tid & 63, wr = wid >> 2, wc = wid & 3, fr = lane & 15, fq = lane >> 4;
    const int K = g.K, nt = K / BK;
    unsigned voffA[2], voffB[2];
#pragma unroll
    for (int i = 0; i < 2; ++i) { int R, C; stage_rc(tid * 16 + i * 8192, R, C); voffA[i] = (unsigned)(R * K + C) * 2u; voffB[i] = voffA[i]; }
    const size_t kstep = (size_t)(BK * 2);
    const size_t hstep = (size_t)HALF * K * 2;
    const size_t tstep = 2 * hstep;
    const unsigned ldsw = (unsigned)wid * 1024u;
    const int aoff = lds_byte(wr * 64 + fr, fq * 8), boff = lds_byte(wc * 32 + fr, fq * 8);
#define PG8_SA(b, h) (((b) * 2 + (h)) * HTB)
#define PG8_SB(b, h) ((4 + (b) * 2 + (h)) * HTB)
#define PG8_STAGE(bufoff, gbase, voff) do { _Pragma("unroll") for (int _i = 0; _i < 2; ++_i) \
        __builtin_amdgcn_global_load_lds((const unsigned*)((const char*)(gbase) + (voff)[_i]), (LAS unsigned*)(lds + (bufoff) + ldsw + _i * 8192), 16, 0, 0); } while (0)
#define PG8_LDA(dst, b, h) do { _Pragma("unroll") for (int m = 0; m < 4; ++m) _Pragma("unroll") for (int k = 0; k < 2; ++k) dst[m][k] = *(const LAS bf16x8*)(lds + PG8_SA(b, h) + aoff + m * 2048 + k * 1024); } while (0)
#define PG8_LDB(dst, b, h) do { _Pragma("unroll") for (int n = 0; n < 2; ++n) _Pragma("unroll") for (int k = 0; k < 2; ++k) dst[n][k] = *(const LAS bf16x8*)(lds + PG8_SB(b, h) + boff + n * 2048 + k * 1024); } while (0)
#define PG8_MMA(ai, bj, At, Bt) do { __builtin_amdgcn_s_setprio(1); _Pragma("unroll") for (int m = 0; m < 4; ++m) _Pragma("unroll") for (int n = 0; n < 2; ++n) _Pragma("unroll") for (int k = 0; k < 2; ++k) \
        acc[ai][bj][m][n] = __builtin_amdgcn_mfma_f32_16x16x32_bf16(Bt[n][k], At[m][k], acc[ai][bj][m][n], 0, 0, 0); __builtin_amdgcn_s_setprio(0); } while (0)
#define PG8_WAIT_V(n) asm volatile("s_waitcnt vmcnt(" #n ")" ::: "memory")
#define PG8_WAIT_L(n) asm volatile("s_waitcnt lgkmcnt(" #n ")" ::: "memory")
#define PG8_BAR __builtin_amdgcn_s_barrier()
#define PG8_SCHED __builtin_amdgcn_sched_barrier(0)
    Unit cur, nxt; int ui = 0;
    if (!S.next(0, cur)) return;
    f32x4 acc[2][2][4][2];
#pragma unroll
    for (int a = 0; a < 2; ++a)
#pragma unroll
        for (int b = 0; b < 2; ++b)
#pragma unroll
            for (int m = 0; m < 4; ++m)
#pragma unroll
                for (int n = 0; n < 2; ++n) acc[a][b][m][n] = (f32x4){0.f, 0.f, 0.f, 0.f};
    bf16x8 At[4][2], B0[2][2], B1[2][2];
    const char* cA = (const char*)g.A + (size_t)cur.pm * tstep; const char* cB = (const char*)g.Bt + (size_t)cur.pn * tstep;
    PG8_STAGE(PG8_SB(0, 0), cB, voffB); PG8_STAGE(PG8_SA(0, 0), cA, voffA); PG8_STAGE(PG8_SB(0, 1), cB + hstep, voffB); PG8_STAGE(PG8_SA(0, 1), cA + hstep, voffA);
    if (wr == 1) PG8_BAR;
    PG8_WAIT_V(4); PG8_BAR;
    PG8_STAGE(PG8_SB(1, 0), cB + kstep, voffB); PG8_STAGE(PG8_SA(1, 0), cA + kstep, voffA); PG8_STAGE(PG8_SB(1, 1), cB + hstep + kstep, voffB);
    PG8_WAIT_V(6); PG8_BAR;
    for (;;) {
        const bool has_next = S.next(ui + 1, nxt);
        const char* nA = has_next ? (const char*)g.A + (size_t)nxt.pm * tstep : cA; const char* nB = has_next ? (const char*)g.Bt + (size_t)nxt.pn * tstep : cB;
        for (int t = 0; t < nt; t += 2) {
            const bool last = (t == nt - 2);
            const char* a1 = cA + (size_t)(t + 1) * kstep;
            const char* a2 = last ? nA : cA + (size_t)(t + 2) * kstep; const char* b2 = last ? nB : cB + (size_t)(t + 2) * kstep;
            const char* a3 = a2 + kstep; const char* b3 = b2 + kstep;
            PG8_LDB(B0, 0, 0); PG8_SCHED; PG8_LDA(At, 0, 0); PG8_STAGE(PG8_SA(1, 1), a1 + hstep, voffA);
            PG8_WAIT_L(8); PG8_BAR; PG8_WAIT_L(0); PG8_MMA(0, 0, At, B0); PG8_BAR; PG8_SCHED;
            PG8_LDB(B1, 0, 1); PG8_STAGE(PG8_SB(0, 0), b2, voffB);
            PG8_BAR; PG8_WAIT_L(0); PG8_MMA(0, 1, At, B1); PG8_BAR;
            PG8_LDA(At, 0, 1); PG8_STAGE(PG8_SA(0, 0), a2, voffA);
            PG8_BAR; PG8_WAIT_L(0); PG8_MMA(1, 0, At, B0); PG8_BAR; PG8_SCHED;
            PG8_STAGE(PG8_SB(0, 1), b2 + hstep, voffB);
            PG8_WAIT_V(6); PG8_BAR; PG8_MMA(1, 1, At, B1); PG8_BAR;
            PG8_LDB(B0, 1, 0); PG8_SCHED; PG8_LDA(At, 1, 0); PG8_STAGE(PG8_SA(0, 1), a2 + hstep, voffA);
            PG8_WAIT_L(8); PG8_BAR; PG8_WAIT_L(0); PG8_MMA(0, 0, At, B0); PG8_BAR; PG8_SCHED;
            PG8_LDB(B1, 1, 1); PG8_STAGE(PG8_SB(1, 0), b3, voffB);
            PG8_BAR; PG8_WAIT_L(0); PG8_MMA(0, 1, At, B1); PG8_BAR;
            PG8_LDA(At, 1, 1); PG8_STAGE(PG8_SA(1, 0), a3, voffA);
            PG8_BAR; PG8_WAIT_L(0); PG8_MMA(1, 0, At, B0); PG8_BAR; PG8_SCHED;
            PG8_STAGE(PG8_SB(1, 1), b3 + hstep, voffB);
            PG8_WAIT_V(6); PG8_BAR; PG8_MMA(1, 1, At, B1); PG8_BAR;
        }
        E(acc, cur, wr, wc, fr, fq);
        if (!has_next) break;
#pragma unroll
        for (int a = 0; a < 2; ++a)
#pragma unroll
            for (int b = 0; b < 2; ++b)
#pragma unroll
                for (int m = 0; m < 4; ++m)
#pragma unroll
                    for (int n = 0; n < 2; ++n) acc[a][b][m][n] = (f32x4){0.f, 0.f, 0.f, 0.f};
        cur = nxt; cA = nA; cB = nB; ++ui;
    }
    PG8_WAIT_V(0);
    if (wr == 0) PG8_BAR;
    PG8_BAR;
#undef PG8_SA
#undef PG8_SB
#undef PG8_STAGE
#undef PG8_LDA
#undef PG8_LDB
#undef PG8_MMA
#undef PG8_WAIT_V
#undef PG8_WAIT_L
#undef PG8_BAR
#undef PG8_SCHED
}
}

template <class F, int MG = 2> struct EpiRC {
    F f;
    __device__ __forceinline__ void operator()(const f32x4 (&acc)[2][2][4][2], const pg8::Unit& u, int wr, int wc, int fr, int fq) const {
        const int row0 = u.pm * 256 + wr * 64 + fr, col0 = u.pn * 256 + wc * 32 + 4 * fq;
#pragma unroll
        for (int ai = 0; ai < 2; ++ai)
#pragma unroll
            for (int mh = 0; mh < 4 / MG; ++mh) {
                typename F::Ld ld[MG][2][2];
#pragma unroll
                for (int mm = 0; mm < MG; ++mm)
#pragma unroll
                    for (int bj = 0; bj < 2; ++bj)
#pragma unroll
                        for (int n = 0; n < 2; ++n) f.load(row0 + ai * 128 + (mh * MG + mm) * 16, col0 + bj * 128 + n * 16, ld[mm][bj][n]);
#pragma unroll
                for (int mm = 0; mm < MG; ++mm)
#pragma unroll
                    for (int bj = 0; bj < 2; ++bj)
#pragma unroll
                        for (int n = 0; n < 2; ++n) f.apply(row0 + ai * 128 + (mh * MG + mm) * 16, col0 + bj * 128 + n * 16, acc[ai][bj][mh * MG + mm][n], ld[mm][bj][n]);
            }
    }
};
struct EpiResidP {
    const float* src; float* X; const float* modg;
    __device__ __forceinline__ void operator()(const f32x4 (&acc)[2][2][4][2], const pg8::Unit& u, int wr, int wc, int fr, int fq) const {
        const int row0 = u.pm * 256 + wr * 64 + fr, col0 = u.pn * 256 + wc * 32 + 4 * fq;
        const float* gp = modg + (size_t)((u.pm * 256) >> 11) * 6144 + col0;
        f32x4 g[2][2];
#pragma unroll
        for (int bj = 0; bj < 2; ++bj)
#pragma unroll
            for (int n = 0; n < 2; ++n) g[bj][n] = *(const f32x4*)(gp + bj * 128 + n * 16);
#pragma unroll
        for (int ai = 0; ai < 2; ++ai) {
            f32x4 x[4][2][2];
#pragma unroll
            for (int m = 0; m < 4; ++m)
#pragma unroll
                for (int bj = 0; bj < 2; ++bj)
#pragma unroll
                    for (int n = 0; n < 2; ++n) x[m][bj][n] = *(const f32x4*)(src + (size_t)(row0 + ai * 128 + m * 16) * 1024 + col0 + bj * 128 + n * 16);
#pragma unroll
            for (int m = 0; m < 4; ++m)
#pragma unroll
                for (int bj = 0; bj < 2; ++bj)
#pragma unroll
                    for (int n = 0; n < 2; ++n) *(f32x4*)(X + (size_t)(row0 + ai * 128 + m * 16) * 1024 + col0 + bj * 128 + n * 16) = x[m][bj][n] + g[bj][n] * acc[ai][bj][m][n];
        }
    }
};

template <int KW, class F>
__device__ __forceinline__ void skinny_gemm(unsigned char* shm, const bf16_t* A, const bf16_t* Bt, int N, const F& f) {
    constexpr int K = KW * 8, NS = KW / 32 < 4 ? KW / 32 : 4, NSTEP = KW / 32;
    const int tid = tid_(), w = tid >> 6, lane = tid & 63, fr = lane & 15, fq = lane >> 4;
    f32x4* red = (f32x4*)shm;
    const int nun = 16 * (N / 64);
    for (int u = blockIdx.x; u < nun; u += gridDim.x) {
        const int m0 = (u & 15) * 32, n0 = (u >> 4) * 64;
        typename F::Ld eld; const int er = TP + m0 + (w >> 2) * 16 + fr, ec = n0 + (w & 3) * 16 + fq * 4; f.load(er, ec, eld);
        f32x4 acc[2][4];
#pragma unroll
        for (int i = 0; i < 2; ++i)
#pragma unroll
            for (int j = 0; j < 4; ++j) acc[i][j] = (f32x4){0.f, 0.f, 0.f, 0.f};
        const bf16_t* ap = A + (size_t)(m0 + fr) * K + w * KW + fq * 8;
        const bf16_t* bp = Bt + (size_t)(n0 + fr) * K + w * KW + fq * 8;
        bf16x8 ra[NS][2], rb[NS][4];
#pragma unroll
        for (int s = 0; s < NS; ++s) {
#pragma unroll
            for (int i = 0; i < 2; ++i) ra[s][i] = *(const bf16x8*)(ap + (size_t)i * 16 * K + s * 32);
#pragma unroll
            for (int j = 0; j < 4; ++j) rb[s][j] = *(const bf16x8*)(bp + (size_t)j * 16 * K + s * 32);
        }
#pragma unroll
        for (int st = 0; st < NSTEP; ++st) {
            const int s = st % NS;
#pragma unroll
            for (int i = 0; i < 2; ++i)
#pragma unroll
                for (int j = 0; j < 4; ++j) acc[i][j] = mfma16(rb[s][j], ra[s][i], acc[i][j]);
            if (st + NS < NSTEP) {
#pragma unroll
                for (int i = 0; i < 2; ++i) ra[s][i] = *(const bf16x8*)(ap + (size_t)i * 16 * K + (st + NS) * 32);
#pragma unroll
                for (int j = 0; j < 4; ++j) rb[s][j] = *(const bf16x8*)(bp + (size_t)j * 16 * K + (st + NS) * 32);
            }
        }
        __syncthreads();
#pragma unroll
        for (int i = 0; i < 2; ++i)
#pragma unroll
            for (int j = 0; j < 4; ++j) red[(w * 8 + i * 4 + j) * 64 + lane] = acc[i][j];
        __syncthreads();
        f32x4 s = red[w * 64 + lane];
#pragma unroll
        for (int q = 1; q < 8; ++q) s += red[(q * 8 + w) * 64 + lane];
        f.apply(er, ec, s, eld);
    }
    __syncthreads();
}

struct EpiIn {
    int l; KP pp;
    __device__ __forceinline__ void operator()(const f32x4 (&acc)[2][2][4][2], const pg8::Unit& u, int wr, int wc, int fr, int fq) const {
        const KP p = pp;
        unsigned char* ws = p->ws;
        const int pn = u.pn;
        const int row0 = u.pm * 256 + wr * 64 + fr;
        const int ct0 = wc * 32 + 4 * fq;
        if (pn < 3) {
            bf16_t* Qb = (bf16_t*)(ws + W_Q); bf16_t* Kb = (bf16_t*)(ws + W_K); bf16_t* Vb = (bf16_t*)(ws + W_V);
            const f32x2* rope = (const f32x2*)(ws + W_ROPE);
#pragma unroll
            for (int ai = 0; ai < 2; ++ai)
#pragma unroll
                for (int m = 0; m < 4; ++m) {
                    const int row = row0 + ai * 128 + m * 16;
                    const bool samp = row >= TP;
                    const int b = samp ? (row - TP) >> 4 : row >> 11, t = samp ? (row - TP) & 15 : row & 2047;
                    const int pi = samp ? 2048 + t : t;
#pragma unroll
                    for (int bj = 0; bj < 2; ++bj)
#pragma unroll
                        for (int n = 0; n < 2; ++n) {
                            f32x4 v = acc[ai][bj][m][n];
                            const int ct = bj * 128 + ct0 + n * 16;
                            const bool isv = (pn == 2) && (bj == 1);
                            if (!isv && n == 0 && (wc & 1) == 0) {
                                f32x4 o;
                                o[0] = __shfl_xor(v[0], 32); o[1] = __shfl_xor(v[1], 32); o[2] = __shfl_xor(v[2], 32); o[3] = __shfl_xor(v[3], 32);
                                const f32x4* cs = (const f32x4*)(rope + pi * 8 + 4 * (fq & 1));
                                const f32x4 c01 = cs[0], c23 = cs[1];
                                const float sgn = (fq < 2) ? -1.f : 1.f;
                                v[0] = v[0] * c01[0] + sgn * o[0] * c01[1];
                                v[1] = v[1] * c01[2] + sgn * o[1] * c01[3];
                                v[2] = v[2] * c23[0] + sgn * o[2] * c23[1];
                                v[3] = v[3] * c23[2] + sgn * o[3] * c23[3];
                            }
                            u32x2 pk; pk.x = pk2(v[0], v[1]); pk.y = pk2(v[2], v[3]);
                            if (pn < 2) { *(u32x2*)(Qb + (size_t)row * 512 + pn * 256 + ct) = pk; }
                            else {
                                const int c = ct & 127;
                                bf16_t* dst = isv ? Vb : Kb;
                                *(u32x2*)(dst + (size_t)row * 128 + c) = pk;
                                if (samp) {
                                    float* o = p->out + (isv ? O_VS : O_KS) + ((size_t)(l * 32 + b) * 16 + t) * 128 + c;
                                    *(f32x4*)o = v;
                                } else if (t >= 1920) {
                                    float* o = p->out + (isv ? O_VP : O_KP) + ((size_t)(l * 8 + b) * 128 + (t - 1920)) * 128 + c;
                                    *(f32x4*)o = v;
                                }
                            }
                        }
                }
        } else if (pn < 7) {
            bf16_t* Zb = (bf16_t*)(ws + W_Z);
#pragma unroll
            for (int ai = 0; ai < 2; ++ai)
#pragma unroll
                for (int m = 0; m < 4; ++m) {
                    const int row = row0 + ai * 128 + m * 16;
#pragma unroll
                    for (int bj = 0; bj < 2; ++bj)
#pragma unroll
                        for (int n = 0; n < 2; ++n) {
                            const f32x4 v = acc[ai][bj][m][n];
                            u32x2 pk; pk.x = pk2(v[0], v[1]); pk.y = pk2(v[2], v[3]);
                            *(u32x2*)(Zb + (size_t)row * 1024 + (pn - 3) * 256 + bj * 128 + ct0 + n * 16) = pk;
                        }
                }
        } else if (pn < 13) {
            bf16_t* Xb = (bf16_t*)(ws + W_XBC);
#pragma unroll
            for (int ai = 0; ai < 2; ++ai)
#pragma unroll
                for (int m = 0; m < 4; ++m) {
                    const int row = row0 + ai * 128 + m * 16;
                    const bool samp = row >= TP;
                    const int b = samp ? (row - TP) >> 4 : row >> 11, t = samp ? (row - TP) & 15 : row & 2047;
#pragma unroll
                    for (int bj = 0; bj < 2; ++bj)
#pragma unroll
                        for (int n = 0; n < 2; ++n) {
                            const f32x4 v = acc[ai][bj][m][n];
                            const int cc = (pn - 7) * 256 + bj * 128 + ct0 + n * 16;
                            u32x2 pk; pk.x = pk2(v[0], v[1]); pk.y = pk2(v[2], v[3]);
                            *(u32x2*)(Xb + (size_t)row * 1536 + cc) = pk;
                            if (samp) { if (t >= 13) *(f32x4*)(p->out + O_CS + ((size_t)(l * 32 + b) * 3 + (t - 13)) * 1536 + cc) = v; }
                            else if (t >= 2045) *(f32x4*)(p->out + O_CP + ((size_t)(l * 8 + b) * 3 + (t - 2045)) * 1536 + cc) = v;
                        }
                }
        } else if (pn < 17) {
            bf16_t* dst = (bf16_t*)(ws + (pn < 15 ? W_GU : W_GV));
            const int cb = ((pn - 13) & 1) * 256;
#pragma unroll
            for (int ai = 0; ai < 2; ++ai)
#pragma unroll
                for (int m = 0; m < 4; ++m) {
                    const int row = row0 + ai * 128 + m * 16;
#pragma unroll
                    for (int bj = 0; bj < 2; ++bj)
#pragma unroll
                        for (int n = 0; n < 2; ++n) {
                            const f32x4 v = acc[ai][bj][m][n];
                            u32x2 pk; pk.x = pk2(geluf_(v[0]), geluf_(v[1])); pk.y = pk2(geluf_(v[2]), geluf_(v[3]));
                            *(u32x2*)(dst + (size_t)row * 512 + cb + bj * 128 + ct0 + n * 16) = pk;
                        }
                }
        } else if (pn < 29) {
            unsigned char* G8 = ws + W_G8;
#pragma unroll
            for (int ai = 0; ai < 2; ++ai)
#pragma unroll
                for (int m = 0; m < 4; ++m) {
                    const int row = row0 + ai * 128 + m * 16;
#pragma unroll
                    for (int bj = 0; bj < 2; ++bj)
#pragma unroll
                        for (int n = 0; n < 2; ++n) {
                            const f32x4 v = acc[ai][bj][m][n];
                            const unsigned q0 = (unsigned)(sigm(v[0]) * 255.f + 0.5f), q1 = (unsigned)(sigm(v[1]) * 255.f + 0.5f);
                            const unsigned q2 = (unsigned)(sigm(v[2]) * 255.f + 0.5f), q3 = (unsigned)(sigm(v[3]) * 255.f + 0.5f);
                            *(unsigned*)(G8 + (size_t)row * 3072 + (pn - 17) * 256 + bj * 128 + ct0 + n * 16) = q0 | (q1 << 8) | (q2 << 16) | (q3 << 24);
                        }
                }
        } else {
            if (wc == 0) {
                float* DT = (float*)(ws + W_DT);
                const f32x4 bias = *(const f32x4*)(p->dt_bias + l * 16 + 4 * fq);
#pragma unroll
                for (int ai = 0; ai < 2; ++ai)
#pragma unroll
                    for (int m = 0; m < 4; ++m) {
                        const int row = row0 + ai * 128 + m * 16;
                        f32x4 v = acc[ai][0][m][0] + bias;
#pragma unroll
                        for (int e = 0; e < 4; ++e) { const float x = v[e]; v[e] = fmaxf(x, 0.f) + log1pf(__expf(-fabsf(x))); }
                        *(f32x4*)(DT + (size_t)row * 16 + 4 * fq) = v;
                    }
            }
        }
    }
};

template <bool BIG> struct FMergeT {
    int b; const unsigned char* G8; const float* rowss; bf16_t* MG;
    const float* tile_rstd; int tile_row0;
    struct Ld { unsigned g; float ss; u32x2 o; };
    __device__ __forceinline__ void load(int row, int col, Ld& d) const {
        d.g = *(const unsigned*)(G8 + (size_t)row * 3072 + b * 1024 + col);
        d.ss = 1.f;
        if (b == 1) {
            if (BIG) d.ss = tile_rstd[row - tile_row0];
            else {
                const f32x4* pp = (const f32x4*)(rowss + (size_t)row * 32);
                const f32x4 t = ((pp[0] + pp[1]) + (pp[2] + pp[3])) + ((pp[4] + pp[5]) + (pp[6] + pp[7]));
                d.ss = rsqrtf(((t[0] + t[1]) + (t[2] + t[3])) * (1.f / 1024.f) + EPSF);
            }
        }
        d.o = (b > 0) ? *(const u32x2*)(MG + (size_t)row * 1024 + col) : (u32x2){0u, 0u};
    }
    __device__ __forceinline__ void apply(int row, int col, f32x4 v, const Ld& d) const {
        const float sc = d.ss * (1.f / 255.f);
        const unsigned g = d.g;
        f32x4 r;
        r[0] = (float)(g & 255u) * sc * v[0]; r[1] = (float)((g >> 8) & 255u) * sc * v[1];
        r[2] = (float)((g >> 16) & 255u) * sc * v[2]; r[3] = (float)(g >> 24) * sc * v[3];
        if (b > 0) { r[0] += bflo(d.o.x); r[1] += bfhi(d.o.x); r[2] += bflo(d.o.y); r[3] += bfhi(d.o.y); }
        u32x2 pk; pk.x = pk2(r[0], r[1]); pk.y = pk2(r[2], r[3]);
        *(u32x2*)(MG + (size_t)row * 1024 + col) = pk;
    }
};
struct FResid {
    const float* srcP; const float* srcS; float* X; const float* modg;
    struct Ld { f32x4 x, g; };
    __device__ __forceinline__ void load(int row, int col, Ld& d) const {
        const float* s = row < TP ? srcP + (size_t)row * 1024 + col : srcS + (size_t)(row - TP) * 1024 + col;
        d.x = *(const f32x4*)s;
        d.g = *(const f32x4*)(modg + (size_t)mod_row(row) * 6144 + col);
    }
    __device__ __forceinline__ void apply(int row, int col, f32x4 v, const Ld& d) const {
        *(f32x4*)(X + (size_t)row * 1024 + col) = d.x + d.g * v;
    }
};
struct FRelu2 {
    bf16_t* FH;
    struct Ld { };
    __device__ __forceinline__ void load(int, int, Ld&) const {}
    __device__ __forceinline__ void apply(int row, int col, f32x4 v, const Ld&) const {
        f32x4 r; r[0] = fmaxf(v[0], 0.f); r[1] = fmaxf(v[1], 0.f); r[2] = fmaxf(v[2], 0.f); r[3] = fmaxf(v[3], 0.f);
        u32x2 pk; pk.x = pk2(r[0] * r[0], r[1] * r[1]); pk.y = pk2(r[2] * r[2], r[3] * r[3]);
        *(u32x2*)(FH + (size_t)row * 4096 + col) = pk;
    }
};

__device__ __forceinline__ void phase_mod(KP p, float* lds) {
    float* sc = lds;
    float* red = lds + 20480;
    float* MOD = (float*)(p->ws + W_MOD);
    const int tid = tid_();
    const int rh = blockIdx.x & 1;
    __syncthreads();
    {
        float cv[40];
#pragma unroll
        for (int i = 0; i < 40; ++i) {
            const int idx = tid + 512 * i, r = idx >> 10, k = idx & 1023, gr = rh * 20 + r;
            cv[i] = gr < 8 ? p->c_prompt[gr * 1024 + k] : p->c_sample[(gr - 8) * 1024 + k];
        }
#pragma unroll
        for (int i = 0; i < 40; ++i) {
            const int idx = tid + 512 * i, r = idx >> 10, k = idx & 1023;
            sc[k * 20 + r] = siluf_(cv[i]);
        }
    }
    __syncthreads();
    for (int pi = blockIdx.x >> 1; pi < 384; pi += gridDim.x >> 1) {
        const int l = pi / 192, cgp = pi % 192;
        const int cn = tid & 31, ks = tid >> 5, n = cgp * 32 + cn;
        float acc[20];
#pragma unroll
        for (int r = 0; r < 20; ++r) acc[r] = 0.f;
        const float* w = p->w_ada + (size_t)l * 1024 * 6144 + n + (size_t)ks * 64 * 6144;
#pragma unroll 1
        for (int kb = 0; kb < 64; kb += 32) {
            float wv[32];
#pragma unroll
            for (int i = 0; i < 32; ++i) wv[i] = w[(size_t)(kb + i) * 6144];
#pragma unroll
            for (int i = 0; i < 32; ++i) {
                const f32x4* s4 = (const f32x4*)(sc + (ks * 64 + kb + i) * 20);
#pragma unroll
                for (int q = 0; q < 5; ++q) { const f32x4 s = s4[q]; acc[4 * q] += s[0] * wv[i]; acc[4 * q + 1] += s[1] * wv[i]; acc[4 * q + 2] += s[2] * wv[i]; acc[4 * q + 3] += s[3] * wv[i]; }
            }
        }
#pragma unroll
        for (int r = 0; r < 20; ++r) red[(ks * 20 + r) * 32 + cn] = acc[r];
        __syncthreads();
        for (int idx = tid; idx < 640; idx += 512) {
            const int r = idx >> 5, c2 = idx & 31, n2 = cgp * 32 + c2;
            float s = 0.f;
#pragma unroll
            for (int k16 = 0; k16 < 16; ++k16) s += red[(k16 * 20 + r) * 32 + c2];
            MOD[((size_t)l * 40 + rh * 20 + r) * 6144 + n2] = s + p->b_ada[l * 6144 + n2];
        }
        __syncthreads();
    }
}

struct CvtTile { const float* src; bf16_t* dst; int K, Ns, mode, n0, k0; };
__device__ __forceinline__ CvtTile cvt_tile(KP p, int l, int it) {
    bf16_t* WT = (bf16_t*)(p->ws + W_WT);
    CvtTile c; int nT; int r = it; c.mode = 0;
    if (r < 1920) { c.src = p->w_in + (size_t)l * 1024 * 7440; c.K = 1024; c.Ns = 7440; nT = 120; c.dst = WT + WT_IN; c.mode = 1; }
    else if ((r -= 1920) < 128) { c.src = p->w_attn_o + (size_t)l * 512 * 1024; c.K = 512; c.Ns = 1024; nT = 16; c.dst = WT + WT_AO; }
    else if ((r -= 128) < 256) { c.src = p->w_ssm_o + (size_t)l * 1024 * 1024; c.K = 1024; c.Ns = 1024; nT = 16; c.dst = WT + WT_SO; c.mode = 2; }
    else if ((r -= 256) < 128) { c.src = p->w_gm_o + (size_t)l * 512 * 1024; c.K = 512; c.Ns = 1024; nT = 16; c.dst = WT + WT_GO; }
    else if ((r -= 128) < 256) { c.src = p->w_out + (size_t)l * 1024 * 1024; c.K = 1024; c.Ns = 1024; nT = 16; c.dst = WT + WT_OUT; }
    else if ((r -= 256) < 1024) { c.src = p->w_ff1 + (size_t)l * 1024 * 4096; c.K = 1024; c.Ns = 4096; nT = 64; c.dst = WT + WT_F1; }
    else { r -= 1024; c.src = p->w_ff2 + (size_t)l * 4096 * 1024; c.K = 4096; c.Ns = 1024; nT = 16; c.dst = WT + WT_F2; }
    c.n0 = (r % nT) * 64; c.k0 = (r / nT) * 64;
    return c;
}
__device__ __forceinline__ void convert_weights(KP p, int l, float* tiles) {
    const int tid = tid_();
    for (int it = blockIdx.x * 4; it < 4736; it += gridDim.x * 4) {
        CvtTile c[4] = {cvt_tile(p, l, it), cvt_tile(p, l, it + 1), cvt_tile(p, l, it + 2), cvt_tile(p, l, it + 3)};
        __syncthreads();
        float v[4][8];
#pragma unroll
        for (int h = 0; h < 4; ++h) {
            const int nn = tid & 63, ns = c[h].n0 + nn; int sc_ = ns; bool zero = false;
            if (c[h].mode == 1) { if (ns < 3328) sc_ = ns; else if (ns < 7424) sc_ = ns + 16; else if (ns < 7440) sc_ = ns - 7424 + 3328; else { zero = true; sc_ = 0; } }
#pragma unroll
            for (int i = 0; i < 8; ++i) {
                const int kk = (tid >> 6) + 8 * i;
                v[h][i] = zero ? 0.f : c[h].src[(size_t)(c[h].k0 + kk) * c[h].Ns + sc_];
            }
        }
#pragma unroll
        for (int h = 0; h < 4; ++h)
#pragma unroll
            for (int i = 0; i < 8; ++i) {
                const int kk = (tid >> 6) + 8 * i;
                float x = v[h][i];
                if (c[h].mode == 2) x *= p->ssm_norm_w[l * 1024 + c[h].k0 + kk];
                tiles[h * 4224 + kk * 65 + (tid & 63)] = x;
            }
        __syncthreads();
#pragma unroll
        for (int h = 0; h < 4; ++h) {
            const float* tile = tiles + h * 4224;
            const int nr = tid >> 3, kc = (tid & 7) * 8;
            u32x4 o;
            o.x = pk2(tile[(kc + 0) * 65 + nr], tile[(kc + 1) * 65 + nr]);
            o.y = pk2(tile[(kc + 2) * 65 + nr], tile[(kc + 3) * 65 + nr]);
            o.z = pk2(tile[(kc + 4) * 65 + nr], tile[(kc + 5) * 65 + nr]);
            o.w = pk2(tile[(kc + 6) * 65 + nr], tile[(kc + 7) * 65 + nr]);
            *(u32x4*)(c[h].dst + (size_t)(c[h].n0 + nr) * c[h].K + c[h].k0 + kc) = o;
        }
    }
    __syncthreads();
}

__device__ __forceinline__ void phase_norm(KP p, int l, const float* srcP, const float* srcS, const float* gvec, int shift_idx) {
    const int tid = tid_(), lane = tid & 63, gw = blockIdx.x * 8 + (tid >> 6), ngw = gridDim.x * 8;
    const float* MOD = (const float*)(p->ws + W_MOD);
    bf16_t* H = (bf16_t*)(p->ws + W_H);
    f32x4 g[4];
#pragma unroll
    for (int j = 0; j < 4; ++j) g[j] = ((const f32x4*)gvec)[lane + 64 * j];
    f32x4 nx[4];
    {
        const int row = gw < T ? gw : T - 1;
        const float* xr = row < TP ? srcP + (size_t)row * 1024 : srcS + (size_t)(row - TP) * 1024;
#pragma unroll
        for (int j = 0; j < 4; ++j) nx[j] = ((const f32x4*)xr)[lane + 64 * j];
    }
    for (int row = gw; row < T; row += ngw) {
        f32x4 v[4];
#pragma unroll
        for (int j = 0; j < 4; ++j) v[j] = nx[j];
        {
            const int rn = row + ngw < T ? row + ngw : row;
            const float* xr = rn < TP ? srcP + (size_t)rn * 1024 : srcS + (size_t)(rn - TP) * 1024;
#pragma unroll
            for (int j = 0; j < 4; ++j) nx[j] = ((const f32x4*)xr)[lane + 64 * j];
        }
        const float* md = MOD + ((size_t)l * 40 + mod_row(row)) * 6144 + shift_idx * 1024;
        f32x4 sh[4], sc[4];
#pragma unroll
        for (int j = 0; j < 4; ++j) { sh[j] = ((const f32x4*)md)[lane + 64 * j]; sc[j] = ((const f32x4*)(md + 1024))[lane + 64 * j]; }
        float ss = 0.f;
#pragma unroll
        for (int j = 0; j < 4; ++j) ss += v[j][0] * v[j][0] + v[j][1] * v[j][1] + v[j][2] * v[j][2] + v[j][3] * v[j][3];
        ss = wave_sum(ss);
        const float rstd = rsqrtf(ss * (1.f / 1024.f) + EPSF);
#pragma unroll
        for (int j = 0; j < 4; ++j) {
            f32x4 h;
#pragma unroll
            for (int e = 0; e < 4; ++e) h[e] = (v[j][e] * rstd * g[j][e]) * (1.f + sc[j][e]) + sh[j][e];
            u32x2 pk; pk.x = pk2(h[0], h[1]); pk.y = pk2(h[2], h[3]);
            *(u32x2*)(H + (size_t)row * 1024 + (lane + 64 * j) * 4) = pk;
        }
    }
}

template <int NMT>
__device__ __forceinline__ void attn_load_q(const bf16_t* qo, int lane, bf16x8 (&qf)[NMT][2]) {
    const int fr = lane & 15, fq = lane >> 4;
#pragma unroll
    for (int mt = 0; mt < NMT; ++mt)
#pragma unroll
        for (int ks = 0; ks < 2; ++ks) qf[mt][ks] = *(const bf16x8*)(qo + (size_t)(mt * 16 + fr) * 512 + ks * 32 + fq * 8);
}
template <int NMT>
__device__ __forceinline__ void attn_compute(const bf16_t* Ks, const bf16_t* VT, bf16_t* qo, const bf16x8 (&qf)[NMT][2], int kt0, int kt1, int nkeys, float sink, int lane) {
    const int fr = lane & 15, fq = lane >> 4;
    f32x4 s[12][NMT];
#pragma unroll
    for (int kp = 0; kp < 6; ++kp) {
#pragma unroll
        for (int h2 = 0; h2 < 2; ++h2)
#pragma unroll
            for (int mt = 0; mt < NMT; ++mt) s[2 * kp + h2][mt] = (f32x4){0.f, 0.f, 0.f, 0.f};
        if (2 * kp >= kt0 && 2 * kp < kt1) {
            bf16x8 kf[2][2];
#pragma unroll
            for (int h2 = 0; h2 < 2; ++h2)
#pragma unroll
                for (int ks = 0; ks < 2; ++ks) kf[h2][ks] = *(const bf16x8*)(Ks + ((2 * kp + h2) * 16 + fr) * 72 + ks * 32 + fq * 8);
#pragma unroll
            for (int h2 = 0; h2 < 2; ++h2)
#pragma unroll
                for (int ks = 0; ks < 2; ++ks)
#pragma unroll
                    for (int mt = 0; mt < NMT; ++mt) s[2 * kp + h2][mt] = mfma16(kf[h2][ks], qf[mt][ks], s[2 * kp + h2][mt]);
        }
    }
    float inv[NMT];
#pragma unroll
    for (int mt = 0; mt < NMT; ++mt) {
        float mx = -INFINITY;
#pragma unroll
        for (int kt = 0; kt < 12; ++kt)
            if (kt >= kt0 && kt < kt1) {
#pragma unroll
                for (int j = 0; j < 4; ++j) { const int key = kt * 16 + fq * 4 + j; const float v = key < nkeys ? s[kt][mt][j] * 0.125f : -INFINITY; s[kt][mt][j] = v; mx = fmaxf(mx, v); }
            }
        mx = fmaxf(mx, __shfl_xor(mx, 16)); mx = fmaxf(mx, __shfl_xor(mx, 32)); mx = fmaxf(mx, sink);
        float sum = 0.f;
#pragma unroll
        for (int kt = 0; kt < 12; ++kt)
            if (kt >= kt0 && kt < kt1) {
#pragma unroll
                for (int j = 0; j < 4; ++j) { const float e = __expf(s[kt][mt][j] - mx); s[kt][mt][j] = e; sum += e; }
            }
        sum += __shfl_xor(sum, 16); sum += __shfl_xor(sum, 32);
        inv[mt] = 1.f / (sum + __expf(sink - mx));
    }
    f32x4 o[4][NMT];
#pragma unroll
    for (int dt = 0; dt < 4; ++dt)
#pragma unroll
        for (int mt = 0; mt < NMT; ++mt) o[dt][mt] = (f32x4){0.f, 0.f, 0.f, 0.f};
#pragma unroll
    for (int kb = 0; kb < 6; ++kb) {
        if (2 * kb >= kt0 && 2 * kb < kt1) {
            bf16x8 pf[NMT];
#pragma unroll
            for (int mt = 0; mt < NMT; ++mt) {
                const f32x4 a = s[2 * kb][mt], b = s[2 * kb + 1][mt];
                u32x4 t; t.x = pk2(a[0], a[1]); t.y = pk2(a[2], a[3]); t.z = pk2(b[0], b[1]); t.w = pk2(b[2], b[3]);
                pf[mt] = __builtin_bit_cast(bf16x8, t);
            }
            bf16x8 vf[4];
#pragma unroll
            for (int dt = 0; dt < 4; ++dt) {
                const u32x2 lo = *(const u32x2*)(VT + (dt * 16 + fr) * 200 + kb * 32 + fq * 4);
                const u32x2 hi = *(const u32x2*)(VT + (dt * 16 + fr) * 200 + kb * 32 + 16 + fq * 4);
                u32x4 t; t.x = lo.x; t.y = lo.y; t.z = hi.x; t.w = hi.y;
                vf[dt] = __builtin_bit_cast(bf16x8, t);
            }
#pragma unroll
            for (int dt = 0; dt < 4; ++dt)
#pragma unroll
                for (int mt = 0; mt < NMT; ++mt) o[dt][mt] = mfma16(vf[dt], pf[mt], o[dt][mt]);
        }
    }
#pragma unroll
    for (int mt = 0; mt < NMT; ++mt)
#pragma unroll
        for (int dt = 0; dt < 4; ++dt) {
            const f32x4 v = o[dt][mt] * inv[mt];
            u32x2 pk; pk.x = pk2(v[0], v[1]); pk.y = pk2(v[2], v[3]);
            *(u32x2*)(qo + (size_t)(mt * 16 + fr) * 512 + dt * 16 + fq * 4) = pk;
        }
}

__device__ __forceinline__ void scatter_vt(bf16_t* VT, int ch, int kk, u32x4 vv) {
    bf16_t* d = VT + (ch * 8) * 200 + kk;
    d[0 * 200] = (bf16_t)(vv.x & 0xffffu); d[1 * 200] = (bf16_t)(vv.x >> 16);
    d[2 * 200] = (bf16_t)(vv.y & 0xffffu); d[3 * 200] = (bf16_t)(vv.y >> 16);
    d[4 * 200] = (bf16_t)(vv.z & 0xffffu); d[5 * 200] = (bf16_t)(vv.z >> 16);
    d[6 * 200] = (bf16_t)(vv.w & 0xffffu); d[7 * 200] = (bf16_t)(vv.w >> 16);
}

__device__ __forceinline__ void attn_prompt_item(KP p, int l, int it, unsigned char* shm) {
    const int tid = tid_(), w = tid >> 6, lane = tid & 63;
    const int b = it >> 6, c = (it >> 1) & 31, kvh = it & 1;
    bf16_t* Ks = (bf16_t*)shm; bf16_t* VT = Ks + 192 * 72;
    bf16_t* Qb = (bf16_t*)(p->ws + W_Q); const bf16_t* Kb = (const bf16_t*)(p->ws + W_K); const bf16_t* Vb = (const bf16_t*)(p->ws + W_V);
    const int kt0 = c >= 2 ? 0 : (2 - c) * 4;
    const int g = w >> 1, q0 = (w & 1) * 32, hq = kvh * 4 + g;
    bf16_t* qo = Qb + ((size_t)b * 2048 + c * 64 + q0) * 512 + hq * 64;
    const float sink = p->sinks[l * 8 + hq];
    __syncthreads();
    {
        u32x4 kv[3], vv[3];
        bf16x8 qf[2][2];
#pragma unroll
        for (int it3 = 0; it3 < 3; ++it3) {
            const int idx = tid + it3 * 512, ch = idx / 192, kk = idx - ch * 192;
            const int kkc = kk >= kt0 * 16 ? kk : kt0 * 16;
            const size_t row = (size_t)b * 2048 + (c - 2) * 64 + kkc;
            kv[it3] = *(const u32x4*)(Kb + row * 128 + kvh * 64 + ch * 8);
            vv[it3] = *(const u32x4*)(Vb + row * 128 + kvh * 64 + ch * 8);
        }
        attn_load_q<2>(qo, lane, qf);
#pragma unroll
        for (int it3 = 0; it3 < 3; ++it3) {
            const int idx = tid + it3 * 512, ch = idx / 192, kk = idx - ch * 192;
            if (kk >= kt0 * 16) { *(u32x4*)(Ks + kk * 72 + ch * 8) = kv[it3]; scatter_vt(VT, ch, kk, vv[it3]); }
        }
        __syncthreads();
        attn_compute<2>(Ks, VT, qo, qf, kt0, 12, 192, sink, lane);
    }
}

__device__ __forceinline__ void attn_sample_item(KP p, int l, int it, unsigned char* shm) {
    const int tid = tid_(), w = tid >> 6, lane = tid & 63;
    const int sb = it >> 1, kvh = it & 1;
    bf16_t* Ks = (bf16_t*)shm; bf16_t* VT = Ks + 192 * 72;
    bf16_t* Qb = (bf16_t*)(p->ws + W_Q); const bf16_t* Kb = (const bf16_t*)(p->ws + W_K); const bf16_t* Vb = (const bf16_t*)(p->ws + W_V);
    __syncthreads();
    for (int idx = tid; idx < 160 * 8; idx += 512) {
        const int ch = idx / 160, kk = idx - ch * 160;
        u32x4 kv, vv;
        if (kk < 128) {
            const size_t o = ((((size_t)l * 32 + sb) * 128 + kk) * 2 + kvh) * 64 + ch * 8;
            const f32x4 k0 = *(const f32x4*)(p->cache_k + o), k1 = *(const f32x4*)(p->cache_k + o + 4);
            const f32x4 v0 = *(const f32x4*)(p->cache_v + o), v1 = *(const f32x4*)(p->cache_v + o + 4);
            kv.x = pk2(k0[0], k0[1]); kv.y = pk2(k0[2], k0[3]); kv.z = pk2(k1[0], k1[1]); kv.w = pk2(k1[2], k1[3]);
            vv.x = pk2(v0[0], v0[1]); vv.y = pk2(v0[2], v0[3]); vv.z = pk2(v1[0], v1[1]); vv.w = pk2(v1[2], v1[3]);
        } else if (kk < 144) {
            const size_t row = (size_t)TP + sb * 16 + (kk - 128);
            kv = *(const u32x4*)(Kb + row * 128 + kvh * 64 + ch * 8);
            vv = *(const u32x4*)(Vb + row * 128 + kvh * 64 + ch * 8);
        } else { kv = zero4(); vv = kv; }
        *(u32x4*)(Ks + kk * 72 + ch * 8) = kv;
        scatter_vt(VT, ch, kk, vv);
    }
    __syncthreads();
    if (w < 4) {
        const int hq = kvh * 4 + w;
        bf16_t* qo = Qb + ((size_t)TP + sb * 16) * 512 + hq * 64;
        bf16x8 qf[1][2];
        attn_load_q<1>(qo, lane, qf);
        attn_compute<1>(Ks, VT, qo, qf, 0, 10, 144, p->sinks[l * 8 + hq], lane);
    }
}

__device__ __forceinline__ void gmlp_item(KP p, int l, bool samp, int bi, int cidx, int g, unsigned char* shm) {
    const int tid = tid_(), w = tid >> 6, lane = tid & 63, fr = lane & 15, fq = lane >> 4;
    bf16_t* Wm = (bf16_t*)shm; bf16_t* VT = Wm + 128 * 136;
    const int L = samp ? 16 : 128;
    const int row0 = samp ? TP + bi * 16 : bi * 2048 + cidx * 128;
    bf16_t* GUb = (bf16_t*)(p->ws + W_GU); const bf16_t* GVb = (const bf16_t*)(p->ws + W_GV);
    __syncthreads();
    if (samp) {
        { const int idx = tid * 8, d = idx >> 5, s = idx & 31; *(u32x4*)(VT + d * 136 + s) = zero4(); }
        if (tid < 128) {
            const int t = tid >> 3, s4 = (tid & 7) * 4;
            f32x4 wv = (f32x4){0.f, 0.f, 0.f, 0.f};
            if (s4 < 16) wv = *(const f32x4*)(p->gm_w_s + ((size_t)(l * 4 + g) * 128 + t) * 128 + s4);
#pragma unroll
            for (int e = 0; e < 4; ++e) if (s4 + e > t) wv[e] = 0.f;
            u32x2 pk; pk.x = pk2(wv[0], wv[1]); pk.y = pk2(wv[2], wv[3]);
            *(u32x2*)(Wm + t * 136 + s4) = pk;
        }
        __syncthreads();
    }
    if (!samp) {
        const int r = tid >> 2, q = tid & 3;
        const bf16_t* src = GVb + (size_t)(row0 + r) * 512 + q * 128;
        u32x4 rv[16];
#pragma unroll
        for (int k = 0; k < 16; ++k) rv[k] = *(const u32x4*)(src + k * 8);
        float s = 0.f, s2 = 0.f;
#pragma unroll
        for (int k = 0; k < 16; ++k) {
            const float a0 = bflo(rv[k].x), a1 = bfhi(rv[k].x), a2 = bflo(rv[k].y), a3 = bfhi(rv[k].y), a4 = bflo(rv[k].z), a5 = bfhi(rv[k].z), a6 = bflo(rv[k].w), a7 = bfhi(rv[k].w);
            s += ((a0 + a1) + (a2 + a3)) + ((a4 + a5) + (a6 + a7));
            s2 += ((a0 * a0 + a1 * a1) + (a2 * a2 + a3 * a3)) + ((a4 * a4 + a5 * a5) + (a6 * a6 + a7 * a7));
        }
        s += __shfl_xor(s, 1); s += __shfl_xor(s, 2); s2 += __shfl_xor(s2, 1); s2 += __shfl_xor(s2, 2);
        float* lgs = (float*)(VT + 128 * 136);
        if (q == 0) {
            const float mean = s * (1.f / 512.f);
            lgs[256 + 2 * r] = mean; lgs[257 + 2 * r] = rsqrtf(fmaxf(s2 * (1.f / 512.f) - mean * mean, 0.f) + EPSF);
        }
        if (tid < 128) lgs[tid] = p->gm_ln_g[l * 512 + g * 128 + tid]; else if (tid < 256) lgs[tid] = p->gm_ln_b[l * 512 + g * 128 + tid - 128];
        const int r2 = tid & 127, dq = tid >> 7;
        u32x4 xv[4];
#pragma unroll
        for (int k = 0; k < 4; ++k) xv[k] = *(const u32x4*)(GVb + (size_t)(row0 + r2) * 512 + g * 128 + dq * 32 + k * 8);
        __syncthreads();
        {
            const float mean = lgs[256 + 2 * r2], rstd = lgs[257 + 2 * r2];
#pragma unroll
            for (int k = 0; k < 4; ++k) {
                const unsigned uu[4] = {xv[k].x, xv[k].y, xv[k].z, xv[k].w};
                const f32x4 g0 = *(const f32x4*)(lgs + dq * 32 + k * 8), g1 = *(const f32x4*)(lgs + dq * 32 + k * 8 + 4);
                const f32x4 b0 = *(const f32x4*)(lgs + 128 + dq * 32 + k * 8), b1 = *(const f32x4*)(lgs + 128 + dq * 32 + k * 8 + 4);
#pragma unroll
                for (int e = 0; e < 8; ++e) {
                    const float v = (e & 1) ? bfhi(uu[e >> 1]) : bflo(uu[e >> 1]);
                    const float gg = e < 4 ? g0[e & 3] : g1[e & 3], bb = e < 4 ? b0[e & 3] : b1[e & 3];
                    VT[(dq * 32 + k * 8 + e) * 136 + r2] = f2bf((v - mean) * rstd * gg + bb);
                }
            }
        }
        {
            f32x4 wv[8];
#pragma unroll
            for (int q = 0; q < 8; ++q) { const int idx = tid + q * 512; wv[q] = *(const f32x4*)(p->gm_w_s + ((size_t)(l * 4 + g) * 128 + (idx >> 5)) * 128 + (idx & 31) * 4); }
#pragma unroll
            for (int q = 0; q < 8; ++q) {
                const int idx = tid + q * 512, t = idx >> 5, s4 = (idx & 31) * 4;
#pragma unroll
                for (int e = 0; e < 4; ++e) if (s4 + e > t) wv[q][e] = 0.f;
                u32x2 pk; pk.x = pk2(wv[q][0], wv[q][1]); pk.y = pk2(wv[q][2], wv[q][3]);
                *(u32x2*)(Wm + t * 136 + s4) = pk;
            }
        }
    } else if (w == 0) {
        u32x4 rawv[16];
#pragma unroll
        for (int r = 0; r < 16; ++r) rawv[r] = *(const u32x4*)(GVb + (size_t)(row0 + r) * 512 + lane * 8);
#pragma unroll
        for (int r = 0; r < 16; ++r) {
            const u32x4 raw = rawv[r];
            float v[8];
            v[0] = bflo(raw.x); v[1] = bfhi(raw.x); v[2] = bflo(raw.y); v[3] = bfhi(raw.y); v[4] = bflo(raw.z); v[5] = bfhi(raw.z); v[6] = bflo(raw.w); v[7] = bfhi(raw.w);
            float s = 0.f;
#pragma unroll
            for (int e = 0; e < 8; ++e) s += v[e];
            const float mean = wave_sum(s) * (1.f / 512.f);
            float s2 = 0.f;
#pragma unroll
            for (int e = 0; e < 8; ++e) { v[e] -= mean; s2 += v[e] * v[e]; }
            const float rstd = rsqrtf(wave_sum(s2) * (1.f / 512.f) + EPSF);
            if (fq == g) {
#pragma unroll
                for (int e = 0; e < 8; ++e) {
                    const int d = fr * 8 + e, col = g * 128 + d;
                    const float vn = v[e] * rstd * p->gm_ln_g[l * 512 + col] + p->gm_ln_b[l * 512 + col];
                    VT[d * 136 + r] = f2bf(vn);
                    p->out[O_GS + ((size_t)(l * 32 + bi) * 16 + r) * 512 + col] = vn;
                }
            }
        }
    }
    bf16_t uv[4][8];
    if (w * 16 < L) {
#pragma unroll
        for (int j = 0; j < 4; ++j)
#pragma unroll
            for (int dt = 0; dt < 8; ++dt) uv[j][dt] = GUb[(size_t)(row0 + w * 16 + fq * 4 + j) * 512 + g * 128 + dt * 16 + fr];
    }
    __syncthreads();
    if (w * 16 < L) {
        f32x4 acc[8];
#pragma unroll
        for (int dt = 0; dt < 8; ++dt) acc[dt] = (f32x4){0.f, 0.f, 0.f, 0.f};
        const int nks = samp ? 1 : ((w * 16 + 15) >> 5) + 1;
#pragma unroll
        for (int ks = 0; ks < 4; ++ks) {
            if (ks < nks) {
                const bf16x8 wf = *(const bf16x8*)(Wm + (w * 16 + fr) * 136 + ks * 32 + fq * 8);
                bf16x8 vf[8];
#pragma unroll
                for (int dt = 0; dt < 8; ++dt) vf[dt] = *(const bf16x8*)(VT + (dt * 16 + fr) * 136 + ks * 32 + fq * 8);
#pragma unroll
                for (int dt = 0; dt < 8; ++dt) acc[dt] = mfma16(wf, vf[dt], acc[dt]);
            }
        }
#pragma unroll
        for (int j = 0; j < 4; ++j) {
            const int t = w * 16 + fq * 4 + j;
            const float bias = p->gm_b_s[(l * 4 + g) * 128 + t];
#pragma unroll
            for (int dt = 0; dt < 8; ++dt) {
                const size_t idx = (size_t)(row0 + t) * 512 + g * 128 + dt * 16 + fr;
                GUb[idx] = f2bf(bf2f(uv[j][dt]) * (acc[dt][j] + bias));
            }
        }
    }
}

constexpr size_t XT_SAMP = (size_t)256 * 1024 * 64, BT_SAMP = (size_t)256 * 256 * 64;
__device__ __forceinline__ void conv_prepass(KP p, int l, unsigned char* shm) {
    const int tid = tid_();
    bf16_t* R = (bf16_t*)shm;
    bf16_t* An = R + 67 * 264;
    bf16_t* At = An + 64 * 264;
    unsigned char* ws = p->ws;
    const bf16_t* Xb = (const bf16_t*)(ws + W_XBC);
    bf16_t* XT = (bf16_t*)(ws + W_H); bf16_t* BCN = (bf16_t*)(ws + W_BCN); bf16_t* BTg = (bf16_t*)(ws + W_BT);
    for (int it = blockIdx.x; it < 288 * 6; it += gridDim.x) {
        const int cidx = it / 6, slab = it - cidx * 6;
        const bool samp = cidx >= 256; const int sb = cidx - 256;
        const int row0 = samp ? TP + sb * 16 : cidx * 64, Lv = samp ? 16 : 64, c0 = slab * 256;
        __syncthreads();
        {
            u32x4 v[5];
#pragma unroll
            for (int q = 0; q < 5; ++q) {
                const int idx = tid + q * 512, r = idx >> 5, ck = idx & 31, rr = r - 3;
                v[q] = zero4();
                if (idx < (Lv + 3) * 32) {
                    if (rr >= 0 || (!samp && (cidx & 31) > 0)) v[q] = *(const u32x4*)(Xb + (size_t)(row0 + rr) * 1536 + c0 + ck * 8);
                    else if (samp) {
                        const float* sp = p->state_conv + (((size_t)l * 32 + sb) * 3 + (3 + rr)) * 1536 + c0 + ck * 8;
                        const f32x4 a = *(const f32x4*)sp, b = *(const f32x4*)(sp + 4);
                        v[q].x = pk2(a[0], a[1]); v[q].y = pk2(a[2], a[3]); v[q].z = pk2(b[0], b[1]); v[q].w = pk2(b[2], b[3]);
                    }
                }
            }
#pragma unroll
            for (int q = 0; q < 5; ++q) {
                const int idx = tid + q * 512;
                if (idx < (Lv + 3) * 32) *(u32x4*)(R + (idx >> 5) * 264 + (idx & 31) * 8) = v[q];
            }
        }
        __syncthreads();
        {
            const int j = tid & 255, tq = tid >> 8;
            if (tq * 32 < Lv) {
                const float w0 = p->conv_w[(l * 4 + 0) * 1536 + c0 + j], w1 = p->conv_w[(l * 4 + 1) * 1536 + c0 + j];
                const float w2 = p->conv_w[(l * 4 + 2) * 1536 + c0 + j], w3 = p->conv_w[(l * 4 + 3) * 1536 + c0 + j], cb = p->conv_b[l * 1536 + c0 + j];
                float x0 = bf2f(R[(tq * 32 + 0) * 264 + j]), x1 = bf2f(R[(tq * 32 + 1) * 264 + j]), x2 = bf2f(R[(tq * 32 + 2) * 264 + j]);
#pragma unroll
                for (int e = 0; e < 32; e += 2) {
                    const int t = tq * 32 + e;
                    if (t < Lv) {
                        const float x3 = bf2f(R[(t + 3) * 264 + j]), x4 = bf2f(R[(t + 4) * 264 + j]);
                        const float o0 = siluf_(cb + w0 * x0 + w1 * x1 + w2 * x2 + w3 * x3);
                        const float o1 = siluf_(cb + w0 * x1 + w1 * x2 + w2 * x3 + w3 * x4);
                        x0 = x2; x1 = x3; x2 = x4;
                        const unsigned pk = pk2(o0, o1);
                        An[t * 264 + j] = (bf16_t)(pk & 0xffffu); An[(t + 1) * 264 + j] = (bf16_t)(pk >> 16);
                        *(unsigned*)(At + j * 66 + t) = pk;
                    }
                }
            }
        }
        __syncthreads();
        if (slab >= 4) {
            for (int idx = tid; idx < Lv * 32; idx += 512) {
                const int t = idx >> 5, ck = idx & 31;
                *(u32x4*)(BCN + (size_t)(row0 + t) * 512 + (slab - 4) * 256 + ck * 8) = *(const u32x4*)(An + t * 264 + ck * 8);
            }
        }
        if (slab < 5) {
            const int sh = samp ? 1 : 3;
            bf16_t* dst;
            if (slab < 4) dst = samp ? XT + XT_SAMP + ((size_t)sb * 1024 + slab * 256) * 16 : XT + ((size_t)cidx * 1024 + slab * 256) * 64;
            else dst = samp ? BTg + BT_SAMP + (size_t)sb * 256 * 16 : BTg + (size_t)cidx * 256 * 64;
            for (int idx = tid; idx < (256 << sh); idx += 512) {
                const int j = idx >> sh, tc = idx & ((1 << sh) - 1);
                const unsigned* src = (const unsigned*)(At + j * 66 + tc * 8);
                u32x4 v; v.x = src[0]; v.y = src[1]; v.z = src[2]; v.w = src[3];
                *(u32x4*)(dst + (size_t)j * Lv + tc * 8) = v;
            }
        }
    }
    __syncthreads();
}

__device__ __forceinline__ void ssd_item(KP p, int l, bool samp, int bi, int h, unsigned char* shm) {
    const int tid = tid_(), w = tid >> 6, lane = tid & 63, fr = lane & 15, fq = lane >> 4;
    bf16_t* xT = (bf16_t*)shm;
    bf16_t* xwT = xT + 64 * 72;
    bf16_t* Bs = xwT + 64 * 72;
    bf16_t* BT = Bs + 64 * 136;
    bf16_t* Cs = BT + 128 * 72;
    bf16_t* Ms = Cs + 64 * 136;
    bf16_t* hb = Ms + 64 * 72;
    float* cumv = (float*)(hb + 64 * 136);
    float* dtv = cumv + 64;
    float* scl = dtv + 64;
    const int gr = h >> 3, nch = samp ? 1 : 32, Lv = samp ? 16 : 64;
    const int rowbase = samp ? TP + bi * 16 : bi * 2048;
    const float a_h = -__expf(p->a_log[l * 16 + h]), Dh = p->d_skip[l * 16 + h];
    unsigned char* ws = p->ws;
    const float* DT = (const float*)(ws + W_DT);
    const bf16_t* XTg = (const bf16_t*)(ws + W_H); const bf16_t* BCN = (const bf16_t*)(ws + W_BCN); const bf16_t* BTg = (const bf16_t*)(ws + W_BT);
    bf16_t* Zb = (bf16_t*)(ws + W_Z);
    float* ROWSS = (float*)(ws + W_ROWSS);
    const int pts = w >> 1, nt0 = (w & 1) * 4;
    f32x4 hacc[4];
    float* stout = samp ? p->out + O_SS + (((size_t)l * 32 + bi) * 16 + h) * 8192 : p->out + O_SP + (((size_t)l * 8 + bi) * 16 + h) * 8192;
    __syncthreads();
#pragma unroll
    for (int i = 0; i < 4; ++i) {
#pragma unroll
        for (int j = 0; j < 4; ++j) {
            const int pr = pts * 16 + fq * 4 + j, n = (nt0 + i) * 16 + fr;
            float v = 0.f;
            if (samp) v = p->state_ssm[((((size_t)l * 32 + bi) * 16 + h) * 64 + pr) * 128 + n];
            hacc[i][j] = v;
            hb[pr * 136 + n] = f2bf(v);
        }
    }
    const int ttile = w >> 1, half = w & 1;
    const int xp = tid >> 3, xc = tid & 7;

    u32x4 lx, lb[2], lc[2], lbt[2];
    float dcur = 0.f;
    auto load_ops = [&](int chx) {
        const int t0x = rowbase + chx * 64;
        lx = zero4();
        if (!samp) {
            const size_t cidx = (size_t)bi * 32 + chx;
            lx = *(const u32x4*)(XTg + (cidx * 1024 + h * 64 + xp) * 64 + xc * 8);
#pragma unroll
            for (int q = 0; q < 2; ++q) {
                const int idx = tid + q * 512;
                const bf16_t* rowp = BCN + (size_t)(t0x + (idx >> 4)) * 512 + gr * 128 + (idx & 15) * 8;
                lb[q] = *(const u32x4*)rowp; lc[q] = *(const u32x4*)(rowp + 256);
                lbt[q] = *(const u32x4*)(BTg + (cidx * 256 + gr * 128 + (idx >> 3)) * 64 + (idx & 7) * 8);
            }
        } else {
            if (xc < 2) lx = *(const u32x4*)(XTg + XT_SAMP + ((size_t)bi * 1024 + h * 64 + xp) * 16 + xc * 8);
#pragma unroll
            for (int q = 0; q < 2; ++q) {
                const int idx = tid + q * 512;
                lb[q] = zero4(); lc[q] = lb[q]; lbt[q] = lb[q];
                if ((idx >> 4) < 16) {
                    const bf16_t* rowp = BCN + (size_t)(t0x + (idx >> 4)) * 512 + gr * 128 + (idx & 15) * 8;
                    lb[q] = *(const u32x4*)rowp; lc[q] = *(const u32x4*)(rowp + 256);
                }
                if ((idx & 7) < 2) lbt[q] = *(const u32x4*)(BTg + BT_SAMP + ((size_t)bi * 256 + gr * 128 + (idx >> 3)) * 16 + (idx & 7) * 8);
            }
        }
        dcur = 0.f;
        if (w == 0 && lane < Lv) dcur = DT[(size_t)(t0x + lane) * 16 + h];
    };
    load_ops(0);

    for (int ch = 0; ch < nch; ++ch) {
        const int t0 = rowbase + ch * 64;
        bf16_t zr[8];
#pragma unroll
        for (int j = 0; j < 4; ++j)
#pragma unroll
            for (int i = 0; i < 2; ++i) {
                int t = ttile * 16 + fq * 4 + j; t = t < Lv ? t : Lv - 1;
                zr[j * 2 + i] = Zb[(size_t)(t0 + t) * 1024 + h * 64 + (half * 2 + i) * 16 + fr];
            }
        __syncthreads();
        if (w == 0) {
            const float c = wave_scan(dcur * a_h);
            const float c63 = __int_as_float(__builtin_amdgcn_readlane(__float_as_int(c), 63));
            cumv[lane] = c; dtv[lane] = dcur; scl[lane] = dcur * __expf(c63 - c);
        }
        *(u32x4*)(xT + xp * 72 + xc * 8) = lx;
#pragma unroll
        for (int q = 0; q < 2; ++q) {
            const int idx = tid + q * 512;
            *(u32x4*)(Bs + (idx >> 4) * 136 + (idx & 15) * 8) = lb[q];
            *(u32x4*)(Cs + (idx >> 4) * 136 + (idx & 15) * 8) = lc[q];
            *(u32x4*)(BT + (idx >> 3) * 72 + (idx & 7) * 8) = lbt[q];
        }
        __syncthreads();
        {
            const f32x4 s0 = *(const f32x4*)(scl + xc * 8), s1 = *(const f32x4*)(scl + xc * 8 + 4);
            u32x4 o;
            o.x = pk2(bflo(lx.x) * s0[0], bfhi(lx.x) * s0[1]); o.y = pk2(bflo(lx.y) * s0[2], bfhi(lx.y) * s0[3]);
            o.z = pk2(bflo(lx.z) * s1[0], bfhi(lx.z) * s1[1]); o.w = pk2(bflo(lx.w) * s1[2], bfhi(lx.w) * s1[3]);
            *(u32x4*)(xwT + xp * 72 + xc * 8) = o;
        }
        if (ch + 1 < nch) load_ops(ch + 1);
        f32x4 cb[2], yacc[2];
#pragma unroll
        for (int i = 0; i < 2; ++i) { cb[i] = (f32x4){0.f, 0.f, 0.f, 0.f}; yacc[i] = (f32x4){0.f, 0.f, 0.f, 0.f}; }
        {
            bf16x8 cf[4], bfr[4][2], hf[4][2];
#pragma unroll
            for (int ks = 0; ks < 4; ++ks) {
                cf[ks] = *(const bf16x8*)(Cs + (ttile * 16 + fr) * 136 + ks * 32 + fq * 8);
#pragma unroll
                for (int i = 0; i < 2; ++i) {
                    bfr[ks][i] = *(const bf16x8*)(Bs + ((half * 2 + i) * 16 + fr) * 136 + ks * 32 + fq * 8);
                    hf[ks][i] = *(const bf16x8*)(hb + ((half * 2 + i) * 16 + fr) * 136 + ks * 32 + fq * 8);
                }
            }
#pragma unroll
            for (int ks = 0; ks < 4; ++ks)
#pragma unroll
                for (int i = 0; i < 2; ++i) { cb[i] = mfma16(cf[ks], bfr[ks][i], cb[i]); yacc[i] = mfma16(cf[ks], hf[ks][i], yacc[i]); }
        }
#pragma unroll
        for (int j = 0; j < 4; ++j) {
            const int t = ttile * 16 + fq * 4 + j;
            const float ct = cumv[t];
            const float et = __expf(ct);
#pragma unroll
            for (int i = 0; i < 2; ++i) {
                const int s = (half * 2 + i) * 16 + fr;
                const float mv = (s <= t) ? cb[i][j] * __expf(ct - cumv[s]) * dtv[s] : 0.f;
                Ms[t * 72 + s] = f2bf(mv);
                yacc[i][j] *= et;
            }
        }
        __syncthreads();
        bf16x8 mf[2], xf[2][2], xwf[2], btf[2][4];
#pragma unroll
        for (int ks = 0; ks < 2; ++ks) {
            mf[ks] = *(const bf16x8*)(Ms + (ttile * 16 + fr) * 72 + ks * 32 + fq * 8);
#pragma unroll
            for (int i = 0; i < 2; ++i) xf[ks][i] = *(const bf16x8*)(xT + ((half * 2 + i) * 16 + fr) * 72 + ks * 32 + fq * 8);
            xwf[ks] = *(const bf16x8*)(xwT + (pts * 16 + fr) * 72 + ks * 32 + fq * 8);
#pragma unroll
            for (int i = 0; i < 4; ++i) btf[ks][i] = *(const bf16x8*)(BT + ((nt0 + i) * 16 + fr) * 72 + ks * 32 + fq * 8);
        }
#pragma unroll
        for (int ks = 0; ks < 2; ++ks)
#pragma unroll
            for (int i = 0; i < 2; ++i) yacc[i] = mfma16(mf[ks], xf[ks][i], yacc[i]);
        {
            float ssq[4] = {0.f, 0.f, 0.f, 0.f};
#pragma unroll
            for (int j = 0; j < 4; ++j) {
                const int t = ttile * 16 + fq * 4 + j;
                if (!samp || t < Lv) {
#pragma unroll
                    for (int i = 0; i < 2; ++i) {
                        const int pc = (half * 2 + i) * 16 + fr;
                        const float xv = bf2f(xT[pc * 72 + t]);
                        const float y = yacc[i][j] + Dh * xv;
                        const size_t zi = (size_t)(t0 + t) * 1024 + h * 64 + pc;
                        const float uu = y * siluf_(bf2f(zr[j * 2 + i]));
                        Zb[zi] = f2bf(uu);
                        ssq[j] += uu * uu;
                    }
                }
            }
#pragma unroll
            for (int j = 0; j < 4; ++j) {
                const float s = row16_sum(ssq[j]);
                const int t = ttile * 16 + fq * 4 + j;
                if (fr == 0 && (!samp || t < Lv)) ROWSS[(size_t)(t0 + t) * 32 + h * 2 + half] = s;
            }
        }
        const float dec = __expf(cumv[63]);
#pragma unroll
        for (int i = 0; i < 4; ++i) hacc[i] *= dec;
#pragma unroll
        for (int ks = 0; ks < 2; ++ks)
#pragma unroll
            for (int i = 0; i < 4; ++i) hacc[i] = mfma16(xwf[ks], btf[ks][i], hacc[i]);
#pragma unroll
        for (int i = 0; i < 4; ++i)
#pragma unroll
            for (int j = 0; j < 4; ++j) hb[(pts * 16 + fq * 4 + j) * 136 + (nt0 + i) * 16 + fr] = f2bf(hacc[i][j]);
    }
#pragma unroll
    for (int i = 0; i < 4; ++i)
#pragma unroll
        for (int j = 0; j < 4; ++j) stout[(pts * 16 + fq * 4 + j) * 128 + (nt0 + i) * 16 + fr] = hacc[i][j];
}

constexpr int N_OTHER = 512 + 512 + 512 + 64 + 128;
__device__ __forceinline__ void phase_mixers(int l, unsigned char* shm) {
    int* s_item = (int*)(shm + 131072);
    for (int it = blockIdx.x; it < 128; it += gridDim.x) ssd_item(kparams(), l, false, it >> 4, it & 15, shm);
    unsigned nxt_ticket = 0u;
    if (threadIdx.x == 0) nxt_ticket = atomicAdd((unsigned*)(kparams()->ws + W_CNT) + l, 1u);
    for (;;) {
        __syncthreads();
        if (threadIdx.x == 0) *s_item = (int)nxt_ticket;
        __syncthreads();
        int j = *s_item;
        if (j >= N_OTHER) break;
        const KP p = kparams();
        if (threadIdx.x == 0) nxt_ticket = atomicAdd((unsigned*)(p->ws + W_CNT) + l, 1u);
        if (j < 512) { attn_prompt_item(p, l, j, shm); continue; } j -= 512;
        if (j < 512) { gmlp_item(p, l, false, j >> 6, (j >> 2) & 15, j & 3, shm); continue; } j -= 512;
        if (j < 512) { ssd_item(p, l, true, j >> 4, j & 15, shm); continue; } j -= 512;
        if (j < 64) { attn_sample_item(p, l, j, shm); continue; } j -= 64;
        gmlp_item(p, l, true, j >> 2, 0, j & 3, shm);
    }
}

#define XB_TMO      128
#define XB_XCNT(j)  (256  + 64 * (j))
#define XB_XSUB(j)  (1280 + 64 * (j))
#define XB_XGEN(j)  (2304 + 64 * (j))
#define XB_TOP      3328
#define XB_TOPGEN   3392
#define XCD_BAR_WORDS 3456
#define XB_SPIN_CAP (1u << 18)
__device__ __forceinline__ unsigned xb_ld(unsigned* p)              { return __hip_atomic_load(p, __ATOMIC_RELAXED, __HIP_MEMORY_SCOPE_AGENT); }
__device__ __forceinline__ unsigned xb_add(unsigned* p, unsigned v) { return __hip_atomic_fetch_add(p, v, __ATOMIC_RELAXED, __HIP_MEMORY_SCOPE_AGENT); }
__device__ __forceinline__ unsigned xb_xcc_id() { return (unsigned)__builtin_amdgcn_s_getreg((3 << 11) | 20) & 0xFu; }
#define XB_SPIN(cond, bar) do { unsigned _sp = 0; while (cond) { __builtin_amdgcn_s_sleep(1); \
    if ((++_sp & 255u) == 0u) { if (xb_ld(&(bar)[XB_TMO])) break; if (_sp > XB_SPIN_CAP) { atomicAdd(&(bar)[XB_TMO], 1u); break; } } } } while (0)
struct XcdBarrier { unsigned* bar; unsigned x; volatile LAS unsigned* st; };
__device__ __forceinline__ XcdBarrier xcd_barrier_post(unsigned* bar, volatile LAS unsigned* st) {
    XcdBarrier b; b.bar = bar; b.x = xb_xcc_id(); b.st = st;
    if (threadIdx.x == 0) (void)xb_add(&bar[XB_XCNT(b.x)], 1u);
    return b;
}
__device__ __forceinline__ void xcd_barrier_complete(unsigned* bar, unsigned x, unsigned& nloc, unsigned& nx) {
    const unsigned G = gridDim.x * gridDim.y * gridDim.z;
    unsigned sum, cnt, mine, sp = 0u;
    for (;;) {
        sum = 0u; cnt = 0u; mine = 0u;
#pragma unroll
        for (unsigned j = 0; j < 16; ++j) { const unsigned c = xb_ld(&bar[XB_XCNT(j)]); sum += c; cnt += (c > 0u) ? 1u : 0u; mine = (j == x) ? c : mine; }
        if (sum == G) break;
        __builtin_amdgcn_s_sleep(1);
        if ((++sp & 255u) == 0u) { if (xb_ld(&bar[XB_TMO])) break; if (sp > XB_SPIN_CAP) { atomicAdd(&bar[XB_TMO], 1u); break; } }
    }
    nloc = mine > 0u ? mine : 1u; nx = cnt > 0u ? cnt : 1u;
}
__device__ __forceinline__ void xcd_barrier(const XcdBarrier& b) {
    asm volatile("s_waitcnt vmcnt(0)" ::: "memory");
    __syncthreads();
    if (threadIdx.x == 0) {
        unsigned* bar = b.bar;
        __builtin_amdgcn_s_waitcnt(0);
        unsigned nloc = b.st[0], nx = b.st[1];
        if (nloc == 0u) { xcd_barrier_complete(bar, b.x, nloc, nx); b.st[0] = nloc; b.st[1] = nx; }
        const unsigned old = xb_add(&bar[XB_XSUB(b.x)], 1u);
        const unsigned gen = old / nloc;
        if (old + 1u == (gen + 1u) * nloc) {
            __builtin_amdgcn_fence(__ATOMIC_RELEASE, "agent");
            asm volatile("s_waitcnt vmcnt(0)" ::: "memory");
            const unsigned og = xb_add(&bar[XB_TOP], 1u);
            const unsigned tg = og / nx;
            if (og + 1u == (tg + 1u) * nx) xb_add(&bar[XB_TOPGEN], 1u);
            else XB_SPIN(xb_ld(&bar[XB_TOPGEN]) == tg, bar);
            __builtin_amdgcn_fence(__ATOMIC_ACQUIRE, "agent");
            xb_add(&bar[XB_XGEN(b.x)], 1u);
            asm volatile("s_waitcnt vmcnt(0)" ::: "memory");
        } else {
            XB_SPIN(xb_ld(&bar[XB_XGEN(b.x)]) == gen, bar);
            __builtin_amdgcn_fence(__ATOMIC_ACQUIRE, "agent");
            asm volatile("s_waitcnt vmcnt(0)" ::: "memory");
        }
    }
    __syncthreads();
}
__device__ __forceinline__ void grid_seam(unsigned char* shm) {
    XcdBarrier b; b.bar = (unsigned*)(kparams()->ws + W_BAR); b.x = xb_xcc_id(); b.st = (volatile LAS unsigned*)(LAS unsigned char*)(shm + 131072 + 16);
    xcd_barrier(b);
}

__global__ void __launch_bounds__(512, 2) fwd_kernel(Params p_unused) {
    extern __shared__ __attribute__((aligned(16))) unsigned char shm[];
    cg::grid_group grid = cg::this_grid();
    LAS unsigned char* lds = (LAS unsigned char*)shm;
    const int tid = tid_();
#if PROBE_MASK
    unsigned long long probe_acc = 0;
#endif

    {
        if (tid == 0) { volatile LAS unsigned* st = (volatile LAS unsigned*)(LAS unsigned char*)(shm + 131072 + 16); st[0] = 0u; st[1] = 0u; }
        __syncthreads();
        const KP p = kparams();
        (void)xcd_barrier_post((unsigned*)(p->ws + W_BAR), (volatile LAS unsigned*)(LAS unsigned char*)(shm + 131072 + 16));
        if (p->ws == nullptr) grid.sync();
    }
    PH_BEGIN(0);
    phase_mod(kparams(), (float*)shm);
    {
        const KP p = kparams();
        unsigned char* ws = p->ws;
        f32x2* rope = (f32x2*)(ws + W_ROPE);
        for (int idx = blockIdx.x * 512 + tid_(); idx < 2064 * 8; idx += gridDim.x * 512) {
            const int pi = idx >> 3, j = idx & 7;
            const float pos = (float)(pi < 2048 ? pi : 4096 + (pi - 2048));
            const float invf = exp2f(-(float)j * 0.125f * 18.931568569324174f);
            const float ang = pos * invf;
            const double a = (double)ang;
            const double kk = rint(a * 0.15915494309189535);
            const float r = (float)(a - kk * 6.283185307179586);
            rope[idx] = (f32x2){__cosf(r), __sinf(r)};
        }
        if (blockIdx.x == 0 && tid < 64) ((unsigned*)(ws + W_CNT))[tid] = 0u;
    }
    convert_weights(kparams(), 0, (float*)shm);
    grid_seam(shm);
    PH_END(0);

#pragma unroll 1
    for (int l = 0; l < 2; ++l) {
        PH_BEGIN(1);
        {
            const KP p = kparams();
            float* X = p->out + O_Y;
            phase_norm(p, l, l == 0 ? p->x_prompt : X, l == 0 ? p->x_sample : X + (size_t)TP * 1024, p->g_mix + l * 1024, 0);
        }
        if (l == 1) {
            convert_weights(kparams(), 1, (float*)shm);
        }
        grid_seam(shm);
        PH_END(1);
        PH_BEGIN(2);
        {
            const KP p = kparams();
            const bf16_t* H = (const bf16_t*)(p->ws + W_H); const bf16_t* WT = (const bf16_t*)(p->ws + W_WT);
            pg8::StaticOrder S; S.init(T, NINP, (int)gridDim.x, (int)blockIdx.x);
            EpiIn E; E.l = l; E.pp = p;
            pg8::gemm_phase(lds, pg8::Gemm{H, WT + WT_IN, T, NINP, 1024}, S, E);
        }
        grid_seam(shm);
        PH_END(2);
        PH_BEGIN(3);
        conv_prepass(kparams(), l, shm);
        grid_seam(shm);
        phase_mixers(l, shm);
        grid_seam(shm);
        PH_END(3);
        PH_BEGIN(4);
#pragma unroll 1
        for (int b = 0; b < 3; ++b) {
            const KP p = kparams();
            unsigned char* ws = p->ws;
            const bf16_t* WT = (const bf16_t*)(ws + W_WT);
            const bf16_t* A = (const bf16_t*)(ws + (b == 0 ? W_Q : (b == 1 ? W_Z : W_GU)));
            const bf16_t* Bt = WT + (b == 0 ? WT_AO : (b == 1 ? WT_SO : WT_GO));
            const int K = b == 1 ? 1024 : 512;
            EpiRC<FMergeT<true>, 4> E; E.f.b = b; E.f.G8 = ws + W_G8; E.f.rowss = (const float*)(ws + W_ROWSS); E.f.MG = (bf16_t*)(ws + W_H);
            pg8::StaticOrder S; S.init(TP, 1024, (int)gridDim.x, (int)blockIdx.x);
            E.f.tile_rstd = (const float*)(shm + 131072 + 512); E.f.tile_row0 = 0;
            if (b == 1) {
                pg8::Unit u0;
                if (S.next(0, u0)) {
                    E.f.tile_row0 = u0.pm * 256;
                    const int t2 = tid_();
                    if (t2 < 256) {
                        const f32x4* pp = (const f32x4*)((const float*)(ws + W_ROWSS) + (size_t)(u0.pm * 256 + t2) * 32);
                        const f32x4 t = ((pp[0] + pp[1]) + (pp[2] + pp[3])) + ((pp[4] + pp[5]) + (pp[6] + pp[7]));
                        ((float*)(shm + 131072 + 512))[t2] = rsqrtf(((t[0] + t[1]) + (t[2] + t[3])) * (1.f / 1024.f) + EPSF);
                    }
                }
                __syncthreads();
            }
            pg8::gemm_phase(lds, pg8::Gemm{A, Bt, TP, 1024, K}, S, E);
            FMergeT<false> fs2; fs2.b = b; fs2.G8 = E.f.G8; fs2.rowss = E.f.rowss; fs2.MG = E.f.MG; fs2.tile_rstd = nullptr; fs2.tile_row0 = 0;
            if (K == 512) skinny_gemm<64>(shm, A + (size_t)TP * K, Bt, 1024, fs2); else skinny_gemm<128>(shm, A + (size_t)TP * K, Bt, 1024, fs2);
        }
        grid_seam(shm);
        PH_END(4);
#pragma unroll 1
        for (int s2 = 0; s2 < 2; ++s2) {
            PH_BEGIN(5);
            {
                const KP p = kparams();
                unsigned char* ws = p->ws;
                float* X = p->out + O_Y;
                const bf16_t* WT = (const bf16_t*)(ws + W_WT);
                const bf16_t* A = (const bf16_t*)(ws + (s2 == 0 ? W_H : W_FH));
                const bf16_t* Bt = WT + (s2 == 0 ? WT_OUT : WT_F2);
                const int K = s2 == 0 ? 1024 : 4096;
                const bool first = (l == 0 && s2 == 0);
                FResid fs; fs.srcP = first ? p->x_prompt : X; fs.srcS = first ? p->x_sample : X + (size_t)TP * 1024; fs.X = X;
                fs.modg = (const float*)(ws + W_MOD) + (size_t)l * 40 * 6144 + (s2 == 0 ? 2 : 5) * 1024;
                EpiResidP E; E.src = fs.srcP; E.X = X; E.modg = fs.modg;
                pg8::StaticOrder S; S.init(TP, 1024, (int)gridDim.x, (int)blockIdx.x);
                pg8::gemm_phase(lds, pg8::Gemm{A, Bt, TP, 1024, K}, S, E);
                if (s2 == 0) skinny_gemm<128>(shm, A + (size_t)TP * K, Bt, 1024, fs); else skinny_gemm<512>(shm, A + (size_t)TP * K, Bt, 1024, fs);
            }
            grid_seam(shm);
            PH_END(5);
            if (s2 == 0) {
                PH_BEGIN(6);
                {
                    const KP p = kparams();
                    float* X = p->out + O_Y;
                    phase_norm(p, l, X, X + (size_t)TP * 1024, p->g_ff + l * 1024, 3);
                }
                grid_seam(shm);
                PH_END(6);
                PH_BEGIN(7);
                {
                    const KP p = kparams();
                    unsigned char* ws = p->ws;
                    const bf16_t* H = (const bf16_t*)(ws + W_H); const bf16_t* WT = (const bf16_t*)(ws + W_WT);
                    EpiRC<FRelu2> E; E.f.FH = (bf16_t*)(ws + W_FH);
                    pg8::StaticOrder S; S.init(TP, 4096, (int)gridDim.x, (int)blockIdx.x);
                    pg8::gemm_phase(lds, pg8::Gemm{H, WT + WT_F1, TP, 4096, 1024}, S, E);
                    skinny_gemm<128>(shm, H + (size_t)TP * 1024, WT + WT_F1, 4096, E.f);
                }
                grid_seam(shm);
                PH_END(7);
            }
        }
    }
    {
        const KP p = kparams();
        float* X = p->out + O_Y;
        const float* gf = p->g_final;
        const int tidf = tid_(), lane = tidf & 63, gw = blockIdx.x * 8 + (tidf >> 6), ngw = gridDim.x * 8;
        for (int row = gw; row < T; row += ngw) {
            f32x4* xr = (f32x4*)(X + (size_t)row * 1024);
            f32x4 v[4]; float ss = 0.f;
#pragma unroll
            for (int j = 0; j < 4; ++j) { v[j] = xr[lane + 64 * j]; ss += v[j][0] * v[j][0] + v[j][1] * v[j][1] + v[j][2] * v[j][2] + v[j][3] * v[j][3]; }
            ss = wave_sum(ss);
            const float rstd = rsqrtf(ss * (1.f / 1024.f) + EPSF);
#pragma unroll
            for (int j = 0; j < 4; ++j) { const f32x4 g = ((const f32x4*)gf)[lane + 64 * j]; xr[lane + 64 * j] = v[j] * rstd * g; }
        }
    }
#if PROBE_MASK
    { const unsigned long long t0 = wall_clock64(); while (wall_clock64() - t0 < probe_acc) __builtin_amdgcn_s_sleep(8); }
#endif
}

extern "C" void kernel_launch(void* const* d_in, const int* in_sizes, int n_in, void* d_out, int out_size, void* d_ws, size_t ws_size, hipStream_t stream) {
    static int grid_blocks = 0;
    if (!grid_blocks) {
        int dev = 0, cus = 0, per_cu = 0;
        hipGetDevice(&dev);
        hipDeviceGetAttribute(&cus, hipDeviceAttributeMultiprocessorCount, dev);
        hipFuncSetAttribute((const void*)fwd_kernel, hipFuncAttributeMaxDynamicSharedMemorySize, LDS_BYTES);
        hipOccupancyMaxActiveBlocksPerMultiprocessor(&per_cu, (const void*)fwd_kernel, 512, LDS_BYTES);
        if (per_cu < 1) per_cu = 1;
        grid_blocks = cus * per_cu;
        if (ws_size < W_END) fprintf(stderr, "kernel_launch: workspace too small: need %zu, got %zu\n", (size_t)W_END, ws_size);
    }
    Params p{};
    const float** fp = (const float**)&p;
    for (int i = 0; i < 31; ++i) fp[i] = (const float*)d_in[i];
    p.out = (float*)d_out; p.ws = (unsigned char*)d_ws;
    (void)hipMemsetAsync((unsigned char*)d_ws + W_BAR, 0, XCD_BAR_WORDS * 4, stream);
    void* args[] = {&p};
    hipError_t e = hipLaunchCooperativeKernel((const void*)fwd_kernel, dim3(grid_blocks), dim3(512), args, LDS_BYTES, stream);
    if (e != hipSuccess) fprintf(stderr, "cooperative launch failed: %s (grid %d)\n", hipGetErrorString(e), grid_blocks);
}
```

```cpp
#include <hip/hip_runtime.h>
#include <hip/hip_cooperative_groups.h>
#include <cstdio>
namespace cg = cooperative_groups;

#define LAS __attribute__((address_space(3)))
typedef unsigned short bf16_t;
typedef short bf16x8 __attribute__((ext_vector_type(8)));
typedef float f32x4 __attribute__((ext_vector_type(4)));
typedef float f32x2 __attribute__((ext_vector_type(2)));
typedef unsigned u32x2 __attribute__((ext_vector_type(2)));
typedef unsigned u32x4 __attribute__((ext_vector_type(4)));

constexpr int DM = 1024, TP = 16384, TS = 512, T = TP + TS;
constexpr int NINP = 7680;
constexpr float EPSF = 1e-6f;

constexpr size_t O_Y = 0;
constexpr size_t O_KP = (size_t)T * DM;
constexpr size_t O_VP = O_KP + 2 * 8 * 128 * 128;
constexpr size_t O_SP = O_VP + 2 * 8 * 128 * 128;
constexpr size_t O_CP = O_SP + (size_t)2 * 8 * 16 * 64 * 128;
constexpr size_t O_KS = O_CP + 2 * 8 * 3 * 1536;
constexpr size_t O_VS = O_KS + 2 * 32 * 16 * 128;
constexpr size_t O_SS = O_VS + 2 * 32 * 16 * 128;
constexpr size_t O_CS = O_SS + (size_t)2 * 32 * 16 * 64 * 128;
constexpr size_t O_GS = O_CS + 2 * 32 * 3 * 1536;

constexpr size_t WT_IN = 0;
constexpr size_t WT_AO = WT_IN + (size_t)NINP * 1024;
constexpr size_t WT_SO = WT_AO + 1024 * 512;
constexpr size_t WT_GO = WT_SO + 1024 * 1024;
constexpr size_t WT_OUT = WT_GO + 1024 * 512;
constexpr size_t WT_F1 = WT_OUT + 1024 * 1024;
constexpr size_t WT_F2 = WT_F1 + (size_t)4096 * 1024;
constexpr size_t WT_END = WT_F2 + (size_t)1024 * 4096;

constexpr size_t al256(size_t x) { return (x + 255) & ~(size_t)255; }
constexpr size_t W_WT = 0;
constexpr size_t W_MOD = al256(W_WT + WT_END * 2);
constexpr size_t W_ROPE = al256(W_MOD + (size_t)2 * 40 * 6144 * 4);
constexpr size_t W_ROWSS = al256(W_ROPE + (size_t)2064 * 8 * 8);
constexpr size_t W_CNT = al256(W_ROWSS + (size_t)T * 32 * 4);
constexpr size_t W_BAR = al256(W_CNT + 256);
constexpr size_t W_DT = al256(W_BAR + 3456 * 4);
constexpr size_t W_H = al256(W_DT + (size_t)T * 16 * 4);
constexpr size_t W_Q = al256(W_H + (size_t)T * 1024 * 2);
constexpr size_t W_K = W_Q + (size_t)T * 512 * 2;
constexpr size_t W_V = W_K + (size_t)T * 128 * 2;
constexpr size_t W_Z = W_V + (size_t)T * 128 * 2;
constexpr size_t W_XBC = W_Z + (size_t)T * 1024 * 2;
constexpr size_t W_GU = W_XBC + (size_t)T * 1536 * 2;
constexpr size_t W_GV = W_GU + (size_t)T * 512 * 2;
constexpr size_t W_PAEND = W_GV + (size_t)T * 512 * 2;
constexpr size_t W_FH = W_Q;
constexpr size_t W_G8 = al256(W_PAEND);
constexpr size_t W_BCN = al256(W_G8 + (size_t)T * 3072);
constexpr size_t W_BT = al256(W_BCN + (size_t)T * 512 * 2);
constexpr size_t W_END = W_BT + ((size_t)256 * 256 * 64 + (size_t)32 * 256 * 16) * 2;
static_assert((size_t)T * 4096 * 2 <= W_PAEND - W_Q, "FH alias");

constexpr int LDS_BYTES = 131072 + 2048;
#ifndef PROBE_MASK
#define PROBE_MASK 0
#endif
#if PROBE_MASK
#define PH_BEGIN(id) const unsigned long long _t_##id = wall_clock64()
#define PH_END(id) do { if ((PROBE_MASK >> (id)) & 1) probe_acc += wall_clock64() - _t_##id; } while (0)
#else
#define PH_BEGIN(id) do {} while (0)
#define PH_END(id) do {} while (0)
#endif

struct Params {
    const float *x_prompt, *x_sample, *c_prompt, *c_sample, *cache_k, *cache_v, *state_ssm, *state_conv;
    const float *w_ada, *b_ada, *g_mix, *w_in, *sinks, *conv_w, *conv_b, *dt_bias, *a_log, *d_skip, *ssm_norm_w;
    const float *gm_ln_g, *gm_ln_b, *gm_w_s, *gm_b_s, *w_attn_o, *w_ssm_o, *w_gm_o, *w_out, *g_ff, *w_ff1, *w_ff2, *g_final;
    float* out;
    unsigned char* ws;
};

typedef const Params __attribute__((address_space(4)))* KP;
__device__ __forceinline__ KP kparams() { KP q = (KP)__builtin_amdgcn_kernarg_segment_ptr(); asm volatile("" : "+s"(q)); return q; }

__device__ __forceinline__ int tid_() { int t = threadIdx.x; asm volatile("" : "+v"(t)); return t; }
__device__ __forceinline__ unsigned pk2(float lo, float hi) { unsigned r; asm("v_cvt_pk_bf16_f32 %0, %1, %2" : "=v"(r) : "v"(lo), "v"(hi)); return r; }
__device__ __forceinline__ bf16_t f2bf(float f) { return (bf16_t)(pk2(f, 0.f) & 0xffffu); }
__device__ __forceinline__ float bf2f(bf16_t b) { return __uint_as_float(((unsigned)b) << 16); }
__device__ __forceinline__ float bflo(unsigned u) { return __uint_as_float(u << 16); }
__device__ __forceinline__ float bfhi(unsigned u) { return __uint_as_float(u & 0xffff0000u); }
__device__ __forceinline__ float sigm(float x) { return __builtin_amdgcn_rcpf(1.f + __expf(-x)); }
__device__ __forceinline__ float siluf_(float x) { return x * sigm(x); }
__device__ __forceinline__ float geluf_(float x) { return x * sigm(1.5957691216057308f * (x + 0.044715f * x * x * x)); }
__device__ __forceinline__ float wave_sum(float v) {
#pragma unroll
    for (int o = 1; o < 64; o <<= 1) v += __shfl_xor(v, o);
    return v;
}
__device__ __forceinline__ u32x4 zero4() { unsigned z; asm volatile("v_mov_b32 %0, 0" : "=v"(z)); return (u32x4){z, z, z, z}; }
template <int CTRL, int RM = 0xf, int BK = 0xf>
__device__ __forceinline__ float dpp_add(float v) { return v + __int_as_float(__builtin_amdgcn_update_dpp(0, __float_as_int(v), CTRL, RM, BK, false)); }
__device__ __forceinline__ float row16_sum(float v) { v = dpp_add<0xB1>(v); v = dpp_add<0x4E>(v); v = dpp_add<0x141>(v); return dpp_add<0x140>(v); }
__device__ __forceinline__ float wave_scan(float c) { c = dpp_add<0x111>(c); c = dpp_add<0x112>(c); c = dpp_add<0x114>(c); c = dpp_add<0x118>(c); c = dpp_add<0x142, 0xa>(c); return dpp_add<0x143, 0xc>(c); }
__device__ __forceinline__ f32x4 mfma16(bf16x8 a, bf16x8 b, f32x4 c) { return __builtin_amdgcn_mfma_f32_16x16x32_bf16(a, b, c, 0, 0, 0); }
__device__ __forceinline__ int mod_row(int row) { return row < TP ? (row >> 11) : 8 + ((row - TP) >> 4); }

namespace pg8 {
constexpr int BM = 256, BK = 64, HALF = 128, HTB = HALF * BK * 2, STAGE_BYTES = 8 * HTB, NXCD = 8, WGM = 8;
__device__ __forceinline__ int lds_byte(int r, int c) { const int st = (r >> 4) * 2 + (c >> 5), rr = r & 15, cc = c & 31, ob = rr * 64 + cc * 2; return st * 1024 + (ob ^ (((ob >> 9) & 1) << 5)); }
__device__ __forceinline__ void stage_rc(int b, int& R, int& C) { const int st = b / 1024, sb = b % 1024, swz = sb ^ (((sb >> 9) & 1) << 5); R = (st >> 1) * 16 + swz / 64; C = (st & 1) * 32 + (swz % 64) / 2; }
struct Unit { int pm, pn; };
struct Gemm { const bf16_t* A; const bf16_t* Bt; int M, N, K; };
struct StaticOrder {
    int nM, nN, nwg, G, c;
    __device__ __forceinline__ void init(int M, int N, int G_, int c_) { nM = M / BM; nN = N / BM; nwg = nM * nN; G = G_; c = c_; }
    __device__ __forceinline__ bool next(int i, Unit& u) const {
        const long L = (long)i * G + c; if (L >= nwg) return false;
        int wgid = (int)L; { const int q = nwg / NXCD, r = nwg % NXCD, xcd = wgid % NXCD, off = wgid / NXCD; wgid = (xcd < r ? xcd * (q + 1) : r * (q + 1) + (xcd - r) * q) + off; }
        const int nig = WGM * nN, gid = wgid / nig, fm = gid * WGM, gsz = (nM - fm) < WGM ? (nM - fm) : WGM;
        u.pm = fm + ((wgid % nig) % gsz); u.pn = (wgid % nig) / gsz; return true;
    }
};
template <class Epi>
__device__ __forceinline__ void gemm_phase(LAS unsigned char* lds, const Gemm g, const StaticOrder& S, const Epi& E) {
    const int tid = tid_(), wid = __builtin_amdgcn_readfirstlane(tid >> 6), lane = tid & 63, wr = wid >> 2, wc = wid & 3, fr = lane & 15, fq = lane >> 4;
    const int K = g.K, nt = K / BK;
    unsigned voffA[2], voffB[2];
#pragma unroll
    for (int i = 0; i < 2; ++i) { int R, C; stage_rc(tid * 16 + i * 8192, R, C); voffA[i] = (unsigned)(R * K + C) * 2u; voffB[i] = voffA[i]; }
    const size_t kstep = (size_t)(BK * 2);
    const size_t hstep = (size_t)HALF * K * 2;
    const size_t tstep = 2 * hstep;
    const unsigned ldsw = (unsigned)wid * 1024u;
    const int aoff = lds_byte(wr * 64 + fr, fq * 8), boff = lds_byte(wc * 32 + fr, fq * 8);
#define PG8_SA(b, h) (((b) * 2 + (h)) * HTB)
#define PG8_SB(b, h) ((4 + (b) * 2 + (h)) * HTB)
#define PG8_STAGE(bufoff, gbase, voff) do { _Pragma("unroll") for (int _i = 0; _i < 2; ++_i) \
        __builtin_amdgcn_global_load_lds((const unsigned*)((const char*)(gbase) + (voff)[_i]), (LAS unsigned*)(lds + (bufoff) + ldsw + _i * 8192), 16, 0, 0); } while (0)
#define PG8_LDA(dst, b, h) do { _Pragma("unroll") for (int m = 0; m < 4; ++m) _Pragma("unroll") for (int k = 0; k < 2; ++k) dst[m][k] = *(const LAS bf16x8*)(lds + PG8_SA(b, h) + aoff + m * 2048 + k * 1024); } while (0)
#define PG8_LDB(dst, b, h) do { _Pragma("unroll") for (int n = 0; n < 2; ++n) _Pragma("unroll") for (int k = 0; k < 2; ++k) dst[n][k] = *(const LAS bf16x8*)(lds + PG8_SB(b, h) + boff + n * 2048 + k * 1024); } while (0)
#define PG8_MMA(ai, bj, At, Bt) do { __builtin_amdgcn_s_setprio(1); _Pragma("unroll") for (int m = 0; m < 4; ++m) _Pragma("unroll") for (int n = 0; n < 2; ++n) _Pragma("unroll") for (int k = 0; k < 2; ++k) \
        acc[ai][bj][m][n] = __builtin_amdgcn_mfma_f32_16x16x32_bf16(Bt[n][k], At[m][k], acc[ai][bj][m][n], 0, 0, 0); __builtin_amdgcn_s_setprio(0); } while (0)
#define PG8_WAIT_V(n) asm volatile("s_waitcnt vmcnt(" #n ")" ::: "memory")
#define PG8_WAIT_L(n) asm volatile("s_waitcnt lgkmcnt(" #n ")" ::: "memory")
#define PG8_BAR __builtin_amdgcn_s_barrier()
#define PG8_SCHED __builtin_amdgcn_sched_barrier(0)
    Unit cur, nxt; int ui = 0;
    if (!S.next(0, cur)) return;
    f32x4 acc[2][2][4][2];
#pragma unroll
    for (int a = 0; a < 2; ++a)
#pragma unroll
        for (int b = 0; b < 2; ++b)
#pragma unroll
            for (int m = 0; m < 4; ++m)
#pragma unroll
                for (int n = 0; n < 2; ++n) acc[a][b][m][n] = (f32x4){0.f, 0.f, 0.f, 0.f};
    bf16x8 At[4][2], B0[2][2], B1[2][2];
    const char* cA = (const char*)g.A + (size_t)cur.pm * tstep; const char* cB = (const char*)g.Bt + (size_t)cur.pn * tstep;
    PG8_STAGE(PG8_SB(0, 0), cB, voffB); PG8_STAGE(PG8_SA(0, 0), cA, voffA); PG8_STAGE(PG8_SB(0, 1), cB + hstep, voffB); PG8_STAGE(PG8_SA(0, 1), cA + hstep, voffA);
    if (wr == 1) PG8_BAR;
    PG8_WAIT_V(4); PG8_BAR;
    PG8_STAGE(PG8_SB(1, 0), cB + kstep, voffB); PG8_STAGE(PG8_SA(1, 0), cA + kstep, voffA); PG8_STAGE(PG8_SB(1, 1), cB + hstep + kstep, voffB);
    PG8_WAIT_V(6); PG8_BAR;
    for (;;) {
        const bool has_next = S.next(ui + 1, nxt);
        const char* nA = has_next ? (const char*)g.A + (size_t)nxt.pm * tstep : cA; const char* nB = has_next ? (const char*)g.Bt + (size_t)nxt.pn * tstep : cB;
        for (int t = 0; t < nt; t += 2) {
            const bool last = (t == nt - 2);
            const char* a1 = cA + (size_t)(t + 1) * kstep;
            const char* a2 = last ? nA : cA + (size_t)(t + 2) * kstep; const char* b2 = last ? nB : cB + (size_t)(t + 2) * kstep;
            const char* a3 = a2 + kstep; const char* b3 = b2 + kstep;
            PG8_LDB(B0, 0, 0); PG8_SCHED; PG8_LDA(At, 0, 0); PG8_STAGE(PG8_SA(1, 1), a1 + hstep, voffA);
            PG8_WAIT_L(8); PG8_BAR; PG8_WAIT_L(0); PG8_MMA(0, 0, At, B0); PG8_BAR; PG8_SCHED;
            PG8_LDB(B1, 0, 1); PG8_STAGE(PG8_SB(0, 0), b2, voffB);
            PG8_BAR; PG8_WAIT_L(0); PG8_MMA(0, 1, At, B1); PG8_BAR;
            PG8_LDA(At, 0, 1); PG8_STAGE(PG8_SA(0, 0), a2, voffA);
            PG8_BAR; PG8_WAIT_L(0); PG8_MMA(1, 0, At, B0); PG8_BAR; PG8_SCHED;
            PG8_STAGE(PG8_SB(0, 1), b2 + hstep, voffB);
            PG8_WAIT_V(6); PG8_BAR; PG8_MMA(1, 1, At, B1); PG8_BAR;
            PG8_LDB(B0, 1, 0); PG8_SCHED; PG8_LDA(At, 1, 0); PG8_STAGE(PG8_SA(0, 1), a2 + hstep, voffA);
            PG8_WAIT_L(8); PG8_BAR; PG8_WAIT_L(0); PG8_MMA(0, 0, At, B0); PG8_BAR; PG8_SCHED;
            PG8_LDB(B1, 1, 1); PG8_STAGE(PG8_SB(1, 0), b3, voffB);
            PG8_BAR; PG8_WAIT_L(0); PG8_MMA(0, 1, At, B1); PG8_BAR;
            PG8_LDA(At, 1, 1); PG8_STAGE(PG8_SA(1, 0), a3, voffA);
            PG8_BAR; PG8_WAIT_L(0); PG8_MMA(1, 0, At, B0); PG8_BAR; PG8_SCHED;
            PG8_STAGE(PG8_SB(1, 1), b3 + hstep, voffB);
            PG8_WAIT_V(6); PG8_BAR; PG8_MMA(1, 1, At, B1); PG8_BAR;
        }
        E(acc, cur, wr, wc, fr, fq);
        if (!has_next) break;
#pragma unroll
        for (int a = 0; a < 2; ++a)
#pragma unroll
            for (int b = 0; b < 2; ++b)
#pragma unroll
                for (int m = 0; m < 4; ++m)
#pragma unroll
                    for (int n = 0; n < 2; ++n) acc[a][b][m][n] = (f32x4){0.f, 0.f, 0.f, 0.f};
        cur = nxt; cA = nA; cB = nB; ++ui;
    }
    PG8_WAIT_V(0);
    if (wr == 0) PG8_BAR;
    PG8_BAR;
#undef PG8_SA
#undef PG8_SB
#undef PG8_STAGE
#undef PG8_LDA
#undef PG8_LDB
#undef PG8_MMA
#undef PG8_WAIT_V
#undef PG8_WAIT_L
#undef PG8_BAR
#undef PG8_SCHED
}
}

template <class F, int MG = 2> struct EpiRC {
    F f;
    __device__ __forceinline__ void operator()(const f32x4 (&acc)[2][2][4][2], const pg8::Unit& u, int wr, int wc, int fr, int fq) const {
        const int row0 = u.pm * 256 + wr * 64 + fr, col0 = u.pn * 256 + wc * 32 + 4 * fq;
#pragma unroll
        for (int ai = 0; ai < 2; ++ai)
#pragma unroll
            for (int mh = 0; mh < 4 / MG; ++mh) {
                typename F::Ld ld[MG][2][2];
#pragma unroll
                for (int mm = 0; mm < MG; ++mm)
#pragma unroll
                    for (int bj = 0; bj < 2; ++bj)
#pragma unroll
                        for (int n = 0; n < 2; ++n) f.load(row0 + ai * 128 + (mh * MG + mm) * 16, col0 + bj * 128 + n * 16, ld[mm][bj][n]);
#pragma unroll
                for (int mm = 0; mm < MG; ++mm)
#pragma unroll
                    for (int bj = 0; bj < 2; ++bj)
#pragma unroll
                        for (int n = 0; n < 2; ++n) f.apply(row0 + ai * 128 + (mh * MG + mm) * 16, col0 + bj * 128 + n * 16, acc[ai][bj][mh * MG + mm][n], ld[mm][bj][n]);
            }
    }
};
struct EpiResidP {
    const float* src; float* X; const float* modg;
    __device__ __forceinline__ void operator()(const f32x4 (&acc)[2][2][4][2], const pg8::Unit& u, int wr, int wc, int fr, int fq) const {
        const int row0 = u.pm * 256 + wr * 64 + fr, col0 = u.pn * 256 + wc * 32 + 4 * fq;
        const float* gp = modg + (size_t)((u.pm * 256) >> 11) * 6144 + col0;
        f32x4 g[2][2];
#pragma unroll
        for (int bj = 0; bj < 2; ++bj)
#pragma unroll
            for (int n = 0; n < 2; ++n) g[bj][n] = *(const f32x4*)(gp + bj * 128 + n * 16);
#pragma unroll
        for (int ai = 0; ai < 2; ++ai) {
            f32x4 x[4][2][2];
#pragma unroll
            for (int m = 0; m < 4; ++m)
#pragma unroll
                for (int bj = 0; bj < 2; ++bj)
#pragma unroll
                    for (int n = 0; n < 2; ++n) x[m][bj][n] = *(const f32x4*)(src + (size_t)(row0 + ai * 128 + m * 16) * 1024 + col0 + bj * 128 + n * 16);
#pragma unroll
            for (int m = 0; m < 4; ++m)
#pragma unroll
                for (int bj = 0; bj < 2; ++bj)
#pragma unroll
                    for (int n = 0; n < 2; ++n) *(f32x4*)(X + (size_t)(row0 + ai * 128 + m * 16) * 1024 + col0 + bj * 128 + n * 16) = x[m][bj][n] + g[bj][n] * acc[ai][bj][m][n];
        }
    }
};

template <int KW, class F>
__device__ __forceinline__ void skinny_gemm(unsigned char* shm, const bf16_t* A, const bf16_t* Bt, int N, const F& f) {
    constexpr int K = KW * 8, NS = KW / 32 < 4 ? KW / 32 : 4, NSTEP = KW / 32;
    const int tid = tid_(), w = tid >> 6, lane = tid & 63, fr = lane & 15, fq = lane >> 4;
    f32x4* red = (f32x4*)shm;
    const int nun = 16 * (N / 64);
    for (int u = blockIdx.x; u < nun; u += gridDim.x) {
        const int m0 = (u & 15) * 32, n0 = (u >> 4) * 64;
        typename F::Ld eld; const int er = TP + m0 + (w >> 2) * 16 + fr, ec = n0 + (w & 3) * 16 + fq * 4; f.load(er, ec, eld);
        f32x4 acc[2][4];
#pragma unroll
        for (int i = 0; i < 2; ++i)
#pragma unroll
            for (int j = 0; j < 4; ++j) acc[i][j] = (f32x4){0.f, 0.f, 0.f, 0.f};
        const bf16_t* ap = A + (size_t)(m0 + fr) * K + w * KW + fq * 8;
        const bf16_t* bp = Bt + (size_t)(n0 + fr) * K + w * KW + fq * 8;
        bf16x8 ra[NS][2], rb[NS][4];
#pragma unroll
        for (int s = 0; s < NS; ++s) {
#pragma unroll
            for (int i = 0; i < 2; ++i) ra[s][i] = *(const bf16x8*)(ap + (size_t)i * 16 * K + s * 32);
#pragma unroll
            for (int j = 0; j < 4; ++j) rb[s][j] = *(const bf16x8*)(bp + (size_t)j * 16 * K + s * 32);
        }
#pragma unroll
        for (int st = 0; st < NSTEP; ++st) {
            const int s = st % NS;
#pragma unroll
            for (int i = 0; i < 2; ++i)
#pragma unroll
                for (int j = 0; j < 4; ++j) acc[i][j] = mfma16(rb[s][j], ra[s][i], acc[i][j]);
            if (st + NS < NSTEP) {
#pragma unroll
                for (int i = 0; i < 2; ++i) ra[s][i] = *(const bf16x8*)(ap + (size_t)i * 16 * K + (st + NS) * 32);
#pragma unroll
                for (int j = 0; j < 4; ++j) rb[s][j] = *(const bf16x8*)(bp + (size_t)j * 16 * K + (st + NS) * 32);
            }
        }
        __syncthreads();
#pragma unroll
        for (int i = 0; i < 2; ++i)
#pragma unroll
            for (int j = 0; j < 4; ++j) red[(w * 8 + i * 4 + j) * 64 + lane] = acc[i][j];
        __syncthreads();
        f32x4 s = red[w * 64 + lane];
#pragma unroll
        for (int q = 1; q < 8; ++q) s += red[(q * 8 + w) * 64 + lane];
        f.apply(er, ec, s, eld);
    }
    __syncthreads();
}

struct EpiIn {
    int l; KP pp;
    __device__ __forceinline__ void operator()(const f32x4 (&acc)[2][2][4][2], const pg8::Unit& u, int wr, int wc, int fr, int fq) const {
        const KP p = pp;
        unsigned char* ws = p->ws;
        const int pn = u.pn;
        const int row0 = u.pm * 256 + wr * 64 + fr;
        const int ct0 = wc * 32 + 4 * fq;
        if (pn < 3) {
            bf16_t* Qb = (bf16_t*)(ws + W_Q); bf16_t* Kb = (bf16_t*)(ws + W_K); bf16_t* Vb = (bf16_t*)(ws + W_V);
            const f32x2* rope = (const f32x2*)(ws + W_ROPE);
#pragma unroll
            for (int ai = 0; ai < 2; ++ai) {
                f32x4 rcs[4][2];
#pragma unroll
                for (int m = 0; m < 4; ++m) {
                    const int row = row0 + ai * 128 + m * 16;
                    const int pi = row >= TP ? 2048 + ((row - TP) & 15) : (row & 2047);
                    const f32x4* cs = (const f32x4*)(rope + pi * 8 + 4 * (fq & 1));
                    rcs[m][0] = cs[0]; rcs[m][1] = cs[1];
                }
#pragma unroll
                for (int m = 0; m < 4; ++m) {
                    const int row = row0 + ai * 128 + m * 16;
                    const bool samp = row >= TP;
                    const int b = samp ? (row - TP) >> 4 : row >> 11, t = samp ? (row - TP) & 15 : row & 2047;
#pragma unroll
                    for (int bj = 0; bj < 2; ++bj)
#pragma unroll
                        for (int n = 0; n < 2; ++n) {
                            f32x4 v = acc[ai][bj][m][n];
                            const int ct = bj * 128 + ct0 + n * 16;
                            const bool isv = (pn == 2) && (bj == 1);
                            if (!isv && n == 0 && (wc & 1) == 0) {
                                f32x4 o;
                                o[0] = __shfl_xor(v[0], 32); o[1] = __shfl_xor(v[1], 32); o[2] = __shfl_xor(v[2], 32); o[3] = __shfl_xor(v[3], 32);
                                const f32x4 c01 = rcs[m][0], c23 = rcs[m][1];
                                const float sgn = (fq < 2) ? -1.f : 1.f;
                                v[0] = v[0] * c01[0] + sgn * o[0] * c01[1];
                                v[1] = v[1] * c01[2] + sgn * o[1] * c01[3];
                                v[2] = v[2] * c23[0] + sgn * o[2] * c23[1];
                                v[3] = v[3] * c23[2] + sgn * o[3] * c23[3];
                            }
                            u32x2 pk; pk.x = pk2(v[0], v[1]); pk.y = pk2(v[2], v[3]);
                            if (pn < 2) { *(u32x2*)(Qb + (size_t)row * 512 + pn * 256 + ct) = pk; }
                            else {
                                const int c = ct & 127;
                                bf16_t* dst = isv ? Vb : Kb;
                                *(u32x2*)(dst + (size_t)row * 128 + c) = pk;
                                if (samp) {
                                    float* o = p->out + (isv ? O_VS : O_KS) + ((size_t)(l * 32 + b) * 16 + t) * 128 + c;
                                    *(f32x4*)o = v;
                                } else if (t >= 1920) {
                                    float* o = p->out + (isv ? O_VP : O_KP) + ((size_t)(l * 8 + b) * 128 + (t - 1920)) * 128 + c;
                                    *(f32x4*)o = v;
                                }
                            }
                        }
                }
            }
        } else if (pn < 7) {
            bf16_t* Zb = (bf16_t*)(ws + W_Z);
#pragma unroll
            for (int ai = 0; ai < 2; ++ai)
#pragma unroll
                for (int m = 0; m < 4; ++m) {
                    const int row = row0 + ai * 128 + m * 16;
#pragma unroll
                    for (int bj = 0; bj < 2; ++bj)
#pragma unroll
                        for (int n = 0; n < 2; ++n) {
                            const f32x4 v = acc[ai][bj][m][n];
                            u32x2 pk; pk.x = pk2(v[0], v[1]); pk.y = pk2(v[2], v[3]);
                            *(u32x2*)(Zb + (size_t)row * 1024 + (pn - 3) * 256 + bj * 128 + ct0 + n * 16) = pk;
                        }
                }
        } else if (pn < 13) {
            bf16_t* Xb = (bf16_t*)(ws + W_XBC);
#pragma unroll
            for (int ai = 0; ai < 2; ++ai)
#pragma unroll
                for (int m = 0; m < 4; ++m) {
                    const int row = row0 + ai * 128 + m * 16;
                    const bool samp = row >= TP;
                    const int b = samp ? (row - TP) >> 4 : row >> 11, t = samp ? (row - TP) & 15 : row & 2047;
#pragma unroll
                    for (int bj = 0; bj < 2; ++bj)
#pragma unroll
                        for (int n = 0; n < 2; ++n) {
                            const f32x4 v = acc[ai][bj][m][n];
                            const int cc = (pn - 7) * 256 + bj * 128 + ct0 + n * 16;
                            u32x2 pk; pk.x = pk2(v[0], v[1]); pk.y = pk2(v[2], v[3]);
                            *(u32x2*)(Xb + (size_t)row * 1536 + cc) = pk;
                            if (samp) { if (t >= 13) *(f32x4*)(p->out + O_CS + ((size_t)(l * 32 + b) * 3 + (t - 13)) * 1536 + cc) = v; }
                            else if (t >= 2045) *(f32x4*)(p->out + O_CP + ((size_t)(l * 8 + b) * 3 + (t - 2045)) * 1536 + cc) = v;
                        }
                }
        } else if (pn < 17) {
            bf16_t* dst = (bf16_t*)(ws + (pn < 15 ? W_GU : W_GV));
            const int cb = ((pn - 13) & 1) * 256;
#pragma unroll
            for (int ai = 0; ai < 2; ++ai)
#pragma unroll
                for (int m = 0; m < 4; ++m) {
                    const int row = row0 + ai * 128 + m * 16;
#pragma unroll
                    for (int bj = 0; bj < 2; ++bj)
#pragma unroll
                        for (int n = 0; n < 2; ++n) {
                            const f32x4 v = acc[ai][bj][m][n];
                            u32x2 pk; pk.x = pk2(geluf_(v[0]), geluf_(v[1])); pk.y = pk2(geluf_(v[2]), geluf_(v[3]));
                            *(u32x2*)(dst + (size_t)row * 512 + cb + bj * 128 + ct0 + n * 16) = pk;
                        }
                }
        } else if (pn < 29) {
            unsigned char* G8 = ws + W_G8;
#pragma unroll
            for (int ai = 0; ai < 2; ++ai)
#pragma unroll
                for (int m = 0; m < 4; ++m) {
                    const int row = row0 + ai * 128 + m * 16;
#pragma unroll
                    for (int bj = 0; bj < 2; ++bj)
#pragma unroll
                        for (int n = 0; n < 2; ++n) {
                            const f32x4 v = acc[ai][bj][m][n];
                            const unsigned q0 = (unsigned)(sigm(v[0]) * 255.f + 0.5f), q1 = (unsigned)(sigm(v[1]) * 255.f + 0.5f);
                            const unsigned q2 = (unsigned)(sigm(v[2]) * 255.f + 0.5f), q3 = (unsigned)(sigm(v[3]) * 255.f + 0.5f);
                            *(unsigned*)(G8 + (size_t)row * 3072 + (pn - 17) * 256 + bj * 128 + ct0 + n * 16) = q0 | (q1 << 8) | (q2 << 16) | (q3 << 24);
                        }
                }
        } else {
            if (wc == 0) {
                float* DT = (float*)(ws + W_DT);
                const f32x4 bias = *(const f32x4*)(p->dt_bias + l * 16 + 4 * fq);
#pragma unroll
                for (int ai = 0; ai < 2; ++ai)
#pragma unroll
                    for (int m = 0; m < 4; ++m) {
                        const int row = row0 + ai * 128 + m * 16;
                        f32x4 v = acc[ai][0][m][0] + bias;
#pragma unroll
                        for (int e = 0; e < 4; ++e) { const float x = v[e]; v[e] = fmaxf(x, 0.f) + log1pf(__expf(-fabsf(x))); }
                        *(f32x4*)(DT + (size_t)row * 16 + 4 * fq) = v;
                    }
            }
        }
    }
};

template <bool BIG> struct FMergeT {
    int b; const unsigned char* G8; const float* rowss; bf16_t* MG;
    const float* tile_rstd; int tile_row0;
    struct Ld { unsigned g; float ss; u32x2 o; };
    __device__ __forceinline__ void load(int row, int col, Ld& d) const {
        d.g = *(const unsigned*)(G8 + (size_t)row * 3072 + b * 1024 + col);
        d.ss = 1.f;
        if (b == 1) {
            if (BIG) d.ss = tile_rstd[row - tile_row0];
            else {
                const f32x4* pp = (const f32x4*)(rowss + (size_t)row * 32);
                const f32x4 t = ((pp[0] + pp[1]) + (pp[2] + pp[3])) + ((pp[4] + pp[5]) + (pp[6] + pp[7]));
                d.ss = rsqrtf(((t[0] + t[1]) + (t[2] + t[3])) * (1.f / 1024.f) + EPSF);
            }
        }
        d.o = (b > 0) ? *(const u32x2*)(MG + (size_t)row * 1024 + col) : (u32x2){0u, 0u};
    }
    __device__ __forceinline__ void apply(int row, int col, f32x4 v, const Ld& d) const {
        const float sc = d.ss * (1.f / 255.f);
        const unsigned g = d.g;
        f32x4 r;
        r[0] = (float)(g & 255u) * sc * v[0]; r[1] = (float)((g >> 8) & 255u) * sc * v[1];
        r[2] = (float)((g >> 16) & 255u) * sc * v[2]; r[3] = (float)(g >> 24) * sc * v[3];
        if (b > 0) { r[0] += bflo(d.o.x); r[1] += bfhi(d.o.x); r[2] += bflo(d.o.y); r[3] += bfhi(d.o.y); }
        u32x2 pk; pk.x = pk2(r[0], r[1]); pk.y = pk2(r[2], r[3]);
        *(u32x2*)(MG + (size_t)row * 1024 + col) = pk;
    }
};
struct FResid {
    const float* srcP; const float* srcS; float* X; const float* modg;
    struct Ld { f32x4 x, g; };
    __device__ __forceinline__ void load(int row, int col, Ld& d) const {
        const float* s = row < TP ? srcP + (size_t)row * 1024 + col : srcS + (size_t)(row - TP) * 1024 + col;
        d.x = *(const f32x4*)s;
        d.g = *(const f32x4*)(modg + (size_t)mod_row(row) * 6144 + col);
    }
    __device__ __forceinline__ void apply(int row, int col, f32x4 v, const Ld& d) const {
        *(f32x4*)(X + (size_t)row * 1024 + col) = d.x + d.g * v;
    }
};
struct FRelu2 {
    bf16_t* FH;
    struct Ld { };
    __device__ __forceinline__ void load(int, int, Ld&) const {}
    __device__ __forceinline__ void apply(int row, int col, f32x4 v, const Ld&) const {
        f32x4 r; r[0] = fmaxf(v[0], 0.f); r[1] = fmaxf(v[1], 0.f); r[2] = fmaxf(v[2], 0.f); r[3] = fmaxf(v[3], 0.f);
        u32x2 pk; pk.x = pk2(r[0] * r[0], r[1] * r[1]); pk.y = pk2(r[2] * r[2], r[3] * r[3]);
        *(u32x2*)(FH + (size_t)row * 4096 + col) = pk;
    }
};

__device__ __forceinline__ void phase_mod(KP p, float* lds) {
    float* sc = lds;
    float* red = lds + 20480;
    float* MOD = (float*)(p->ws + W_MOD);
    const int tid = tid_();
    const int rh = blockIdx.x & 1;
    __syncthreads();
    {
        float cv[40];
#pragma unroll
        for (int i = 0; i < 40; ++i) {
            const int idx = tid + 512 * i, r = idx >> 10, k = idx & 1023, gr = rh * 20 + r;
            cv[i] = gr < 8 ? p->c_prompt[gr * 1024 + k] : p->c_sample[(gr - 8) * 1024 + k];
        }
#pragma unroll
        for (int i = 0; i < 40; ++i) {
            const int idx = tid + 512 * i, r = idx >> 10, k = idx & 1023;
            sc[k * 20 + r] = siluf_(cv[i]);
        }
    }
    __syncthreads();
    for (int pi = blockIdx.x >> 1; pi < 384; pi += gridDim.x >> 1) {
        const int l = pi / 192, cgp = pi % 192;
        const int cn = tid & 31, ks = tid >> 5, n = cgp * 32 + cn;
        float acc[20];
#pragma unroll
        for (int r = 0; r < 20; ++r) acc[r] = 0.f;
        const float* w = p->w_ada + (size_t)l * 1024 * 6144 + n + (size_t)ks * 64 * 6144;
#pragma unroll 1
        for (int kb = 0; kb < 64; kb += 32) {
            float wv[32];
#pragma unroll
            for (int i = 0; i < 32; ++i) wv[i] = w[(size_t)(kb + i) * 6144];
#pragma unroll
            for (int i = 0; i < 32; ++i) {
                const f32x4* s4 = (const f32x4*)(sc + (ks * 64 + kb + i) * 20);
#pragma unroll
                for (int q = 0; q < 5; ++q) { const f32x4 s = s4[q]; acc[4 * q] += s[0] * wv[i]; acc[4 * q + 1] += s[1] * wv[i]; acc[4 * q + 2] += s[2] * wv[i]; acc[4 * q + 3] += s[3] * wv[i]; }
            }
        }
#pragma unroll
        for (int r = 0; r < 20; ++r) red[(ks * 20 + r) * 32 + cn] = acc[r];
        __syncthreads();
        for (int idx = tid; idx < 640; idx += 512) {
            const int r = idx >> 5, c2 = idx & 31, n2 = cgp * 32 + c2;
            float s = 0.f;
#pragma unroll
            for (int k16 = 0; k16 < 16; ++k16) s += red[(k16 * 20 + r) * 32 + c2];
            MOD[((size_t)l * 40 + rh * 20 + r) * 6144 + n2] = s + p->b_ada[l * 6144 + n2];
        }
        __syncthreads();
    }
}

struct CvtTile { const float* src; bf16_t* dst; int K, Ns, mode, n0, k0; };
__device__ __forceinline__ CvtTile cvt_tile(KP p, int l, int it) {
    bf16_t* WT = (bf16_t*)(p->ws + W_WT);
    CvtTile c; int nT; int r = it; c.mode = 0;
    if (r < 1920) { c.src = p->w_in + (size_t)l * 1024 * 7440; c.K = 1024; c.Ns = 7440; nT = 120; c.dst = WT + WT_IN; c.mode = 1; }
    else if ((r -= 1920) < 128) { c.src = p->w_attn_o + (size_t)l * 512 * 1024; c.K = 512; c.Ns = 1024; nT = 16; c.dst = WT + WT_AO; }
    else if ((r -= 128) < 256) { c.src = p->w_ssm_o + (size_t)l * 1024 * 1024; c.K = 1024; c.Ns = 1024; nT = 16; c.dst = WT + WT_SO; c.mode = 2; }
    else if ((r -= 256) < 128) { c.src = p->w_gm_o + (size_t)l * 512 * 1024; c.K = 512; c.Ns = 1024; nT = 16; c.dst = WT + WT_GO; }
    else if ((r -= 128) < 256) { c.src = p->w_out + (size_t)l * 1024 * 1024; c.K = 1024; c.Ns = 1024; nT = 16; c.dst = WT + WT_OUT; }
    else if ((r -= 256) < 1024) { c.src = p->w_ff1 + (size_t)l * 1024 * 4096; c.K = 1024; c.Ns = 4096; nT = 64; c.dst = WT + WT_F1; }
    else { r -= 1024; c.src = p->w_ff2 + (size_t)l * 4096 * 1024; c.K = 4096; c.Ns = 1024; nT = 16; c.dst = WT + WT_F2; }
    c.n0 = (r % nT) * 64; c.k0 = (r / nT) * 64;
    return c;
}
__device__ __forceinline__ void convert_weights(KP p, int l, float* tiles) {
    const int tid = tid_();
    for (int it = blockIdx.x * 4; it < 4736; it += gridDim.x * 4) {
        CvtTile c[4] = {cvt_tile(p, l, it), cvt_tile(p, l, it + 1), cvt_tile(p, l, it + 2), cvt_tile(p, l, it + 3)};
        __syncthreads();
        float v[4][8];
#pragma unroll
        for (int h = 0; h < 4; ++h) {
            const int nn = tid & 63, ns = c[h].n0 + nn; int sc_ = ns; bool zero = false;
            if (c[h].mode == 1) { if (ns < 3328) sc_ = ns; else if (ns < 7424) sc_ = ns + 16; else if (ns < 7440) sc_ = ns - 7424 + 3328; else { zero = true; sc_ = 0; } }
#pragma unroll
            for (int i = 0; i < 8; ++i) {
                const int kk = (tid >> 6) + 8 * i;
                v[h][i] = zero ? 0.f : c[h].src[(size_t)(c[h].k0 + kk) * c[h].Ns + sc_];
            }
        }
#pragma unroll
        for (int h = 0; h < 4; ++h)
#pragma unroll
            for (int i = 0; i < 8; ++i) {
                const int kk = (tid >> 6) + 8 * i;
                float x = v[h][i];
                if (c[h].mode == 2) x *= p->ssm_norm_w[l * 1024 + c[h].k0 + kk];
                tiles[h * 4224 + kk * 65 + (tid & 63)] = x;
            }
        __syncthreads();
#pragma unroll
        for (int h = 0; h < 4; ++h) {
            const float* tile = tiles + h * 4224;
            const int nr = tid >> 3, kc = (tid & 7) * 8;
            u32x4 o;
            o.x = pk2(tile[(kc + 0) * 65 + nr], tile[(kc + 1) * 65 + nr]);
            o.y = pk2(tile[(kc + 2) * 65 + nr], tile[(kc + 3) * 65 + nr]);
            o.z = pk2(tile[(kc + 4) * 65 + nr], tile[(kc + 5) * 65 + nr]);
            o.w = pk2(tile[(kc + 6) * 65 + nr], tile[(kc + 7) * 65 + nr]);
            *(u32x4*)(c[h].dst + (size_t)(c[h].n0 + nr) * c[h].K + c[h].k0 + kc) = o;
        }
    }
    __syncthreads();
}

__device__ __forceinline__ void phase_norm(KP p, int l, const float* srcP, const float* srcS, const float* gvec, int shift_idx) {
    const int tid = tid_(), lane = tid & 63, gw = blockIdx.x * 8 + (tid >> 6), ngw = gridDim.x * 8;
    const float* MOD = (const float*)(p->ws + W_MOD);
    bf16_t* H = (bf16_t*)(p->ws + W_H);
    f32x4 g[4];
#pragma unroll
    for (int j = 0; j < 4; ++j) g[j] = ((const f32x4*)gvec)[lane + 64 * j];
    f32x4 nx[4];
    {
        const int row = gw < T ? gw : T - 1;
        const float* xr = row < TP ? srcP + (size_t)row * 1024 : srcS + (size_t)(row - TP) * 1024;
#pragma unroll
        for (int j = 0; j < 4; ++j) nx[j] = ((const f32x4*)xr)[lane + 64 * j];
    }
    for (int row = gw; row < T; row += ngw) {
        f32x4 v[4];
#pragma unroll
        for (int j = 0; j < 4; ++j) v[j] = nx[j];
        {
            const int rn = row + ngw < T ? row + ngw : row;
            const float* xr = rn < TP ? srcP + (size_t)rn * 1024 : srcS + (size_t)(rn - TP) * 1024;
#pragma unroll
            for (int j = 0; j < 4; ++j) nx[j] = ((const f32x4*)xr)[lane + 64 * j];
        }
        const float* md = MOD + ((size_t)l * 40 + mod_row(row)) * 6144 + shift_idx * 1024;
        f32x4 sh[4], sc[4];
#pragma unroll
        for (int j = 0; j < 4; ++j) { sh[j] = ((const f32x4*)md)[lane + 64 * j]; sc[j] = ((const f32x4*)(md + 1024))[lane + 64 * j]; }
        float ss = 0.f;
#pragma unroll
        for (int j = 0; j < 4; ++j) ss += v[j][0] * v[j][0] + v[j][1] * v[j][1] + v[j][2] * v[j][2] + v[j][3] * v[j][3];
        ss = wave_sum(ss);
        const float rstd = rsqrtf(ss * (1.f / 1024.f) + EPSF);
#pragma unroll
        for (int j = 0; j < 4; ++j) {
            f32x4 h;
#pragma unroll
            for (int e = 0; e < 4; ++e) h[e] = (v[j][e] * rstd * g[j][e]) * (1.f + sc[j][e]) + sh[j][e];
            u32x2 pk; pk.x = pk2(h[0], h[1]); pk.y = pk2(h[2], h[3]);
            *(u32x2*)(H + (size_t)row * 1024 + (lane + 64 * j) * 4) = pk;
        }
    }
}

template <int NMT>
__device__ __forceinline__ void attn_load_q(const bf16_t* qo, int lane, bf16x8 (&qf)[NMT][2]) {
    const int fr = lane & 15, fq = lane >> 4;
#pragma unroll
    for (int mt = 0; mt < NMT; ++mt)
#pragma unroll
        for (int ks = 0; ks < 2; ++ks) qf[mt][ks] = *(const bf16x8*)(qo + (size_t)(mt * 16 + fr) * 512 + ks * 32 + fq * 8);
}
template <int NMT>
__device__ __forceinline__ void attn_compute(const bf16_t* Ks, const bf16_t* VT, bf16_t* qo, const bf16x8 (&qf)[NMT][2], int kt0, int kt1, int nkeys, float sink, int lane) {
    const int fr = lane & 15, fq = lane >> 4;
    f32x4 s[12][NMT];
#pragma unroll
    for (int kp = 0; kp < 6; ++kp) {
#pragma unroll
        for (int h2 = 0; h2 < 2; ++h2)
#pragma unroll
            for (int mt = 0; mt < NMT; ++mt) s[2 * kp + h2][mt] = (f32x4){0.f, 0.f, 0.f, 0.f};
        if (2 * kp >= kt0 && 2 * kp < kt1) {
            bf16x8 kf[2][2];
#pragma unroll
            for (int h2 = 0; h2 < 2; ++h2)
#pragma unroll
                for (int ks = 0; ks < 2; ++ks) kf[h2][ks] = *(const bf16x8*)(Ks + ((2 * kp + h2) * 16 + fr) * 72 + ks * 32 + fq * 8);
#pragma unroll
            for (int h2 = 0; h2 < 2; ++h2)
#pragma unroll
                for (int ks = 0; ks < 2; ++ks)
#pragma unroll
                    for (int mt = 0; mt < NMT; ++mt) s[2 * kp + h2][mt] = mfma16(kf[h2][ks], qf[mt][ks], s[2 * kp + h2][mt]);
        }
    }
    float inv[NMT];
#pragma unroll
    for (int mt = 0; mt < NMT; ++mt) {
        float mx = -INFINITY;
#pragma unroll
        for (int kt = 0; kt < 12; ++kt)
            if (kt >= kt0 && kt < kt1) {
#pragma unroll
                for (int j = 0; j < 4; ++j) { const int key = kt * 16 + fq * 4 + j; const float v = key < nkeys ? s[kt][mt][j] * 0.125f : -INFINITY; s[kt][mt][j] = v; mx = fmaxf(mx, v); }
            }
        mx = fmaxf(mx, __shfl_xor(mx, 16)); mx = fmaxf(mx, __shfl_xor(mx, 32)); mx = fmaxf(mx, sink);
        float sum = 0.f;
#pragma unroll
        for (int kt = 0; kt < 12; ++kt)
            if (kt >= kt0 && kt < kt1) {
#pragma unroll
                for (int j = 0; j < 4; ++j) { const float e = __expf(s[kt][mt][j] - mx); s[kt][mt][j] = e; sum += e; }
            }
        sum += __shfl_xor(sum, 16); sum += __shfl_xor(sum, 32);
        inv[mt] = 1.f / (sum + __expf(sink - mx));
    }
    f32x4 o[4][NMT];
#pragma unroll
    for (int dt = 0; dt < 4; ++dt)
#pragma unroll
        for (int mt = 0; mt < NMT; ++mt) o[dt][mt] = (f32x4){0.f, 0.f, 0.f, 0.f};
#pragma unroll
    for (int kb = 0; kb < 6; ++kb) {
        if (2 * kb >= kt0 && 2 * kb < kt1) {
            bf16x8 pf[NMT];
#pragma unroll
            for (int mt = 0; mt < NMT; ++mt) {
                const f32x4 a = s[2 * kb][mt], b = s[2 * kb + 1][mt];
                u32x4 t; t.x = pk2(a[0], a[1]); t.y = pk2(a[2], a[3]); t.z = pk2(b[0], b[1]); t.w = pk2(b[2], b[3]);
                pf[mt] = __builtin_bit_cast(bf16x8, t);
            }
            bf16x8 vf[4];
#pragma unroll
            for (int dt = 0; dt < 4; ++dt) {
                const u32x2 lo = *(const u32x2*)(VT + (dt * 16 + fr) * 200 + kb * 32 + fq * 4);
                const u32x2 hi = *(const u32x2*)(VT + (dt * 16 + fr) * 200 + kb * 32 + 16 + fq * 4);
                u32x4 t; t.x = lo.x; t.y = lo.y; t.z = hi.x; t.w = hi.y;
                vf[dt] = __builtin_bit_cast(bf16x8, t);
            }
#pragma unroll
            for (int dt = 0; dt < 4; ++dt)
#pragma unroll
                for (int mt = 0; mt < NMT; ++mt) o[dt][mt] = mfma16(vf[dt], pf[mt], o[dt][mt]);
        }
    }
#pragma unroll
    for (int mt = 0; mt < NMT; ++mt)
#pragma unroll
        for (int dt = 0; dt < 4; ++dt) {
            const f32x4 v = o[dt][mt] * inv[mt];
            u32x2 pk; pk.x = pk2(v[0], v[1]); pk.y = pk2(v[2], v[3]);
            *(u32x2*)(qo + (size_t)(mt * 16 + fr) * 512 + dt * 16 + fq * 4) = pk;
        }
}

__device__ __forceinline__ void scatter_vt(bf16_t* VT, int ch, int kk, u32x4 vv) {
    bf16_t* d = VT + (ch * 8) * 200 + kk;
    d[0 * 200] = (bf16_t)(vv.x & 0xffffu); d[1 * 200] = (bf16_t)(vv.x >> 16);
    d[2 * 200] = (bf16_t)(vv.y & 0xffffu); d[3 * 200] = (bf16_t)(vv.y >> 16);
    d[4 * 200] = (bf16_t)(vv.z & 0xffffu); d[5 * 200] = (bf16_t)(vv.z >> 16);
    d[6 * 200] = (bf16_t)(vv.w & 0xffffu); d[7 * 200] = (bf16_t)(vv.w >> 16);
}

__device__ __forceinline__ void attn_prompt_item(KP p, int l, int it, unsigned char* shm) {
    const int tid = tid_(), w = tid >> 6, lane = tid & 63;
    const int b = it >> 6, c = (it >> 1) & 31, kvh = it & 1;
    bf16_t* Ks = (bf16_t*)shm; bf16_t* VT = Ks + 192 * 72;
    bf16_t* Qb = (bf16_t*)(p->ws + W_Q); const bf16_t* Kb = (const bf16_t*)(p->ws + W_K); const bf16_t* Vb = (const bf16_t*)(p->ws + W_V);
    const int kt0 = c >= 2 ? 0 : (2 - c) * 4;
    const int g = w >> 1, q0 = (w & 1) * 32, hq = kvh * 4 + g;
    bf16_t* qo = Qb + ((size_t)b * 2048 + c * 64 + q0) * 512 + hq * 64;
    const float sink = p->sinks[l * 8 + hq];
    __syncthreads();
    {
        u32x4 kv[3], vv[3];
        bf16x8 qf[2][2];
#pragma unroll
        for (int it3 = 0; it3 < 3; ++it3) {
            const int idx = tid + it3 * 512, ch = idx / 192, kk = idx - ch * 192;
            const int kkc = kk >= kt0 * 16 ? kk : kt0 * 16;
            const size_t row = (size_t)b * 2048 + (c - 2) * 64 + kkc;
            kv[it3] = *(const u32x4*)(Kb + row * 128 + kvh * 64 + ch * 8);
            vv[it3] = *(const u32x4*)(Vb + row * 128 + kvh * 64 + ch * 8);
        }
        attn_load_q<2>(qo, lane, qf);
#pragma unroll
        for (int it3 = 0; it3 < 3; ++it3) {
            const int idx = tid + it3 * 512, ch = idx / 192, kk = idx - ch * 192;
            if (kk >= kt0 * 16) { *(u32x4*)(Ks + kk * 72 + ch * 8) = kv[it3]; scatter_vt(VT, ch, kk, vv[it3]); }
        }
        __syncthreads();
        attn_compute<2>(Ks, VT, qo, qf, kt0, 12, 192, sink, lane);
    }
}

__device__ __forceinline__ void attn_sample_item(KP p, int l, int it, unsigned char* shm) {
    const int tid = tid_(), w = tid >> 6, lane = tid & 63;
    const int sb = it >> 1, kvh = it & 1;
    bf16_t* Ks = (bf16_t*)shm; bf16_t* VT = Ks + 192 * 72;
    bf16_t* Qb = (bf16_t*)(p->ws + W_Q); const bf16_t* Kb = (const bf16_t*)(p->ws + W_K); const bf16_t* Vb = (const bf16_t*)(p->ws + W_V);
    __syncthreads();
    for (int idx = tid; idx < 160 * 8; idx += 512) {
        const int ch = idx / 160, kk = idx - ch * 160;
        u32x4 kv, vv;
        if (kk < 128) {
            const size_t o = ((((size_t)l * 32 + sb) * 128 + kk) * 2 + kvh) * 64 + ch * 8;
            const f32x4 k0 = *(const f32x4*)(p->cache_k + o), k1 = *(const f32x4*)(p->cache_k + o + 4);
            const f32x4 v0 = *(const f32x4*)(p->cache_v + o), v1 = *(const f32x4*)(p->cache_v + o + 4);
            kv.x = pk2(k0[0], k0[1]); kv.y = pk2(k0[2], k0[3]); kv.z = pk2(k1[0], k1[1]); kv.w = pk2(k1[2], k1[3]);
            vv.x = pk2(v0[0], v0[1]); vv.y = pk2(v0[2], v0[3]); vv.z = pk2(v1[0], v1[1]); vv.w = pk2(v1[2], v1[3]);
        } else if (kk < 144) {
            const size_t row = (size_t)TP + sb * 16 + (kk - 128);
            kv = *(const u32x4*)(Kb + row * 128 + kvh * 64 + ch * 8);
            vv = *(const u32x4*)(Vb + row * 128 + kvh * 64 + ch * 8);
        } else { kv = zero4(); vv = kv; }
        *(u32x4*)(Ks + kk * 72 + ch * 8) = kv;
        scatter_vt(VT, ch, kk, vv);
    }
    __syncthreads();
    if (w < 4) {
        const int hq = kvh * 4 + w;
        bf16_t* qo = Qb + ((size_t)TP + sb * 16) * 512 + hq * 64;
        bf16x8 qf[1][2];
        attn_load_q<1>(qo, lane, qf);
        attn_compute<1>(Ks, VT, qo, qf, 0, 10, 144, p->sinks[l * 8 + hq], lane);
    }
}

__device__ __forceinline__ void gmlp_item(KP p, int l, bool samp, int bi, int cidx, int g, unsigned char* shm) {
    const int tid = tid_(), w = tid >> 6, lane = tid & 63, fr = lane & 15, fq = lane >> 4;
    bf16_t* Wm = (bf16_t*)shm; bf16_t* VT = Wm + 128 * 136;
    const int L = samp ? 16 : 128;
    const int row0 = samp ? TP + bi * 16 : bi * 2048 + cidx * 128;
    bf16_t* GUb = (bf16_t*)(p->ws + W_GU); const bf16_t* GVb = (const bf16_t*)(p->ws + W_GV);
    __syncthreads();
    if (samp) {
        { const int idx = tid * 8, d = idx >> 5, s = idx & 31; *(u32x4*)(VT + d * 136 + s) = zero4(); }
        if (tid < 128) {
            const int t = tid >> 3, s4 = (tid & 7) * 4;
            f32x4 wv = (f32x4){0.f, 0.f, 0.f, 0.f};
            if (s4 < 16) wv = *(const f32x4*)(p->gm_w_s + ((size_t)(l * 4 + g) * 128 + t) * 128 + s4);
#pragma unroll
            for (int e = 0; e < 4; ++e) if (s4 + e > t) wv[e] = 0.f;
            u32x2 pk; pk.x = pk2(wv[0], wv[1]); pk.y = pk2(wv[2], wv[3]);
            *(u32x2*)(Wm + t * 136 + s4) = pk;
        }
        __syncthreads();
    }
    if (!samp) {
        const int r = tid >> 2, q = tid & 3;
        const bf16_t* src = GVb + (size_t)(row0 + r) * 512 + q * 128;
        u32x4 rv[16];
#pragma unroll
        for (int k = 0; k < 16; ++k) rv[k] = *(const u32x4*)(src + k * 8);
        float s = 0.f, s2 = 0.f;
#pragma unroll
        for (int k = 0; k < 16; ++k) {
            const float a0 = bflo(rv[k].x), a1 = bfhi(rv[k].x), a2 = bflo(rv[k].y), a3 = bfhi(rv[k].y), a4 = bflo(rv[k].z), a5 = bfhi(rv[k].z), a6 = bflo(rv[k].w), a7 = bfhi(rv[k].w);
            s += ((a0 + a1) + (a2 + a3)) + ((a4 + a5) + (a6 + a7));
            s2 += ((a0 * a0 + a1 * a1) + (a2 * a2 + a3 * a3)) + ((a4 * a4 + a5 * a5) + (a6 * a6 + a7 * a7));
        }
        s += __shfl_xor(s, 1); s += __shfl_xor(s, 2); s2 += __shfl_xor(s2, 1); s2 += __shfl_xor(s2, 2);
        float* lgs = (float*)(VT + 128 * 136);
        if (q == 0) {
            const float mean = s * (1.f / 512.f);
            lgs[256 + 2 * r] = mean; lgs[257 + 2 * r] = rsqrtf(fmaxf(s2 * (1.f / 512.f) - mean * mean, 0.f) + EPSF);
        }
        if (tid < 128) lgs[tid] = p->gm_ln_g[l * 512 + g * 128 + tid]; else if (tid < 256) lgs[tid] = p->gm_ln_b[l * 512 + g * 128 + tid - 128];
        const int r2 = tid & 127, dq = tid >> 7;
        u32x4 xv[4];
#pragma unroll
        for (int k = 0; k < 4; ++k) xv[k] = *(const u32x4*)(GVb + (size_t)(row0 + r2) * 512 + g * 128 + dq * 32 + k * 8);
        __syncthreads();
        {
            const float mean = lgs[256 + 2 * r2], rstd = lgs[257 + 2 * r2];
#pragma unroll
            for (int k = 0; k < 4; ++k) {
                const unsigned uu[4] = {xv[k].x, xv[k].y, xv[k].z, xv[k].w};
                const f32x4 g0 = *(const f32x4*)(lgs + dq * 32 + k * 8), g1 = *(const f32x4*)(lgs + dq * 32 + k * 8 + 4);
                const f32x4 b0 = *(const f32x4*)(lgs + 128 + dq * 32 + k * 8), b1 = *(const f32x4*)(lgs + 128 + dq * 32 + k * 8 + 4);
#pragma unroll
                for (int e = 0; e < 8; ++e) {
                    const float v = (e & 1) ? bfhi(uu[e >> 1]) : bflo(uu[e >> 1]);
                    const float gg = e < 4 ? g0[e & 3] : g1[e & 3], bb = e < 4 ? b0[e & 3] : b1[e & 3];
                    VT[(dq * 32 + k * 8 + e) * 136 + r2] = f2bf((v - mean) * rstd * gg + bb);
                }
            }
        }
        {
            f32x4 wv[8];
#pragma unroll
            for (int q = 0; q < 8; ++q) { const int idx = tid + q * 512; wv[q] = *(const f32x4*)(p->gm_w_s + ((size_t)(l * 4 + g) * 128 + (idx >> 5)) * 128 + (idx & 31) * 4); }
#pragma unroll
            for (int q = 0; q < 8; ++q) {
                const int idx = tid + q * 512, t = idx >> 5, s4 = (idx & 31) * 4;
#pragma unroll
                for (int e = 0; e < 4; ++e) if (s4 + e > t) wv[q][e] = 0.f;
                u32x2 pk; pk.x = pk2(wv[q][0], wv[q][1]); pk.y = pk2(wv[q][2], wv[q][3]);
                *(u32x2*)(Wm + t * 136 + s4) = pk;
            }
        }
    } else if (w == 0) {
        u32x4 rawv[16];
#pragma unroll
        for (int r = 0; r < 16; ++r) rawv[r] = *(const u32x4*)(GVb + (size_t)(row0 + r) * 512 + lane * 8);
#pragma unroll
        for (int r = 0; r < 16; ++r) {
            const u32x4 raw = rawv[r];
            float v[8];
            v[0] = bflo(raw.x); v[1] = bfhi(raw.x); v[2] = bflo(raw.y); v[3] = bfhi(raw.y); v[4] = bflo(raw.z); v[5] = bfhi(raw.z); v[6] = bflo(raw.w); v[7] = bfhi(raw.w);
            float s = 0.f;
#pragma unroll
            for (int e = 0; e < 8; ++e) s += v[e];
            const float mean = wave_sum(s) * (1.f / 512.f);
            float s2 = 0.f;
#pragma unroll
            for (int e = 0; e < 8; ++e) { v[e] -= mean; s2 += v[e] * v[e]; }
            const float rstd = rsqrtf(wave_sum(s2) * (1.f / 512.f) + EPSF);
            if (fq == g) {
#pragma unroll
                for (int e = 0; e < 8; ++e) {
                    const int d = fr * 8 + e, col = g * 128 + d;
                    const float vn = v[e] * rstd * p->gm_ln_g[l * 512 + col] + p->gm_ln_b[l * 512 + col];
                    VT[d * 136 + r] = f2bf(vn);
                    p->out[O_GS + ((size_t)(l * 32 + bi) * 16 + r) * 512 + col] = vn;
                }
            }
        }
    }
    bf16_t uv[4][8];
    if (w * 16 < L) {
#pragma unroll
        for (int j = 0; j < 4; ++j)
#pragma unroll
            for (int dt = 0; dt < 8; ++dt) uv[j][dt] = GUb[(size_t)(row0 + w * 16 + fq * 4 + j) * 512 + g * 128 + dt * 16 + fr];
    }
    __syncthreads();
    if (w * 16 < L) {
        f32x4 acc[8];
#pragma unroll
        for (int dt = 0; dt < 8; ++dt) acc[dt] = (f32x4){0.f, 0.f, 0.f, 0.f};
        const int nks = samp ? 1 : ((w * 16 + 15) >> 5) + 1;
#pragma unroll
        for (int ks = 0; ks < 4; ++ks) {
            if (ks < nks) {
                const bf16x8 wf = *(const bf16x8*)(Wm + (w * 16 + fr) * 136 + ks * 32 + fq * 8);
                bf16x8 vf[8];
#pragma unroll
                for (int dt = 0; dt < 8; ++dt) vf[dt] = *(const bf16x8*)(VT + (dt * 16 + fr) * 136 + ks * 32 + fq * 8);
#pragma unroll
                for (int dt = 0; dt < 8; ++dt) acc[dt] = mfma16(wf, vf[dt], acc[dt]);
            }
        }
#pragma unroll
        for (int j = 0; j < 4; ++j) {
            const int t = w * 16 + fq * 4 + j;
            const float bias = p->gm_b_s[(l * 4 + g) * 128 + t];
#pragma unroll
            for (int dt = 0; dt < 8; ++dt) {
                const size_t idx = (size_t)(row0 + t) * 512 + g * 128 + dt * 16 + fr;
                GUb[idx] = f2bf(bf2f(uv[j][dt]) * (acc[dt][j] + bias));
            }
        }
    }
}

constexpr size_t XT_SAMP = (size_t)256 * 1024 * 64, BT_SAMP = (size_t)256 * 256 * 64;
__device__ __forceinline__ void conv_prepass(KP p, int l, unsigned char* shm) {
    const int tid = tid_();
    bf16_t* R = (bf16_t*)shm;
    bf16_t* An = R + 67 * 264;
    bf16_t* At = An + 64 * 264;
    unsigned char* ws = p->ws;
    const bf16_t* Xb = (const bf16_t*)(ws + W_XBC);
    bf16_t* XT = (bf16_t*)(ws + W_H); bf16_t* BCN = (bf16_t*)(ws + W_BCN); bf16_t* BTg = (bf16_t*)(ws + W_BT);
    for (int it = blockIdx.x; it < 288 * 6; it += gridDim.x) {
        const int cidx = it / 6, slab = it - cidx * 6;
        const bool samp = cidx >= 256; const int sb = cidx - 256;
        const int row0 = samp ? TP + sb * 16 : cidx * 64, Lv = samp ? 16 : 64, c0 = slab * 256;
        __syncthreads();
        {
            u32x4 v[5];
#pragma unroll
            for (int q = 0; q < 5; ++q) {
                const int idx = tid + q * 512, r = idx >> 5, ck = idx & 31, rr = r - 3;
                v[q] = zero4();
                if (idx < (Lv + 3) * 32) {
                    if (rr >= 0 || (!samp && (cidx & 31) > 0)) v[q] = *(const u32x4*)(Xb + (size_t)(row0 + rr) * 1536 + c0 + ck * 8);
                    else if (samp) {
                        const float* sp = p->state_conv + (((size_t)l * 32 + sb) * 3 + (3 + rr)) * 1536 + c0 + ck * 8;
                        const f32x4 a = *(const f32x4*)sp, b = *(const f32x4*)(sp + 4);
                        v[q].x = pk2(a[0], a[1]); v[q].y = pk2(a[2], a[3]); v[q].z = pk2(b[0], b[1]); v[q].w = pk2(b[2], b[3]);
                    }
                }
            }
#pragma unroll
            for (int q = 0; q < 5; ++q) {
                const int idx = tid + q * 512;
                if (idx < (Lv + 3) * 32) *(u32x4*)(R + (idx >> 5) * 264 + (idx & 31) * 8) = v[q];
            }
        }
        __syncthreads();
        {
            const int j = tid & 255, tq = tid >> 8;
            if (tq * 32 < Lv) {
                const float w0 = p->conv_w[(l * 4 + 0) * 1536 + c0 + j], w1 = p->conv_w[(l * 4 + 1) * 1536 + c0 + j];
                const float w2 = p->conv_w[(l * 4 + 2) * 1536 + c0 + j], w3 = p->conv_w[(l * 4 + 3) * 1536 + c0 + j], cb = p->conv_b[l * 1536 + c0 + j];
                float x0 = bf2f(R[(tq * 32 + 0) * 264 + j]), x1 = bf2f(R[(tq * 32 + 1) * 264 + j]), x2 = bf2f(R[(tq * 32 + 2) * 264 + j]);
#pragma unroll
                for (int e = 0; e < 32; e += 2) {
                    const int t = tq * 32 + e;
                    if (t < Lv) {
                        const float x3 = bf2f(R[(t + 3) * 264 + j]), x4 = bf2f(R[(t + 4) * 264 + j]);
                        const float o0 = siluf_(cb + w0 * x0 + w1 * x1 + w2 * x2 + w3 * x3);
                        const float o1 = siluf_(cb + w0 * x1 + w1 * x2 + w2 * x3 + w3 * x4);
                        x0 = x2; x1 = x3; x2 = x4;
                        const unsigned pk = pk2(o0, o1);
                        An[t * 264 + j] = (bf16_t)(pk & 0xffffu); An[(t + 1) * 264 + j] = (bf16_t)(pk >> 16);
                        *(unsigned*)(At + j * 66 + t) = pk;
                    }
                }
            }
        }
        __syncthreads();
        if (slab >= 4) {
            for (int idx = tid; idx < Lv * 32; idx += 512) {
                const int t = idx >> 5, ck = idx & 31;
                *(u32x4*)(BCN + (size_t)(row0 + t) * 512 + (slab - 4) * 256 + ck * 8) = *(const u32x4*)(An + t * 264 + ck * 8);
            }
        }
        if (slab < 5) {
            const int sh = samp ? 1 : 3;
            bf16_t* dst;
            if (slab < 4) dst = samp ? XT + XT_SAMP + ((size_t)sb * 1024 + slab * 256) * 16 : XT + ((size_t)cidx * 1024 + slab * 256) * 64;
            else dst = samp ? BTg + BT_SAMP + (size_t)sb * 256 * 16 : BTg + (size_t)cidx * 256 * 64;
            for (int idx = tid; idx < (256 << sh); idx += 512) {
                const int j = idx >> sh, tc = idx & ((1 << sh) - 1);
                const unsigned* src = (const unsigned*)(At + j * 66 + tc * 8);
                u32x4 v; v.x = src[0]; v.y = src[1]; v.z = src[2]; v.w = src[3];
                *(u32x4*)(dst + (size_t)j * Lv + tc * 8) = v;
            }
        }
    }
    __syncthreads();
}

__device__ __forceinline__ void ssd_item(KP p, int l, bool samp, int bi, int h, unsigned char* shm) {
    const int tid = tid_(), w = tid >> 6, lane = tid & 63, fr = lane & 15, fq = lane >> 4;
    bf16_t* xT = (bf16_t*)shm;
    bf16_t* xwT = xT + 64 * 72;
    bf16_t* Bs = xwT + 64 * 72;
    bf16_t* BT = Bs + 64 * 136;
    bf16_t* Cs = BT + 128 * 72;
    bf16_t* Ms = Cs + 64 * 136;
    bf16_t* hb = Ms + 64 * 72;
    float* cumv = (float*)(hb + 64 * 136);
    float* dtv = cumv + 64;
    float* scl = dtv + 64;
    const int gr = h >> 3, nch = samp ? 1 : 32, Lv = samp ? 16 : 64;
    const int rowbase = samp ? TP + bi * 16 : bi * 2048;
    const float a_h = -__expf(p->a_log[l * 16 + h]), Dh = p->d_skip[l * 16 + h];
    unsigned char* ws = p->ws;
    const float* DT = (const float*)(ws + W_DT);
    const bf16_t* XTg = (const bf16_t*)(ws + W_H); const bf16_t* BCN = (const bf16_t*)(ws + W_BCN); const bf16_t* BTg = (const bf16_t*)(ws + W_BT);
    bf16_t* Zb = (bf16_t*)(ws + W_Z);
    float* ROWSS = (float*)(ws + W_ROWSS);
    const int pts = w >> 1, nt0 = (w & 1) * 4;
    f32x4 hacc[4];
    float* stout = samp ? p->out + O_SS + (((size_t)l * 32 + bi) * 16 + h) * 8192 : p->out + O_SP + (((size_t)l * 8 + bi) * 16 + h) * 8192;
    __syncthreads();
#pragma unroll
    for (int i = 0; i < 4; ++i) {
#pragma unroll
        for (int j = 0; j < 4; ++j) {
            const int pr = pts * 16 + fq * 4 + j, n = (nt0 + i) * 16 + fr;
            float v = 0.f;
            if (samp) v = p->state_ssm[((((size_t)l * 32 + bi) * 16 + h) * 64 + pr) * 128 + n];
            hacc[i][j] = v;
            hb[pr * 136 + n] = f2bf(v);
        }
    }
    const int ttile = w >> 1, half = w & 1;
    const int xp = tid >> 3, xc = tid & 7;

    u32x4 lx, lb[2], lc[2], lbt[2];
    float dcur = 0.f;
    auto load_ops = [&](int chx) {
        const int t0x = rowbase + chx * 64;
        lx = zero4();
        if (!samp) {
            const size_t cidx = (size_t)bi * 32 + chx;
            lx = *(const u32x4*)(XTg + (cidx * 1024 + h * 64 + xp) * 64 + xc * 8);
#pragma unroll
            for (int q = 0; q < 2; ++q) {
                const int idx = tid + q * 512;
                const bf16_t* rowp = BCN + (size_t)(t0x + (idx >> 4)) * 512 + gr * 128 + (idx & 15) * 8;
                lb[q] = *(const u32x4*)rowp; lc[q] = *(const u32x4*)(rowp + 256);
                lbt[q] = *(const u32x4*)(BTg + (cidx * 256 + gr * 128 + (idx >> 3)) * 64 + (idx & 7) * 8);
            }
        } else {
            if (xc < 2) lx = *(const u32x4*)(XTg + XT_SAMP + ((size_t)bi * 1024 + h * 64 + xp) * 16 + xc * 8);
#pragma unroll
            for (int q = 0; q < 2; ++q) {
                const int idx = tid + q * 512;
                lb[q] = zero4(); lc[q] = lb[q]; lbt[q] = lb[q];
                if ((idx >> 4) < 16) {
                    const bf16_t* rowp = BCN + (size_t)(t0x + (idx >> 4)) * 512 + gr * 128 + (idx & 15) * 8;
                    lb[q] = *(const u32x4*)rowp; lc[q] = *(const u32x4*)(rowp + 256);
                }
                if ((idx & 7) < 2) lbt[q] = *(const u32x4*)(BTg + BT_SAMP + ((size_t)bi * 256 + gr * 128 + (idx >> 3)) * 16 + (idx & 7) * 8);
            }
        }
        dcur = 0.f;
        if (w == 0 && lane < Lv) dcur = DT[(size_t)(t0x + lane) * 16 + h];
    };
    load_ops(0);

    for (int ch = 0; ch < nch; ++ch) {
        const int t0 = rowbase + ch * 64;
        bf16_t zr[8];
#pragma unroll
        for (int j = 0; j < 4; ++j)
#pragma unroll
            for (int i = 0; i < 2; ++i) {
                int t = ttile * 16 + fq * 4 + j; t = t < Lv ? t : Lv - 1;
                zr[j * 2 + i] = Zb[(size_t)(t0 + t) * 1024 + h * 64 + (half * 2 + i) * 16 + fr];
            }
        __syncthreads();
        if (w == 0) {
            const float c = wave_scan(dcur * a_h);
            const float c63 = __int_as_float(__builtin_amdgcn_readlane(__float_as_int(c), 63));
            cumv[lane] = c; dtv[lane] = dcur; scl[lane] = dcur * __expf(c63 - c);
        }
        *(u32x4*)(xT + xp * 72 + xc * 8) = lx;
#pragma unroll
        for (int q = 0; q < 2; ++q) {
            const int idx = tid + q * 512;
            *(u32x4*)(Bs + (idx >> 4) * 136 + (idx & 15) * 8) = lb[q];
            *(u32x4*)(Cs + (idx >> 4) * 136 + (idx & 15) * 8) = lc[q];
            *(u32x4*)(BT + (idx >> 3) * 72 + (idx & 7) * 8) = lbt[q];
        }
        __syncthreads();
        {
            const f32x4 s0 = *(const f32x4*)(scl + xc * 8), s1 = *(const f32x4*)(scl + xc * 8 + 4);
            u32x4 o;
            o.x = pk2(bflo(lx.x) * s0[0], bfhi(lx.x) * s0[1]); o.y = pk2(bflo(lx.y) * s0[2], bfhi(lx.y) * s0[3]);
            o.z = pk2(bflo(lx.z) * s1[0], bfhi(lx.z) * s1[1]); o.w = pk2(bflo(lx.w) * s1[2], bfhi(lx.w) * s1[3]);
            *(u32x4*)(xwT + xp * 72 + xc * 8) = o;
        }
        if (ch + 1 < nch) load_ops(ch + 1);
        f32x4 cb[2], yacc[2];
#pragma unroll
        for (int i = 0; i < 2; ++i) { cb[i] = (f32x4){0.f, 0.f, 0.f, 0.f}; yacc[i] = (f32x4){0.f, 0.f, 0.f, 0.f}; }
        {
            bf16x8 cf[4], bfr[4][2], hf[4][2];
#pragma unroll
            for (int ks = 0; ks < 4; ++ks) {
                cf[ks] = *(const bf16x8*)(Cs + (ttile * 16 + fr) * 136 + ks * 32 + fq * 8);
#pragma unroll
                for (int i = 0; i < 2; ++i) {
                    bfr[ks][i] = *(const bf16x8*)(Bs + ((half * 2 + i) * 16 + fr) * 136 + ks * 32 + fq * 8);
                    hf[ks][i] = *(const bf16x8*)(hb + ((half * 2 + i) * 16 + fr) * 136 + ks * 32 + fq * 8);
                }
            }
#pragma unroll
            for (int ks = 0; ks < 4; ++ks)
#pragma unroll
                for (int i = 0; i < 2; ++i) { cb[i] = mfma16(cf[ks], bfr[ks][i], cb[i]); yacc[i] = mfma16(cf[ks], hf[ks][i], yacc[i]); }
        }
#pragma unroll
        for (int j = 0; j < 4; ++j) {
            const int t = ttile * 16 + fq * 4 + j;
            const float ct = cumv[t];
            const float et = __expf(ct);
#pragma unroll
            for (int i = 0; i < 2; ++i) {
                const int s = (half * 2 + i) * 16 + fr;
                const float mv = (s <= t) ? cb[i][j] * __expf(ct - cumv[s]) * dtv[s] : 0.f;
                Ms[t * 72 + s] = f2bf(mv);
                yacc[i][j] *= et;
            }
        }
        __syncthreads();
        bf16x8 mf[2], xf[2][2], xwf[2], btf[2][4];
#pragma unroll
        for (int ks = 0; ks < 2; ++ks) {
            mf[ks] = *(const bf16x8*)(Ms + (ttile * 16 + fr) * 72 + ks * 32 + fq * 8);
#pragma unroll
            for (int i = 0; i < 2; ++i) xf[ks][i] = *(const bf16x8*)(xT + ((half * 2 + i) * 16 + fr) * 72 + ks * 32 + fq * 8);
            xwf[ks] = *(const bf16x8*)(xwT + (pts * 16 + fr) * 72 + ks * 32 + fq * 8);
#pragma unroll
            for (int i = 0; i < 4; ++i) btf[ks][i] = *(const bf16x8*)(BT + ((nt0 + i) * 16 + fr) * 72 + ks * 32 + fq * 8);
        }
#pragma unroll
        for (int ks = 0; ks < 2; ++ks)
#pragma unroll
            for (int i = 0; i < 2; ++i) yacc[i] = mfma16(mf[ks], xf[ks][i], yacc[i]);
        {
            float ssq[4] = {0.f, 0.f, 0.f, 0.f};
#pragma unroll
            for (int j = 0; j < 4; ++j) {
                const int t = ttile * 16 + fq * 4 + j;
                if (!samp || t < Lv) {
#pragma unroll
                    for (int i = 0; i < 2; ++i) {
                        const int pc = (half * 2 + i) * 16 + fr;
                        const float xv = bf2f(xT[pc * 72 + t]);
                        const float y = yacc[i][j] + Dh * xv;
                        const size_t zi = (size_t)(t0 + t) * 1024 + h * 64 + pc;
                        const float uu = y * siluf_(bf2f(zr[j * 2 + i]));
                        Zb[zi] = f2bf(uu);
                        ssq[j] += uu * uu;
                    }
                }
            }
#pragma unroll
            for (int j = 0; j < 4; ++j) {
                const float s = row16_sum(ssq[j]);
                const int t = ttile * 16 + fq * 4 + j;
                if (fr == 0 && (!samp || t < Lv)) ROWSS[(size_t)(t0 + t) * 32 + h * 2 + half] = s;
            }
        }
        const float dec = __expf(cumv[63]);
#pragma unroll
        for (int i = 0; i < 4; ++i) hacc[i] *= dec;
#pragma unroll
        for (int ks = 0; ks < 2; ++ks)
#pragma unroll
            for (int i = 0; i < 4; ++i) hacc[i] = mfma16(xwf[ks], btf[ks][i], hacc[i]);
#pragma unroll
        for (int i = 0; i < 4; ++i)
#pragma unroll
            for (int j = 0; j < 4; ++j) hb[(pts * 16 + fq * 4 + j) * 136 + (nt0 + i) * 16 + fr] = f2bf(hacc[i][j]);
    }
#pragma unroll
    for (int i = 0; i < 4; ++i)
#pragma unroll
        for (int j = 0; j < 4; ++j) stout[(pts * 16 + fq * 4 + j) * 128 + (nt0 + i) * 16 + fr] = hacc[i][j];
}

constexpr int N_OTHER = 512 + 512 + 512 + 64 + 128;
__device__ __forceinline__ void phase_mixers(int l, unsigned char* shm) {
    int* s_item = (int*)(shm + 131072);
    for (int it = blockIdx.x; it < 128; it += gridDim.x) ssd_item(kparams(), l, false, it >> 4, it & 15, shm);
    unsigned nxt_ticket = 0u;
    if (threadIdx.x == 0) nxt_ticket = atomicAdd((unsigned*)(kparams()->ws + W_CNT) + l, 1u);
    for (;;) {
        __syncthreads();
        if (threadIdx.x == 0) *s_item = (int)nxt_ticket;
        __syncthreads();
        int j = *s_item;
        if (j >= N_OTHER) break;
        const KP p = kparams();
        if (threadIdx.x == 0) nxt_ticket = atomicAdd((unsigned*)(p->ws + W_CNT) + l, 1u);
        if (j < 512) { attn_prompt_item(p, l, j, shm); continue; } j -= 512;
        if (j < 512) { gmlp_item(p, l, false, j >> 6, (j >> 2) & 15, j & 3, shm); continue; } j -= 512;
        if (j < 512) { ssd_item(p, l, true, j >> 4, j & 15, shm); continue; } j -= 512;
        if (j < 64) { attn_sample_item(p, l, j, shm); continue; } j -= 64;
        gmlp_item(p, l, true, j >> 2, 0, j & 3, shm);
    }
}

#define XB_TMO      128
#define XB_XCNT(j)  (256  + 64 * (j))
#define XB_XSUB(j)  (1280 + 64 * (j))
#define XB_XGEN(j)  (2304 + 64 * (j))
#define XB_TOP      3328
#define XB_TOPGEN   3392
#define XCD_BAR_WORDS 3456
#define XB_SPIN_CAP (1u << 18)
__device__ __forceinline__ unsigned xb_ld(unsigned* p)              { return __hip_atomic_load(p, __ATOMIC_RELAXED, __HIP_MEMORY_SCOPE_AGENT); }
__device__ __forceinline__ unsigned xb_add(unsigned* p, unsigned v) { return __hip_atomic_fetch_add(p, v, __ATOMIC_RELAXED, __HIP_MEMORY_SCOPE_AGENT); }
__device__ __forceinline__ unsigned xb_xcc_id() { return (unsigned)__builtin_amdgcn_s_getreg((3 << 11) | 20) & 0xFu; }
#define XB_SPIN(cond, bar) do { unsigned _sp = 0; while (cond) { __builtin_amdgcn_s_sleep(1); \
    if ((++_sp & 255u) == 0u) { if (xb_ld(&(bar)[XB_TMO])) break; if (_sp > XB_SPIN_CAP) { atomicAdd(&(bar)[XB_TMO], 1u); break; } } } } while (0)
struct XcdBarrier { unsigned* bar; unsigned x; volatile LAS unsigned* st; };
__device__ __forceinline__ XcdBarrier xcd_barrier_post(unsigned* bar, volatile LAS unsigned* st) {
    XcdBarrier b; b.bar = bar; b.x = xb_xcc_id(); b.st = st;
    if (threadIdx.x == 0) (void)xb_add(&bar[XB_XCNT(b.x)], 1u);
    return b;
}
__device__ __forceinline__ void xcd_barrier_complete(unsigned* bar, unsigned x, unsigned& nloc, unsigned& nx) {
    const unsigned G = gridDim.x * gridDim.y * gridDim.z;
    unsigned sum, cnt, mine, sp = 0u;
    for (;;) {
        sum = 0u; cnt = 0u; mine = 0u;
#pragma unroll
        for (unsigned j = 0; j < 16; ++j) { const unsigned c = xb_ld(&bar[XB_XCNT(j)]); sum += c; cnt += (c > 0u) ? 1u : 0u; mine = (j == x) ? c : mine; }
        if (sum == G) break;
        __builtin_amdgcn_s_sleep(1);
        if ((++sp & 255u) == 0u) { if (xb_ld(&bar[XB_TMO])) break; if (sp > XB_SPIN_CAP) { atomicAdd(&bar[XB_TMO], 1u); break; } }
    }
    nloc = mine > 0u ? mine : 1u; nx = cnt > 0u ? cnt : 1u;
}
__device__ __forceinline__ void xcd_barrier(const XcdBarrier& b) {
    asm volatile("s_waitcnt vmcnt(0)" ::: "memory");
    __syncthreads();
    if (threadIdx.x == 0) {
        unsigned* bar = b.bar;
        __builtin_amdgcn_s_waitcnt(0);
        unsigned nloc = b.st[0], nx = b.st[1];
        if (nloc == 0u) { xcd_barrier_complete(bar, b.x, nloc, nx); b.st[0] = nloc; b.st[1] = nx; }
        const unsigned old = xb_add(&bar[XB_XSUB(b.x)], 1u);
        const unsigned gen = old / nloc;
        if (old + 1u == (gen + 1u) * nloc) {
            __builtin_amdgcn_fence(__ATOMIC_RELEASE, "agent");
            asm volatile("s_waitcnt vmcnt(0)" ::: "memory");
            const unsigned og = xb_add(&bar[XB_TOP], 1u);
            const unsigned tg = og / nx;
            if (og + 1u == (tg + 1u) * nx) xb_add(&bar[XB_TOPGEN], 1u);
            else XB_SPIN(xb_ld(&bar[XB_TOPGEN]) == tg, bar);
            __builtin_amdgcn_fence(__ATOMIC_ACQUIRE, "agent");
            xb_add(&bar[XB_XGEN(b.x)], 1u);
            asm volatile("s_waitcnt vmcnt(0)" ::: "memory");
        } else {
            XB_SPIN(xb_ld(&bar[XB_XGEN(b.x)]) == gen, bar);
            __builtin_amdgcn_fence(__ATOMIC_ACQUIRE, "agent");
            asm volatile("s_waitcnt vmcnt(0)" ::: "memory");
        }
    }
    __syncthreads();
}
__device__ __forceinline__ void grid_seam(unsigned char* shm) {
    XcdBarrier b; b.bar = (unsigned*)(kparams()->ws + W_BAR); b.x = xb_xcc_id(); b.st = (volatile LAS unsigned*)(LAS unsigned char*)(shm + 131072 + 16);
    xcd_barrier(b);
}

__global__ void __launch_bounds__(512, 2) fwd_kernel(Params p_unused) {
    extern __shared__ __attribute__((aligned(16))) unsigned char shm[];
    cg::grid_group grid = cg::this_grid();
    LAS unsigned char* lds = (LAS unsigned char*)shm;
    const int tid = tid_();
#if PROBE_MASK
    unsigned long long probe_acc = 0;
#endif

    {
        if (tid == 0) { volatile LAS unsigned* st = (volatile LAS unsigned*)(LAS unsigned char*)(shm + 131072 + 16); st[0] = 0u; st[1] = 0u; }
        __syncthreads();
        const KP p = kparams();
        (void)xcd_barrier_post((unsigned*)(p->ws + W_BAR), (volatile LAS unsigned*)(LAS unsigned char*)(shm + 131072 + 16));
        if (p->ws == nullptr) grid.sync();
    }
    PH_BEGIN(0);
    phase_mod(kparams(), (float*)shm);
    {
        const KP p = kparams();
        unsigned char* ws = p->ws;
        f32x2* rope = (f32x2*)(ws + W_ROPE);
        for (int idx = blockIdx.x * 512 + tid_(); idx < 2064 * 8; idx += gridDim.x * 512) {
            const int pi = idx >> 3, j = idx & 7;
            const float pos = (float)(pi < 2048 ? pi : 4096 + (pi - 2048));
            const float invf = exp2f(-(float)j * 0.125f * 18.931568569324174f);
            const float ang = pos * invf;
            const double a = (double)ang;
            const double kk = rint(a * 0.15915494309189535);
            const float r = (float)(a - kk * 6.283185307179586);
            rope[idx] = (f32x2){__cosf(r), __sinf(r)};
        }
        if (blockIdx.x == 0 && tid < 64) ((unsigned*)(ws + W_CNT))[tid] = 0u;
    }
    convert_weights(kparams(), 0, (float*)shm);
    grid_seam(shm);
    PH_END(0);

#pragma unroll 1
    for (int l = 0; l < 2; ++l) {
        PH_BEGIN(1);
        {
            const KP p = kparams();
            float* X = p->out + O_Y;
            phase_norm(p, l, l == 0 ? p->x_prompt : X, l == 0 ? p->x_sample : X + (size_t)TP * 1024, p->g_mix + l * 1024, 0);
        }
        if (l == 1) {
            convert_weights(kparams(), 1, (float*)shm);
        }
        grid_seam(shm);
        PH_END(1);
        PH_BEGIN(2);
        {
            const KP p = kparams();
            const bf16_t* H = (const bf16_t*)(p->ws + W_H); const bf16_t* WT = (const bf16_t*)(p->ws + W_WT);
            pg8::StaticOrder S; S.init(T, NINP, (int)gridDim.x, (int)blockIdx.x);
            EpiIn E; E.l = l; E.pp = p;
            pg8::gemm_phase(lds, pg8::Gemm{H, WT + WT_IN, T, NINP, 1024}, S, E);
        }
        grid_seam(shm);
        PH_END(2);
        PH_BEGIN(3);
        conv_prepass(kparams(), l, shm);
        grid_seam(shm);
        phase_mixers(l, shm);
        grid_seam(shm);
        PH_END(3);
        PH_BEGIN(4);
#pragma unroll 1
        for (int b = 0; b < 3; ++b) {
            const KP p = kparams();
            unsigned char* ws = p->ws;
            const bf16_t* WT = (const bf16_t*)(ws + W_WT);
            const bf16_t* A = (const bf16_t*)(ws + (b == 0 ? W_Q : (b == 1 ? W_Z : W_GU)));
            const bf16_t* Bt = WT + (b == 0 ? WT_AO : (b == 1 ? WT_SO : WT_GO));
            const int K = b == 1 ? 1024 : 512;
            EpiRC<FMergeT<true>, 4> E; E.f.b = b; E.f.G8 = ws + W_G8; E.f.rowss = (const float*)(ws + W_ROWSS); E.f.MG = (bf16_t*)(ws + W_H);
            pg8::StaticOrder S; S.init(TP, 1024, (int)gridDim.x, (int)blockIdx.x);
            E.f.tile_rstd = (const float*)(shm + 131072 + 512); E.f.tile_row0 = 0;
            if (b == 1) {
                pg8::Unit u0;
                if (S.next(0, u0)) {
                    E.f.tile_row0 = u0.pm * 256;
                    const int t2 = tid_();
                    if (t2 < 256) {
                        const f32x4* pp = (const f32x4*)((const float*)(ws + W_ROWSS) + (size_t)(u0.pm * 256 + t2) * 32);
                        const f32x4 t = ((pp[0] + pp[1]) + (pp[2] + pp[3])) + ((pp[4] + pp[5]) + (pp[6] + pp[7]));
                        ((float*)(shm + 131072 + 512))[t2] = rsqrtf(((t[0] + t[1]) + (t[2] + t[3])) * (1.f / 1024.f) + EPSF);
                    }
                }
                __syncthreads();
            }
            pg8::gemm_phase(lds, pg8::Gemm{A, Bt, TP, 1024, K}, S, E);
            FMergeT<false> fs2; fs2.b = b; fs2.G8 = E.f.G8; fs2.rowss = E.f.rowss; fs2.MG = E.f.MG; fs2.tile_rstd = nullptr; fs2.tile_row0 = 0;
            if (K == 512) skinny_gemm<64>(shm, A + (size_t)TP * K, Bt, 1024, fs2); else skinny_gemm<128>(shm, A + (size_t)TP * K, Bt, 1024, fs2);
        }
        grid_seam(shm);
        PH_END(4);
#pragma unroll 1
        for (int s2 = 0; s2 < 2; ++s2) {
            PH_BEGIN(5);
            {
                const KP p = kparams();
                unsigned char* ws = p->ws;
                float* X = p->out + O_Y;
                const bf16_t* WT = (const bf16_t*)(ws + W_WT);
                const bf16_t* A = (const bf16_t*)(ws + (s2 == 0 ? W_H : W_FH));
                const bf16_t* Bt = WT + (s2 == 0 ? WT_OUT : WT_F2);
                const int K = s2 == 0 ? 1024 : 4096;
                const bool first = (l == 0 && s2 == 0);
                FResid fs; fs.srcP = first ? p->x_prompt : X; fs.srcS = first ? p->x_sample : X + (size_t)TP * 1024; fs.X = X;
                fs.modg = (const float*)(ws + W_MOD) + (size_t)l * 40 * 6144 + (s2 == 0 ? 2 : 5) * 1024;
                EpiResidP E; E.src = fs.srcP; E.X = X; E.modg = fs.modg;
                pg8::StaticOrder S; S.init(TP, 1024, (int)gridDim.x, (int)blockIdx.x);
                pg8::gemm_phase(lds, pg8::Gemm{A, Bt, TP, 1024, K}, S, E);
                if (s2 == 0) skinny_gemm<128>(shm, A + (size_t)TP * K, Bt, 1024, fs); else skinny_gemm<512>(shm, A + (size_t)TP * K, Bt, 1024, fs);
            }
            grid_seam(shm);
            PH_END(5);
            if (s2 == 0) {
                PH_BEGIN(6);
                {
                    const KP p = kparams();
                    float* X = p->out + O_Y;
                    phase_norm(p, l, X, X + (size_t)TP * 1024, p->g_ff + l * 1024, 3);
                }
                grid_seam(shm);
                PH_END(6);
                PH_BEGIN(7);
                {
                    const KP p = kparams();
                    unsigned char* ws = p->ws;
                    const bf16_t* H = (const bf16_t*)(ws + W_H); const bf16_t* WT = (const bf16_t*)(ws + W_WT);
                    EpiRC<FRelu2> E; E.f.FH = (bf16_t*)(ws + W_FH);
                    pg8::StaticOrder S; S.init(TP, 4096, (int)gridDim.x, (int)blockIdx.x);
                    pg8::gemm_phase(lds, pg8::Gemm{H, WT + WT_F1, TP, 4096, 1024}, S, E);
                    skinny_gemm<128>(shm, H + (size_t)TP * 1024, WT + WT_F1, 4096, E.f);
                }
                grid_seam(shm);
                PH_END(7);
            }
        }
    }
    {
        const KP p = kparams();
        float* X = p->out + O_Y;
        const float* gf = p->g_final;
        const int tidf = tid_(), lane = tidf & 63, gw = blockIdx.x * 8 + (tidf >> 6), ngw = gridDim.x * 8;
        for (int row = gw; row < T; row += ngw) {
            f32x4* xr = (f32x4*)(X + (size_t)row * 1024);
            f32x4 v[4]; float ss = 0.f;
#pragma unroll
            for (int j = 0; j < 4; ++j) { v[j] = xr[lane + 64 * j]; ss += v[j][0] * v[j][0] + v[j][1] * v[j][1] + v[j][2] * v[j][2] + v[j][3] * v[j][3]; }
            ss = wave_sum(ss);
            const float rstd = rsqrtf(ss * (1.f / 1024.f) + EPSF);
#pragma unroll
            for (int j = 0; j < 4; ++j) { const f32x4 g = ((const f32x4*)gf)[lane + 64 * j]; xr[lane + 64 * j] = v[j] * rstd * g; }
        }
    }
#if PROBE_MASK
    { const unsigned long long t0 = wall_clock64(); while (wall_clock64() - t0 < probe_acc) __builtin_amdgcn_s_sleep(8); }
#endif
}

extern "C" void kernel_launch(void* const* d_in, const int* in_sizes, int n_in, void* d_out, int out_size, void* d_ws, size_t ws_size, hipStream_t stream) {
    static int grid_blocks = 0;
    if (!grid_blocks) {
        int dev = 0, cus = 0, per_cu = 0;
        hipGetDevice(&dev);
        hipDeviceGetAttribute(&cus, hipDeviceAttributeMultiprocessorCount, dev);
        hipFuncSetAttribute((const void*)fwd_kernel, hipFuncAttributeMaxDynamicSharedMemorySize, LDS_BYTES);
        hipOccupancyMaxActiveBlocksPerMultiprocessor(&per_cu, (const void*)fwd_kernel, 512, LDS_BYTES);
        if (per_cu < 1) per_cu = 1;
        grid_blocks = cus * per_cu;
        if (ws_size < W_END) fprintf(stderr, "kernel_launch: workspace too small: need %zu, got %zu\n", (size_t)W_END, ws_size);
    }
    Params p{};
    const float** fp = (const float**)&p;
    for (int i = 0; i < 31; ++i) fp[i] = (const float*)d_in[i];
    p.out = (float*)d_out; p.ws = (unsigned char*)d_ws;
    (void)hipMemsetAsync((unsigned char*)d_ws + W_BAR, 0, XCD_BAR_WORDS * 4, stream);
    void* args[] = {&p};
    hipError_t e = hipLaunchCooperativeKernel((const void*)fwd_kernel, dim3(grid_blocks), dim3(512), args, LDS_BYTES, stream);
    if (e != hipSuccess) fprintf(stderr, "cooperative launch failed: %s (grid %d)\n", hipGetErrorString(e), grid_blocks);
}
```
